# Optimizing an MI355X kernel written in HIP

```python
import jax, jax.numpy as jnp
from jax import lax
import numpy as np

D_MODEL = 1024
BATCH = 8
SEQ = 4096
DEPTH = 1

HEAD_DIM = 64
RET_HEADS = 8
NSA_Q_HEADS = 8
NSA_KV_HEADS = 2
NSA_GROUP = NSA_Q_HEADS // NSA_KV_HEADS
RET_WIDTH = RET_HEADS * HEAD_DIM
NSA_WIDTH = NSA_Q_HEADS * HEAD_DIM
MIX_WIDTH = RET_WIDTH + NSA_WIDTH
KV_WIDTH = NSA_KV_HEADS * HEAD_DIM
RET_CHUNK = 128
RET_THETA = 10000.0
ROPE_THETA = 500000.0
ROPE_DIM = HEAD_DIM // 4
CMP_BLOCK = 32
CMP_STRIDE = 16
CMP_HIDDEN = 256
SEL_BLOCK = 64
SEL_TOPK = 16
WINDOW = 512
NSA_QBLOCK = 64
N_BRANCH = 3
D_FF = 2816
CONV_WIDTH = 3
PLE_DIM = 256
EPS = 1e-6

IN_SIZES = [RET_WIDTH, RET_WIDTH, RET_WIDTH, RET_WIDTH,
            NSA_WIDTH,
            KV_WIDTH, KV_WIDTH, KV_WIDTH, KV_WIDTH, KV_WIDTH, KV_WIDTH,
            NSA_Q_HEADS * N_BRANCH]
IN_WIDTH = int(sum(IN_SIZES))
IN_SPLITS = [int(v) for v in np.cumsum(IN_SIZES)[:-1]]

kernel_name = 'hymba_retnet_nsa_convffn_ple'


def rms_norm(x, w):
    x32 = x.astype(jnp.float32)
    y = x32 * lax.rsqrt(jnp.mean(x32 * x32, axis=-1, keepdims=True) + EPS)
    return (y * w.astype(jnp.float32)).astype(x.dtype)


def rope(x, pos, rot_dim, theta):
    half = rot_dim // 2
    inv = jnp.power(jnp.float32(theta), -jnp.arange(half, dtype=jnp.float32) / half)
    ang = pos.astype(jnp.float32)[..., None] * inv
    cos = jnp.cos(ang)[:, :, None, :].astype(x.dtype)
    sin = jnp.sin(ang)[:, :, None, :].astype(x.dtype)
    x1, x2, rest = x[..., :half], x[..., half:rot_dim], x[..., rot_dim:]
    return jnp.concatenate([x1 * cos - x2 * sin, x1 * sin + x2 * cos, rest], axis=-1)


def masked_softmax(s, mask):
    s = jnp.where(mask, s.astype(jnp.float32), -jnp.inf)
    m = jnp.max(s, axis=-1, keepdims=True)
    m = jnp.where(jnp.isfinite(m), m, 0.0)
    e = jnp.exp(s - m)
    return e / jnp.maximum(jnp.sum(e, axis=-1, keepdims=True), 1e-30)


def retention(q, k, v):
    B, S, H, d = q.shape
    C = RET_CHUNK
    NC = S // C
    dt = q.dtype
    log_g = jnp.log1p(-jnp.exp2(-5.0 - jnp.arange(H, dtype=jnp.float32)))
    pos = jnp.arange(C, dtype=jnp.float32)
    diff = pos[:, None] - pos[None, :]
    decay = jnp.where(diff >= 0, jnp.exp(jnp.maximum(diff, 0.0) * log_g[:, None, None]), 0.0).astype(dt)
    q_decay = jnp.exp((pos + 1.0) * log_g[:, None]).astype(dt).T
    k_decay = jnp.exp((C - 1.0 - pos) * log_g[:, None]).astype(dt).T
    chunk_decay = jnp.exp(C * log_g).astype(dt)
    qc = q.reshape(B, NC, C, H, d)
    kc = k.reshape(B, NC, C, H, d)
    vc = v.reshape(B, NC, C, H, d)
    scores = jnp.einsum('bnchd,bnkhd->bhnck', qc, kc) * decay[None, :, None]
    o_intra = jnp.einsum('bhnck,bnkhd->bnchd', scores, vc)
    kv = jnp.einsum('bnkhd,bnkhe->nbhde', kc * k_decay[None, None, :, :, None], vc)

    def step(state, kv_n):
        return state * chunk_decay[None, :, None, None] + kv_n, state

    _, prev = lax.scan(step, jnp.zeros_like(kv[0]), kv)
    o_cross = jnp.einsum('bnchd,nbhde->bnche', qc * q_decay[None, None, :, :, None], prev)
    return (o_intra + o_cross).reshape(B, S, H, d)


def nsa(q, k_cmp, v_cmp, k_slc, v_slc, k_win, v_win, gates,
        cmp_pos, cmp_k_w1, cmp_k_w2, cmp_v_w1, cmp_v_w2):
    B, S, Hq, d = q.shape
    G, R = NSA_KV_HEADS, NSA_GROUP
    dt = q.dtype
    scale = d ** -0.5
    n_cmp = (S - CMP_BLOCK) // CMP_STRIDE + 1
    tok = jnp.arange(n_cmp)[:, None] * CMP_STRIDE + jnp.arange(CMP_BLOCK)[None, :]

    def compress(t, w1, w2):
        blocks = t[:, tok] + cmp_pos[:, None, :]
        flat = blocks.transpose(0, 3, 1, 2, 4).reshape(B, G, n_cmp, CMP_BLOCK * d)
        return jax.nn.gelu(flat @ w1) @ w2

    ck = compress(k_cmp, cmp_k_w1, cmp_k_w2)
    cv = compress(v_cmp, cmp_v_w1, cmp_v_w2)
    ci = jnp.arange(n_cmp)
    cmp_end = ci * CMP_STRIDE + CMP_BLOCK - 1
    n_sel = S // SEL_BLOCK
    top = min(SEL_TOPK, n_sel)
    ks_blocks = k_slc.transpose(0, 2, 1, 3).reshape(B, G, n_sel, SEL_BLOCK, d)
    vs_blocks = v_slc.transpose(0, 2, 1, 3).reshape(B, G, n_sel, SEL_BLOCK, d)
    sj = jnp.arange(n_sel)
    overlap = ((ci[:, None] * CMP_STRIDE < (sj[None, :] + 1) * SEL_BLOCK)
               & (ci[:, None] * CMP_STRIDE + CMP_BLOCK > sj[None, :] * SEL_BLOCK)).astype(jnp.float32)
    pad = ((0, 0), (0, 0), (WINDOW, 0), (0, 0))
    kw = jnp.pad(k_win.transpose(0, 2, 1, 3), pad)
    vw = jnp.pad(v_win.transpose(0, 2, 1, 3), pad)
    QB = NSA_QBLOCK
    nqb = S // QB
    qb = q.reshape(B, nqb, QB, G, R, d).transpose(1, 0, 3, 4, 2, 5)
    bi = jnp.arange(B)[:, None, None, None]
    gi = jnp.arange(G)[None, :, None, None]

    def block(args):
        qi, i = args
        t0 = i * QB
        t = t0 + jnp.arange(QB)
        s = jnp.einsum('bgrqd,bgnd->bgrqn', qi, ck) * scale
        p_c = masked_softmax(s, cmp_end[None, :] <= t[:, None])
        o_c = jnp.einsum('bgrqn,bgnd->bgrqd', p_c.astype(dt), cv)
        imp = jnp.einsum('bgrqn,ns->bgqs', p_c, overlap)
        cur = t // SEL_BLOCK
        valid = sj[None, :] * SEL_BLOCK <= t[:, None]
        forced = (sj[None, :] == 0) | (sj[None, :] == cur[:, None]) | (sj[None, :] == cur[:, None] - 1)
        score = jnp.where(forced, jnp.inf, jnp.where(valid, imp, -jnp.inf))
        _, idx = lax.top_k(score, top)
        ksel = ks_blocks[bi, gi, idx].reshape(B, G, QB, top * SEL_BLOCK, d)
        vsel = vs_blocks[bi, gi, idx].reshape(B, G, QB, top * SEL_BLOCK, d)
        kpos = (idx[..., None] * SEL_BLOCK + jnp.arange(SEL_BLOCK)).reshape(B, G, QB, top * SEL_BLOCK)
        smask = kpos <= t[:, None]
        s = jnp.einsum('bgrqd,bgqkd->bgrqk', qi, ksel) * scale
        p_s = masked_softmax(s, smask[:, :, None])
        o_s = jnp.einsum('bgrqk,bgqkd->bgrqd', p_s.astype(dt), vsel)
        kwi = lax.dynamic_slice_in_dim(kw, t0, QB + WINDOW, axis=2)
        vwi = lax.dynamic_slice_in_dim(vw, t0, QB + WINDOW, axis=2)
        wpos = t0 - WINDOW + jnp.arange(QB + WINDOW)
        wmask = (wpos[None, :] >= 0) & (wpos[None, :] <= t[:, None]) & (wpos[None, :] > t[:, None] - WINDOW)
        s = jnp.einsum('bgrqd,bgkd->bgrqk', qi, kwi) * scale
        p_w = masked_softmax(s, wmask)
        o_w = jnp.einsum('bgrqk,bgkd->bgrqd', p_w.astype(dt), vwi)
        return o_c, o_s, o_w

    o_c, o_s, o_w = lax.map(block, (qb, jnp.arange(nqb)))
    unblock = lambda o: o.transpose(1, 0, 4, 2, 3, 5).reshape(B, S, Hq, d)
    o = (gates[..., 0:1] * unblock(o_c) + gates[..., 1:2] * unblock(o_s)
         + gates[..., 2:3] * unblock(o_w))
    return o.reshape(B, S, Hq * d)


def causal_dwconv(u, w, b):
    K = w.shape[0]
    S = u.shape[1]
    up = jnp.pad(u, ((0, 0), (K - 1, 0), (0, 0)))
    y = b
    for j in range(K):
        y = y + w[j] * up[:, j:j + S]
    return y


def setup_inputs(seed: int = 0) -> dict:
    key = jax.random.key(seed)
    ks = jax.random.split(key, 24)
    nrm = lambda k, shape, s: jax.random.normal(k, shape, jnp.float32) * s
    L = DEPTH
    inp = {}
    inp['x'] = nrm(ks[0], (BATCH, SEQ, D_MODEL), 1.0)
    inp['p'] = nrm(ks[1], (DEPTH, BATCH, SEQ, PLE_DIM), 1.0)
    offset = jax.random.randint(ks[2], (BATCH, 1), 0, 4096, dtype=jnp.int32)
    inp['positions'] = offset + jnp.arange(SEQ, dtype=jnp.int32)[None, :]
    inp['norm_mix_w'] = 1.0 + nrm(ks[3], (L, D_MODEL), 0.02)
    inp['w_in'] = nrm(ks[4], (L, D_MODEL, IN_WIDTH), D_MODEL ** -0.5)
    inp['ret_gn_w'] = 1.0 + nrm(ks[5], (L, RET_WIDTH), 0.02)
    inp['cmp_pos'] = nrm(ks[6], (L, CMP_BLOCK, HEAD_DIM), 0.02)
    inp['cmp_k_w1'] = nrm(ks[7], (L, CMP_BLOCK * HEAD_DIM, CMP_HIDDEN), (CMP_BLOCK * HEAD_DIM) ** -0.5)
    inp['cmp_k_w2'] = nrm(ks[8], (L, CMP_HIDDEN, HEAD_DIM), CMP_HIDDEN ** -0.5)
    inp['cmp_v_w1'] = nrm(ks[9], (L, CMP_BLOCK * HEAD_DIM, CMP_HIDDEN), (CMP_BLOCK * HEAD_DIM) ** -0.5)
    inp['cmp_v_w2'] = nrm(ks[10], (L, CMP_HIDDEN, HEAD_DIM), CMP_HIDDEN ** -0.5)
    inp['w_out'] = nrm(ks[11], (L, MIX_WIDTH, D_MODEL), MIX_WIDTH ** -0.5)
    inp['norm_ffn_w'] = 1.0 + nrm(ks[12], (L, D_MODEL), 0.02)
    inp['ffn_w_up'] = nrm(ks[13], (L, D_MODEL, 2 * D_FF), D_MODEL ** -0.5)
    inp['ffn_conv_w'] = nrm(ks[14], (L, CONV_WIDTH, D_FF), CONV_WIDTH ** -0.5)
    inp['ffn_conv_b'] = nrm(ks[15], (L, D_FF), 0.01)
    inp['ffn_w_down'] = nrm(ks[16], (L, D_FF, D_MODEL), D_FF ** -0.5)
    inp['ple_w'] = nrm(ks[17], (L, PLE_DIM, D_MODEL), PLE_DIM ** -0.5)
    inp['ple_gate_w'] = nrm(ks[18], (L, D_MODEL, D_MODEL), D_MODEL ** -0.5)
    inp['final_norm_w'] = 1.0 + nrm(ks[19], (D_MODEL,), 0.02)
    return inp


def reference(x, p, positions, norm_mix_w, w_in, ret_gn_w, cmp_pos, cmp_k_w1, cmp_k_w2,
              cmp_v_w1, cmp_v_w2, w_out, norm_ffn_w, ffn_w_up, ffn_conv_w, ffn_conv_b,
              ffn_w_down, ple_w, ple_gate_w, final_norm_w):
    B, S, D = x.shape
    h = x
    for i in range(DEPTH):
        xn = rms_norm(h, norm_mix_w[i])
        proj = xn @ w_in[i]
        (rq, rk, rv, rg, nq, kc, vc, ksl, vsl, kwn, vwn, ng) = jnp.split(proj, IN_SPLITS, axis=-1)
        heads = lambda t, n: t.reshape(B, S, n, HEAD_DIM)
        rq = rope(heads(rq, RET_HEADS), positions, HEAD_DIM, RET_THETA)
        rk = rope(heads(rk, RET_HEADS), positions, HEAD_DIM, RET_THETA) * (HEAD_DIM ** -0.5)
        ro = retention(rq, rk, heads(rv, RET_HEADS)).astype(jnp.float32)
        mu = jnp.mean(ro, axis=-1, keepdims=True)
        var = jnp.mean(jnp.square(ro - mu), axis=-1, keepdims=True)
        ro = ((ro - mu) * lax.rsqrt(var + EPS)).reshape(B, S, RET_WIDTH) * ret_gn_w[i].astype(jnp.float32)
        ret_out = ro.astype(h.dtype) * jax.nn.silu(rg)
        prope = lambda t, n: rope(heads(t, n), positions, ROPE_DIM, ROPE_THETA)
        nsa_out = nsa(prope(nq, NSA_Q_HEADS),
                      prope(kc, NSA_KV_HEADS), heads(vc, NSA_KV_HEADS),
                      prope(ksl, NSA_KV_HEADS), heads(vsl, NSA_KV_HEADS),
                      prope(kwn, NSA_KV_HEADS), heads(vwn, NSA_KV_HEADS),
                      jax.nn.sigmoid(ng.reshape(B, S, NSA_Q_HEADS, N_BRANCH)),
                      cmp_pos[i], cmp_k_w1[i], cmp_k_w2[i], cmp_v_w1[i], cmp_v_w2[i])
        h = h + jnp.concatenate([ret_out, nsa_out], axis=-1) @ w_out[i]
        hn = rms_norm(h, norm_ffn_w[i])
        gate_pre, val = jnp.split(hn @ ffn_w_up[i], 2, axis=-1)
        gate = causal_dwconv(gate_pre, ffn_conv_w[i], ffn_conv_b[i])
        h = h + (jax.nn.silu(gate) * val) @ ffn_w_down[i]
        h = h + jax.nn.sigmoid(h @ ple_gate_w[i]) * (p[i] @ ple_w[i])
    return rms_norm(h, final_norm_w)
```

```cpp
#include <hip/hip_runtime.h>
#include <hip/hip_cooperative_groups.h>
#include <cstdio>
#include <cstdint>
namespace cg = cooperative_groups;

#ifndef XBAR
#define XBAR 0
#endif
#ifndef REP2
#define REP2 0
#endif
#ifndef NSA_REP
#define NSA_REP 0
#endif
#ifndef P0_REP
#define P0_REP 0
#endif
#ifndef REP_MASK
#define REP_MASK 0
#endif
#ifndef N_LAUNCH_PER_PHASE
#define N_LAUNCH_PER_PHASE 0
#endif

#define LAS __attribute__((address_space(3)))
typedef unsigned short bf16_t;
typedef short bf16x8 __attribute__((ext_vector_type(8)));
typedef short v4s __attribute__((ext_vector_type(4)));
typedef float f32x4 __attribute__((ext_vector_type(4)));
typedef float f32x2 __attribute__((ext_vector_type(2)));
typedef unsigned u32x4 __attribute__((ext_vector_type(4)));
typedef unsigned u32x2 __attribute__((ext_vector_type(2)));

constexpr int NB = 8, SEQ = 4096, DM = 1024, T = NB * SEQ;
constexpr int INW = 3352, INP = 3584;
constexpr int DFF = 2816, PLE = 256;
constexpr float EPS = 1e-6f;
constexpr float QSCALE = 0.125f * 1.4426950408889634f;
constexpr int NTHR = 512;

constexpr size_t MiB = 1u << 20;
constexpr size_t WS_WIN = 0, WS_WOUT = 8 * MiB, WS_WUP = 10 * MiB, WS_WDN = 22 * MiB, WS_WG = 28 * MiB, WS_WP = 30 * MiB;
constexpr size_t WS_W1K = 31 * MiB, WS_W1V = 32 * MiB, WS_W2K = 33 * MiB, WS_W2V = 33 * MiB + 65536;
constexpr size_t WS_C1P = 33 * MiB + 512 * 1024, WS_C1 = 33 * MiB + 768 * 1024;
constexpr size_t WS_COSR = 34 * MiB, WS_SINR = 38 * MiB, WS_COSN = 42 * MiB, WS_SINN = 43 * MiB;
constexpr size_t WS_R0 = 44 * MiB, WS_SS1 = 44 * MiB + 256 * 1024, WS_SS3 = 44 * MiB + 512 * 1024;
constexpr size_t WS_SB = 46 * MiB;
constexpr size_t WS_PE = 80 * MiB;
constexpr size_t WS_XS = 144 * MiB;
constexpr size_t WS_PB = 208 * MiB;
constexpr size_t WS_RQ = 224 * MiB, WS_RK = 256 * MiB, WS_RV = 288 * MiB, WS_RG = 320 * MiB, WS_NQ = 352 * MiB;
constexpr size_t WS_KC = 384 * MiB, WS_VC = 392 * MiB, WS_KS = 400 * MiB, WS_VS = 408 * MiB, WS_KW = 416 * MiB, WS_VW = 424 * MiB;
constexpr size_t WS_NG = 432 * MiB;
constexpr size_t WS_KVST = 436 * MiB;
constexpr size_t WS_HIDK = 468 * MiB, WS_HIDV = 470 * MiB, WS_CK = 472 * MiB, WS_CV = 472 * MiB + 512 * 1024;
constexpr size_t WS_HS = 224 * MiB;
constexpr size_t WS_ACT = 288 * MiB;
constexpr size_t WS_BAR = 474 * MiB;
constexpr size_t WS_END = 475 * MiB;

constexpr int LDS_BYTES = 147456;

typedef __bf16 bf16x2_t __attribute__((ext_vector_type(2)));
__device__ __forceinline__ unsigned cvt_pk_bf16(float lo, float hi) { const f32x2 v = {lo, hi}; const bf16x2_t b = __builtin_convertvector(v, bf16x2_t); return __builtin_bit_cast(unsigned, b); }
__device__ __forceinline__ float bf2f(unsigned short b) { return __uint_as_float(((unsigned)b) << 16); }
__device__ __forceinline__ float fexp2(float x) { return __builtin_amdgcn_exp2f(x); }
__device__ __forceinline__ float frcp(float x) { return __builtin_amdgcn_rcpf(x); }
__device__ __forceinline__ float sigmoidf_(float x) { return frcp(1.f + fexp2(-1.4426950408889634f * x)); }
__device__ __forceinline__ float siluf_(float x) { return x * sigmoidf_(x); }
__device__ __forceinline__ float gelu_tanh(float x) { const float u = 0.7978845608028654f * (x + 0.044715f * x * x * x); const float e = fexp2(2.f * 1.4426950408889634f * u); return 0.5f * x * (2.f - 2.f * frcp(1.f + e)); }
__device__ __forceinline__ v4s trrd(const LAS unsigned char* p) { return __builtin_amdgcn_ds_read_tr16_b64_v4i16((LAS v4s*)p); }
__device__ __forceinline__ bf16x8 cat8(v4s a, v4s b) { return __builtin_shufflevector(a, b, 0, 1, 2, 3, 4, 5, 6, 7); }
__device__ __forceinline__ f32x4 mfma16(bf16x8 a, bf16x8 b, f32x4 c) { return __builtin_amdgcn_mfma_f32_16x16x32_bf16(a, b, c, 0, 0, 0); }
__device__ __forceinline__ u32x2 pack4(f32x4 v) { u32x2 w; w.x = cvt_pk_bf16(v[0], v[1]); w.y = cvt_pk_bf16(v[2], v[3]); return w; }
__device__ __forceinline__ bf16x8 pack8(f32x4 a, f32x4 b) { u32x4 w; w.x = cvt_pk_bf16(a[0], a[1]); w.y = cvt_pk_bf16(a[2], a[3]); w.z = cvt_pk_bf16(b[0], b[1]); w.w = cvt_pk_bf16(b[2], b[3]); return __builtin_bit_cast(bf16x8, w); }
__device__ __forceinline__ float rows_max(float v) {
    auto a = __builtin_amdgcn_permlane16_swap(__float_as_uint(v), __float_as_uint(v), false, false); v = fmaxf(__uint_as_float(a[0]), __uint_as_float(a[1]));
    auto b = __builtin_amdgcn_permlane32_swap(__float_as_uint(v), __float_as_uint(v), false, false); return fmaxf(__uint_as_float(b[0]), __uint_as_float(b[1]));
}
__device__ __forceinline__ float rows_sum(float v) {
    auto a = __builtin_amdgcn_permlane16_swap(__float_as_uint(v), __float_as_uint(v), false, false); v = __uint_as_float(a[0]) + __uint_as_float(a[1]);
    auto b = __builtin_amdgcn_permlane32_swap(__float_as_uint(v), __float_as_uint(v), false, false); return __uint_as_float(b[0]) + __uint_as_float(b[1]);
}
template <int N> __device__ __forceinline__ float row_ror(float v) { return __uint_as_float((unsigned)__builtin_amdgcn_update_dpp(0, (int)__float_as_uint(v), 0x120 + N, 0xf, 0xf, false)); }
__device__ __forceinline__ void store_pair16(bf16_t* pX, bf16_t* pY, u32x2 X, u32x2 Y, int fq, bool okX, bool okY) {
    auto r0 = __builtin_amdgcn_permlane16_swap(X.x, Y.x, false, false); auto r1 = __builtin_amdgcn_permlane16_swap(X.y, Y.y, false, false);
    u32x4 o; o.x = r0[0]; o.y = r1[0]; o.z = r0[1]; o.w = r1[1];
    bf16_t* ad = (fq & 1) ? pY - 4 : pX; const bool ok = (fq & 1) ? okY : okX;
    if (ok) *(u32x4*)ad = o;
}
__device__ __forceinline__ void load_pair16(const bf16_t* pX, const bf16_t* pY, u32x2& X, u32x2& Y, int fq) {
    const u32x4 o = *(const u32x4*)((fq & 1) ? pY - 4 : pX);
    auto r0 = __builtin_amdgcn_permlane16_swap(o.x, o.z, false, false); auto r1 = __builtin_amdgcn_permlane16_swap(o.y, o.w, false, false);
    X.x = r0[0]; Y.x = r0[1]; X.y = r1[0]; Y.y = r1[1];
}
__device__ __forceinline__ float wave_sum(float v) {
#pragma unroll
    for (int o = 1; o < 64; o <<= 1) v += __shfl_xor(v, o);
    return v;
}

namespace pg8 {
constexpr int BM = 256, BK = 64, HALF = 128, HTB = HALF * BK * 2, STAGE_BYTES = 8 * HTB, NXCD = 8, WGM = 8;
__host__ __device__ __forceinline__ int lds_byte(int r, int c) { const int st = (r >> 4) * 2 + (c >> 5), rr = r & 15, cc = c & 31, ob = rr * 64 + cc * 2; return st * 1024 + (ob ^ (((ob >> 9) & 1) << 5)); }
__host__ __device__ __forceinline__ void stage_rc(int b, int& R, int& C) { const int st = b / 1024, sb = b % 1024, swz = sb ^ (((sb >> 9) & 1) << 5); R = (st >> 1) * 16 + swz / 64; C = (st & 1) * 32 + (swz % 64) / 2; }
struct Unit { int pm, pn; };
struct Gemm { const bf16_t* A; const bf16_t* Bt; int M, N, K, lda, ldb; };
struct StaticOrder {
    int nM, nN, nwg, G, c;
    __device__ void init(int M, int N, int G_, int c_) { nM = M / BM; nN = N / BM; nwg = nM * nN; G = G_; c = c_; }
    __device__ bool next(int i, Unit& u) const {
        const long L = (long)i * G + c; if (c < 0 || L >= nwg) return false;
        int wgid = (int)L; { const int q = nwg / NXCD, r = nwg % NXCD, xcd = wgid % NXCD, off = wgid / NXCD; wgid = (xcd < r ? xcd * (q + 1) : r * (q + 1) + (xcd - r) * q) + off; }
        const int nig = WGM * nN, gid = wgid / nig, fm = gid * WGM, gsz = (nM - fm) < WGM ? (nM - fm) : WGM;
        u.pm = fm + ((wgid % nig) % gsz); u.pn = (wgid % nig) / gsz; return true;
    }
};
template <class Epi>
__device__ __forceinline__ void gemm_phase(LAS unsigned char* lds, const Gemm g, const StaticOrder& S, const Epi& E, const int tid) {
    const int wid = __builtin_amdgcn_readfirstlane(tid >> 6), lane = tid & 63, wr = wid >> 2, wc = wid & 3, fr = lane & 15, fq = lane >> 4;
    const int K = g.K, nt = K / BK, lda = g.lda, ldb = g.ldb;
    unsigned voffA[2], voffB[2];
#pragma unroll
    for (int i = 0; i < 2; ++i) { int R, C; stage_rc(tid * 16 + i * 8192, R, C); voffA[i] = (unsigned)(R * lda + C) * 2u; voffB[i] = (unsigned)(R * ldb + C) * 2u; }
    const size_t kstep = (size_t)(BK * 2);
    const size_t hstepA = (size_t)HALF * lda * 2, hstepB = (size_t)HALF * ldb * 2;
    const size_t tstepA = 2 * hstepA, tstepB = 2 * hstepB;
    const unsigned ldsw = (unsigned)wid * 1024u;
    const int aoff = lds_byte(wr * 64 + fr, fq * 8), boff = lds_byte(wc * 32 + fr, fq * 8);
#define PG8_SA(b, h) (((b) * 2 + (h)) * HTB)
#define PG8_SB(b, h) ((4 + (b) * 2 + (h)) * HTB)
#define PG8_STAGE(bufoff, gbase, voff) do { _Pragma("unroll") for (int _i = 0; _i < 2; ++_i) \
        __builtin_amdgcn_global_load_lds((const unsigned*)((const char*)(gbase) + (voff)[_i]), (LAS unsigned*)(lds + (bufoff) + ldsw + _i * 8192), 16, 0, 0); } while (0)
#define PG8_LDA(dst, b, h) do { _Pragma("unroll") for (int m = 0; m < 4; ++m) _Pragma("unroll") for (int k = 0; k < 2; ++k) dst[m][k] = *(const LAS bf16x8*)(lds + PG8_SA(b, h) + aoff + m * 2048 + k * 1024); } while (0)
#define PG8_LDB(dst, b, h) do { _Pragma("unroll") for (int n = 0; n < 2; ++n) _Pragma("unroll") for (int k = 0; k < 2; ++k) dst[n][k] = *(const LAS bf16x8*)(lds + PG8_SB(b, h) + boff + n * 2048 + k * 1024); } while (0)
#define PG8_MMA(ai, bj, At, Bt) do { __builtin_amdgcn_s_setprio(1); _Pragma("unroll") for (int m = 0; m < 4; ++m) _Pragma("unroll") for (int n = 0; n < 2; ++n) _Pragma("unroll") for (int k = 0; k < 2; ++k) \
        acc[ai][bj][m][n] = __builtin_amdgcn_mfma_f32_16x16x32_bf16(Bt[n][k], At[m][k], acc[ai][bj][m][n], 0, 0, 0); __builtin_amdgcn_s_setprio(0); } while (0)
#define PG8_WAIT_V(n) asm volatile("s_waitcnt vmcnt(" #n ")" ::: "memory")
#define PG8_WAIT_L(n) asm volatile("s_waitcnt lgkmcnt(" #n ")" ::: "memory")
#define PG8_BAR __builtin_amdgcn_s_barrier()
#define PG8_SCHED __builtin_amdgcn_sched_barrier(0)
    Unit cur, nxt; int ui = 0;
    if (!S.next(0, cur)) return;
    f32x4 acc[2][2][4][2];
#pragma unroll
    for (int a = 0; a < 2; ++a)
#pragma unroll
        for (int b = 0; b < 2; ++b)
#pragma unroll
            for (int m = 0; m < 4; ++m)
#pragma unroll
                for (int n = 0; n < 2; ++n) acc[a][b][m][n] = (f32x4){0.f, 0.f, 0.f, 0.f};
    bf16x8 At[4][2], B0[2][2], B1[2][2];
    const char* cA = (const char*)g.A + (size_t)cur.pm * tstepA; const char* cB = (const char*)g.Bt + (size_t)cur.pn * tstepB;
    PG8_STAGE(PG8_SB(0, 0), cB, voffB); PG8_STAGE(PG8_SB(0, 1), cB + hstepB, voffB); PG8_STAGE(PG8_SA(0, 0), cA, voffA); PG8_STAGE(PG8_SA(0, 1), cA + hstepA, voffA);
    if (wr == 1) PG8_BAR;
    PG8_WAIT_V(2); PG8_BAR;
    PG8_STAGE(PG8_SB(1, 0), cB + kstep, voffB); PG8_STAGE(PG8_SA(1, 0), cA + kstep, voffA); PG8_STAGE(PG8_SB(1, 1), cB + hstepB + kstep, voffB);
    PG8_WAIT_V(6); PG8_BAR;
    for (;;) {
        const bool has_next = S.next(ui + 1, nxt);
        const char* nA = has_next ? (const char*)g.A + (size_t)nxt.pm * tstepA : cA; const char* nB = has_next ? (const char*)g.Bt + (size_t)nxt.pn * tstepB : cB;
        for (int t = 0; t < nt; t += 2) {
            const bool last = (t == nt - 2);
            const char* a1 = cA + (size_t)(t + 1) * kstep;
            const char* a2 = last ? nA : cA + (size_t)(t + 2) * kstep; const char* b2 = last ? nB : cB + (size_t)(t + 2) * kstep;
            const char* a3 = a2 + kstep; const char* b3 = b2 + kstep;
            PG8_LDB(B0, 0, 0); PG8_LDB(B1, 0, 1); PG8_SCHED; PG8_LDA(At, 0, 0); PG8_STAGE(PG8_SA(1, 1), a1 + hstepA, voffA);
            PG8_WAIT_V(8); PG8_WAIT_L(0); PG8_BAR; PG8_MMA(0, 0, At, B0); PG8_MMA(0, 1, At, B1); PG8_BAR; PG8_SCHED;
            PG8_LDA(At, 0, 1); PG8_STAGE(PG8_SB(0, 0), b2, voffB); PG8_STAGE(PG8_SB(0, 1), b2 + hstepB, voffB); PG8_STAGE(PG8_SA(0, 0), a2, voffA);
            PG8_WAIT_V(8); PG8_WAIT_L(0); PG8_BAR; PG8_MMA(1, 0, At, B0); PG8_MMA(1, 1, At, B1); PG8_BAR; PG8_SCHED;
            PG8_LDB(B0, 1, 0); PG8_LDB(B1, 1, 1); PG8_SCHED; PG8_LDA(At, 1, 0); PG8_STAGE(PG8_SA(0, 1), a2 + hstepA, voffA);
            PG8_WAIT_V(8); PG8_WAIT_L(0); PG8_BAR; PG8_MMA(0, 0, At, B0); PG8_MMA(0, 1, At, B1); PG8_BAR; PG8_SCHED;
            PG8_LDA(At, 1, 1); PG8_STAGE(PG8_SB(1, 0), b3, voffB); PG8_STAGE(PG8_SB(1, 1), b3 + hstepB, voffB); PG8_STAGE(PG8_SA(1, 0), a3, voffA);
            PG8_WAIT_V(8); PG8_WAIT_L(0); PG8_BAR; PG8_MMA(1, 0, At, B0); PG8_MMA(1, 1, At, B1); PG8_BAR; PG8_SCHED;
        }
        if (wr == 0) PG8_BAR;
        E(acc, cur, wr, wc, fr, fq);
        if (!has_next) break;
#pragma unroll
        for (int a = 0; a < 2; ++a)
#pragma unroll
            for (int b = 0; b < 2; ++b)
#pragma unroll
                for (int m = 0; m < 4; ++m)
#pragma unroll
                    for (int n = 0; n < 2; ++n) acc[a][b][m][n] = (f32x4){0.f, 0.f, 0.f, 0.f};
        cur = nxt; cA = nA; cB = nB; ++ui;
        if (wr == 1) PG8_BAR;
    }
    PG8_WAIT_V(0);
    PG8_BAR;
#undef PG8_SA
#undef PG8_SB
#undef PG8_STAGE
#undef PG8_LDA
#undef PG8_LDB
#undef PG8_MMA
#undef PG8_WAIT_V
#undef PG8_WAIT_L
#undef PG8_BAR
#undef PG8_SCHED
}
}
using pg8::Unit;
typedef f32x4 Acc[2][2][4][2];

struct EpiIn {
    const float* r0; const int* pos; unsigned char* ws;
    __device__ __forceinline__ void operator()(const Acc& acc, const Unit& u, int wr, int wc, int fr, int fq) const {
        const int tile = u.pn;
        f32x4 invr[2], invn;
#pragma unroll
        for (int e = 0; e < 4; ++e) { invr[0][e] = fexp2(-(float)(4 * fq + e) * (13.287712379549449f / 32.f)); invr[1][e] = fexp2(-(float)(16 + 4 * fq + e) * (13.287712379549449f / 32.f));
            invn[e] = fexp2(-(float)(4 * (fq & 1) + e) * (18.931568569324174f / 8.f)); }
        float rsv[2][4], pfv[2][4], myr[2], myp[2];
#pragma unroll
        for (int ai = 0; ai < 2; ++ai) { const int rowl = u.pm * 256 + ai * 128 + wr * 64 + fq * 16 + fr; myr[ai] = r0[rowl]; myp[ai] = (float)pos[rowl]; }
#pragma unroll
        for (int ai = 0; ai < 2; ++ai)
#pragma unroll
            for (int m = 0; m < 4; ++m) { rsv[ai][m] = __shfl(myr[ai], fr + 16 * m); pfv[ai][m] = __shfl(myp[ai], fr + 16 * m); }
#pragma unroll
        for (int ai = 0; ai < 2; ++ai)
#pragma unroll
            for (int m = 0; m < 4; ++m) {
                const int row = u.pm * 256 + ai * 128 + wr * 64 + m * 16 + fr;
                const float rs = rsv[ai][m], pf = pfv[ai][m];
                if (tile < 4) {
                    bf16_t* dst = (bf16_t*)(ws + (tile < 2 ? WS_RQ : WS_RK)) + (size_t)row * 512 + ((tile & 1) * 4 + wc) * 64;
                    const float sc = tile < 2 ? rs : rs * 0.125f; u32x2 o1[2], o2[2];
#pragma unroll
                    for (int n = 0; n < 2; ++n) {
                        const int i0 = 16 * n + 4 * fq;
                        f32x4 c4, s4;
#pragma unroll
                        for (int e = 0; e < 4; ++e) { const float fv = __builtin_amdgcn_fractf(pf * invr[n][e] * 0.15915494309189535f); c4[e] = __builtin_amdgcn_cosf(fv); s4[e] = __builtin_amdgcn_sinf(fv); }
                        const f32x4 x1 = acc[ai][0][m][n] * sc, x2 = acc[ai][1][m][n] * sc;
                        o1[n] = pack4(x1 * c4 - x2 * s4); o2[n] = pack4(x1 * s4 + x2 * c4);
                    }
                    store_pair16(dst + 4 * fq, dst + 16 + 4 * fq, o1[0], o1[1], fq, true, true);
                    store_pair16(dst + 32 + 4 * fq, dst + 48 + 4 * fq, o2[0], o2[1], fq, true, true);
                } else if (tile < 8) {
                    bf16_t* dst = (bf16_t*)(ws + (tile < 6 ? WS_RV : WS_RG)) + (size_t)row * 512 + ((tile & 1) * 4 + wc) * 64;
#pragma unroll
                    for (int bj = 0; bj < 2; ++bj) { u32x2 ov[2];
#pragma unroll
                        for (int n = 0; n < 2; ++n) {
                            f32x4 v = acc[ai][bj][m][n] * rs;
                            if (tile >= 6) { v[0] = siluf_(v[0]); v[1] = siluf_(v[1]); v[2] = siluf_(v[2]); v[3] = siluf_(v[3]); }
                            ov[n] = pack4(v);
                        }
                        store_pair16(dst + 32 * bj + 4 * fq, dst + 32 * bj + 16 + 4 * fq, ov[0], ov[1], fq, true, true); }
                } else if (tile < 13) {
                    bf16_t* dst; bool roped; float sc = rs;
                    if (tile < 10) { dst = (bf16_t*)(ws + WS_NQ) + (size_t)row * 512 + ((tile & 1) * 4 + wc) * 64; roped = true; sc = rs * QSCALE; }
                    else { const int seg = wc >> 1, g = wc & 1, b = row >> 12, s = row & 4095;
                        const size_t base = (tile == 10 ? (seg ? WS_VC : WS_KC) : tile == 11 ? (seg ? WS_VS : WS_KS) : (seg ? WS_VW : WS_KW));
                        dst = (bf16_t*)(ws + base) + ((size_t)(b * 2 + g) * SEQ + s) * 64; roped = (seg == 0); }
                    f32x4 c4, s4;
#pragma unroll
                    for (int e = 0; e < 4; ++e) { const float fv = __builtin_amdgcn_fractf(pf * invn[e] * 0.15915494309189535f); c4[e] = __builtin_amdgcn_cosf(fv); s4[e] = __builtin_amdgcn_sinf(fv); }
#pragma unroll
                    for (int bj = 0; bj < 2; ++bj) { u32x2 ov[2];
#pragma unroll
                        for (int n = 0; n < 2; ++n) {
                            f32x4 v = acc[ai][bj][m][n] * sc;
                            if (bj == 0 && n == 0) {
                                f32x4 pr; pr[0] = __shfl_xor(v[0], 32); pr[1] = __shfl_xor(v[1], 32); pr[2] = __shfl_xor(v[2], 32); pr[3] = __shfl_xor(v[3], 32);
                                const f32x4 rot = (fq < 2) ? (v * c4 - pr * s4) : (pr * s4 + v * c4);
                                if (roped) v = rot;
                            }
                            ov[n] = pack4(v);
                        }
                        store_pair16(dst + 32 * bj + 4 * fq, dst + 32 * bj + 16 + 4 * fq, ov[0], ov[1], fq, true, true); }
                } else {
                    float* ng = (float*)(ws + WS_NG) + (size_t)row * 24;
                    if (wc == 0) {
                        const f32x4 v0 = acc[ai][0][m][0] * rs; f32x4 o;
                        o[0] = sigmoidf_(v0[0]); o[1] = sigmoidf_(v0[1]); o[2] = sigmoidf_(v0[2]); o[3] = sigmoidf_(v0[3]);
                        *(f32x4*)(ng + 4 * fq) = o;
                        if (fq < 2) { const f32x4 v1 = acc[ai][0][m][1] * rs; o[0] = sigmoidf_(v1[0]); o[1] = sigmoidf_(v1[1]); o[2] = sigmoidf_(v1[2]); o[3] = sigmoidf_(v1[3]); *(f32x4*)(ng + 16 + 4 * fq) = o; }
                    }
                }
            }
    }
};
template <int ACT> struct EpiBf16 {
    bf16_t* O; int ldc; const float* bias;
    __device__ __forceinline__ void operator()(const Acc& acc, const Unit& u, int wr, int wc, int fr, int fq) const {
#pragma unroll
        for (int ai = 0; ai < 2; ++ai)
#pragma unroll
            for (int m = 0; m < 4; ++m) {
                const int row = u.pm * 256 + ai * 128 + wr * 64 + m * 16 + fr;
#pragma unroll
                for (int bj = 0; bj < 2; ++bj) { u32x2 ov[2];
#pragma unroll
                    for (int n = 0; n < 2; ++n) {
                        const int col = u.pn * 256 + 128 * bj + 32 * wc + 16 * n + 4 * fq;
                        f32x4 v = acc[ai][bj][m][n];
                        if (ACT == 1) { const f32x4 bv = *(const f32x4*)(bias + col); v = v + bv; v[0] = gelu_tanh(v[0]); v[1] = gelu_tanh(v[1]); v[2] = gelu_tanh(v[2]); v[3] = gelu_tanh(v[3]); }
                        ov[n] = pack4(v);
                    }
                    bf16_t* pb_ = O + (size_t)row * ldc + u.pn * 256 + 128 * bj + 32 * wc + 4 * fq; store_pair16(pb_, pb_ + 16, ov[0], ov[1], fq, true, true); }
            }
    }
};
struct EpiF32 {
    float* O; int ldc;
    __device__ __forceinline__ void operator()(const Acc& acc, const Unit& u, int wr, int wc, int fr, int fq) const {
#pragma unroll
        for (int ai = 0; ai < 2; ++ai)
#pragma unroll
            for (int m = 0; m < 4; ++m) {
                const int row = u.pm * 256 + ai * 128 + wr * 64 + m * 16 + fr;
#pragma unroll
                for (int bj = 0; bj < 2; ++bj)
#pragma unroll
                    for (int n = 0; n < 2; ++n) *(f32x4*)(O + (size_t)row * ldc + u.pn * 256 + 128 * bj + 32 * wc + 16 * n + 4 * fq) = acc[ai][bj][m][n];
            }
    }
};
struct EpiOut {
    const bf16_t* xb; bf16_t* h1b; float* ss; int dry;
    __device__ __forceinline__ void operator()(const Acc& acc, const Unit& u, int wr, int wc, int fr, int fq) const {
        if (dry) { if (acc[0][0][0][0][0] == 1.2345e-30f) ss[0] = 0.f; return; }
#pragma unroll
        for (int ai = 0; ai < 2; ++ai) {
            u32x2 rv[4][2][2];
#pragma unroll
            for (int m = 0; m < 4; ++m)
#pragma unroll
                for (int bj = 0; bj < 2; ++bj) { const bf16_t* pl_ = xb + (size_t)(u.pm * 256 + ai * 128 + wr * 64 + m * 16 + fr) * DM + u.pn * 256 + 128 * bj + 32 * wc + 4 * fq; load_pair16(pl_, pl_ + 16, rv[m][bj][0], rv[m][bj][1], fq); }
#pragma unroll
            for (int m = 0; m < 4; ++m) {
                const int row = u.pm * 256 + ai * 128 + wr * 64 + m * 16 + fr; float sq = 0.f;
#pragma unroll
                for (int bj = 0; bj < 2; ++bj) { u32x2 ov[2];
#pragma unroll
                    for (int n = 0; n < 2; ++n) {
                        const u32x2 w = rv[m][bj][n];
                        const f32x4 h = (f32x4){__uint_as_float(w.x << 16), __uint_as_float(w.x & 0xffff0000u), __uint_as_float(w.y << 16), __uint_as_float(w.y & 0xffff0000u)} + acc[ai][bj][m][n];
                        ov[n] = pack4(h); sq += (h[0] * h[0] + h[1] * h[1]) + (h[2] * h[2] + h[3] * h[3]);
                    }
                    bf16_t* pb_ = h1b + (size_t)row * DM + u.pn * 256 + 128 * bj + 32 * wc + 4 * fq; store_pair16(pb_, pb_ + 16, ov[0], ov[1], fq, true, true); }
                sq += __shfl_xor(sq, 16); sq += __shfl_xor(sq, 32);
                if (fq == 0) atomicAdd(ss + row, sq);
            }
        }
    }
};
struct EpiUp {
    const float* ss1; const float* cw; const float* cb; bf16_t* act; float* sb;
    __device__ __forceinline__ void operator()(const Acc& acc, const Unit& u, int wr, int wc, int fr, int fq) const {
        float rsv[2][4], myss[2];
        myss[0] = ss1[u.pm * 256 + wr * 64 + fq * 16 + fr]; myss[1] = ss1[u.pm * 256 + 128 + wr * 64 + fq * 16 + fr];
#pragma unroll
        for (int ai = 0; ai < 2; ++ai)
#pragma unroll
            for (int m = 0; m < 4; ++m) rsv[ai][m] = __shfl(myss[ai], fr + 16 * m);
#pragma unroll
        for (int ai = 0; ai < 2; ++ai)
#pragma unroll
            for (int m = 0; m < 4; ++m) rsv[ai][m] = rsqrtf(rsv[ai][m] * (1.f / DM) + EPS);
#pragma unroll
        for (int n = 0; n < 2; ++n) {
            const int col = u.pn * 128 + wc * 32 + 16 * n + 4 * fq;
            const f32x4 w0 = *(const f32x4*)(cw + col), w1 = *(const f32x4*)(cw + DFF + col), w2 = *(const f32x4*)(cw + 2 * DFF + col), bb = *(const f32x4*)(cb + col);
#pragma unroll
            for (int ai = 0; ai < 2; ++ai) {
                const int unit = u.pm * 4 + ai * 2 + wr;
                f32x4 pg = (f32x4){0.f, 0.f, 0.f, 0.f}; u32x2 ppk = (u32x2){0u, 0u};
#pragma unroll
                for (int m = 0; m < 4; ++m) {
                    const int row = u.pm * 256 + ai * 128 + wr * 64 + m * 16 + fr;
                    const float rs = rsv[ai][m];
                    const f32x4 G = acc[ai][0][m][n] * rs, V = acc[ai][1][m][n] * rs; f32x4 a;
#pragma unroll
                    for (int e = 0; e < 4; ++e) {
                        const float a1 = row_ror<1>(G[e]), a2 = row_ror<2>(G[e]), b1 = row_ror<1>(pg[e]), b2 = row_ror<2>(pg[e]);
                        const float g1 = fr >= 1 ? a1 : b1, g2 = fr >= 2 ? a2 : b2;
                        const float gate = bb[e] + w0[e] * g2 + w1[e] * g1 + w2[e] * G[e];
                        a[e] = siluf_(gate) * V[e];
                    }
                    if (m == 0 && fr < 2) { *(f32x4*)(sb + ((size_t)unit * 6 + fr) * DFF + col) = G; *(f32x4*)(sb + ((size_t)unit * 6 + 2 + fr) * DFF + col) = V; }
                    if (m == 3 && fr >= 14) *(f32x4*)(sb + ((size_t)unit * 6 + 4 + (fr - 14)) * DFF + col) = G;
                    if ((m & 1) == 0) ppk = pack4(a);
                    else store_pair16(act + (size_t)(row - 16) * DFF + col, act + (size_t)row * DFF + col, ppk, pack4(a), fq, (m != 1) || (fr >= 2), true);
                    pg = G;
                }
            }
        }
    }
};
struct EpiDown {
    const bf16_t* h1b; bf16_t* hb; int dry;
    __device__ __forceinline__ void operator()(const Acc& acc, const Unit& u, int wr, int wc, int fr, int fq) const {
        if (dry) { if (acc[0][0][0][0][0] == 1.2345e-30f) hb[0] = 0; return; }
#pragma unroll
        for (int ai = 0; ai < 2; ++ai) {
            u32x2 rv[4][2][2];
#pragma unroll
            for (int m = 0; m < 4; ++m)
#pragma unroll
                for (int bj = 0; bj < 2; ++bj) { const bf16_t* pl_ = h1b + (size_t)(u.pm * 256 + ai * 128 + wr * 64 + m * 16 + fr) * DM + u.pn * 256 + 128 * bj + 32 * wc + 4 * fq; load_pair16(pl_, pl_ + 16, rv[m][bj][0], rv[m][bj][1], fq); }
#pragma unroll
            for (int m = 0; m < 4; ++m) {
                const int row = u.pm * 256 + ai * 128 + wr * 64 + m * 16 + fr;
#pragma unroll
                for (int bj = 0; bj < 2; ++bj) { u32x2 ov[2];
#pragma unroll
                    for (int n = 0; n < 2; ++n) { const u32x2 w = rv[m][bj][n];
                        ov[n] = pack4((f32x4){__uint_as_float(w.x << 16), __uint_as_float(w.x & 0xffff0000u), __uint_as_float(w.y << 16), __uint_as_float(w.y & 0xffff0000u)} + acc[ai][bj][m][n]); }
                    bf16_t* pb_ = hb + (size_t)row * DM + u.pn * 256 + 128 * bj + 32 * wc + 4 * fq; store_pair16(pb_, pb_ + 16, ov[0], ov[1], fq, true, true); }
            }
        }
    }
};
struct EpiPle {
    const bf16_t* h2b; bf16_t* h3b; const bf16_t* pe; float* ss; int dry;
    __device__ __forceinline__ void operator()(const Acc& acc, const Unit& u, int wr, int wc, int fr, int fq) const {
        if (dry) { if (acc[0][0][0][0][0] == 1.2345e-30f) h3b[0] = 0; return; }
#pragma unroll
        for (int ai = 0; ai < 2; ++ai)
#pragma unroll
            for (int mh = 0; mh < 2; ++mh) {
                u32x2 hv[2][2][2], pv[2][2][2];
#pragma unroll
                for (int mm = 0; mm < 2; ++mm)
#pragma unroll
                    for (int bj = 0; bj < 2; ++bj) { const size_t off = (size_t)(u.pm * 256 + ai * 128 + wr * 64 + (2 * mh + mm) * 16 + fr) * DM + u.pn * 256 + 128 * bj + 32 * wc + 4 * fq;
                        load_pair16(h2b + off, h2b + off + 16, hv[mm][bj][0], hv[mm][bj][1], fq); load_pair16(pe + off, pe + off + 16, pv[mm][bj][0], pv[mm][bj][1], fq); }
#pragma unroll
                for (int mm = 0; mm < 2; ++mm) {
                    const int m = 2 * mh + mm; const int row = u.pm * 256 + ai * 128 + wr * 64 + m * 16 + fr; float sq = 0.f;
#pragma unroll
                    for (int bj = 0; bj < 2; ++bj) { u32x2 ov[2];
#pragma unroll
                        for (int n = 0; n < 2; ++n) {
                            const u32x2 pw = pv[mm][bj][n], hw = hv[mm][bj][n]; const f32x4 a = acc[ai][bj][m][n];
                            f32x4 h = (f32x4){__uint_as_float(hw.x << 16), __uint_as_float(hw.x & 0xffff0000u), __uint_as_float(hw.y << 16), __uint_as_float(hw.y & 0xffff0000u)};
                            h[0] += sigmoidf_(a[0]) * __uint_as_float(pw.x << 16); h[1] += sigmoidf_(a[1]) * __uint_as_float(pw.x & 0xffff0000u);
                            h[2] += sigmoidf_(a[2]) * __uint_as_float(pw.y << 16); h[3] += sigmoidf_(a[3]) * __uint_as_float(pw.y & 0xffff0000u);
                            ov[n] = pack4(h); sq += (h[0] * h[0] + h[1] * h[1]) + (h[2] * h[2] + h[3] * h[3]);
                        }
                        bf16_t* pb_ = h3b + (size_t)row * DM + u.pn * 256 + 128 * bj + 32 * wc + 4 * fq; store_pair16(pb_, pb_ + 16, ov[0], ov[1], fq, true, true); }
                    sq += __shfl_xor(sq, 16); sq += __shfl_xor(sq, 32);
                    if (fq == 0) atomicAdd(ss + row, sq);
                }
            }
    }
};

__device__ __forceinline__ void tr_item(const float* W, int K, int N, bf16_t* WT, LAS float* scr, int k0, int np0, int src0, int lane, const float* ksc = nullptr) {
    const int q4 = lane & 7, kr = lane >> 3, sc = src0 + 4 * q4; const bool ok = sc < N;
#pragma unroll
    for (int i = 0; i < 8; ++i) { const int kk = 8 * i + kr; const f32x4 v = ok ? *(const f32x4*)(W + (size_t)(k0 + kk) * N + sc) : (f32x4){0.f, 0.f, 0.f, 0.f};
        LAS float* d = scr + kk * 33 + 4 * q4; d[0] = v[0]; d[1] = v[1]; d[2] = v[2]; d[3] = v[3]; }
    asm volatile("s_waitcnt lgkmcnt(0)" ::: "memory");
    const int c = lane & 7;
    f32x4 k0v = (f32x4){1.f, 1.f, 1.f, 1.f}, k1v = k0v;
    if (ksc) { k0v = *(const f32x4*)(ksc + k0 + 8 * c); k1v = *(const f32x4*)(ksc + k0 + 8 * c + 4); }
#pragma unroll
    for (int j = 0; j < 4; ++j) { const int n = (lane >> 3) + 8 * j; const LAS float* s = scr + (8 * c) * 33 + n;
        u32x4 o; o.x = cvt_pk_bf16(s[0 * 33] * k0v[0], s[1 * 33] * k0v[1]); o.y = cvt_pk_bf16(s[2 * 33] * k0v[2], s[3 * 33] * k0v[3]); o.z = cvt_pk_bf16(s[4 * 33] * k1v[0], s[5 * 33] * k1v[1]); o.w = cvt_pk_bf16(s[6 * 33] * k1v[2], s[7 * 33] * k1v[3]);
        *(u32x4*)(WT + (size_t)(np0 + n) * K + k0 + 8 * c) = o; }
    asm volatile("s_waitcnt lgkmcnt(0)" ::: "memory");
}

__device__ __forceinline__ int lnd_i(int v) { asm volatile("" : "+s"(v)); return v; }
template <class P> __device__ __forceinline__ P* lnd_p(P* p) { asm volatile("" : "+s"(p)); return p; }
#define PHASE_LOCALS const int wave = lnd_i(wave0); int lane_ = (int)__builtin_amdgcn_mbcnt_hi(~0u, __builtin_amdgcn_mbcnt_lo(~0u, 0u)); asm volatile("" : "+v"(lane_)); const int lane = lane_, tid = wave * 64 + lane, fr = lane & 15, fq = lane >> 4; (void)fr; (void)fq; (void)wave; const int G = lnd_i(G0), bid = lnd_i(bid0); unsigned char* ws = lnd_p(args.ws); float* out = lnd_p(args.out); (void)G; (void)bid; (void)ws; (void)out;
struct Args { const float* in[20]; float* out; unsigned char* ws; int ph_lo, ph_hi; };
__device__ __forceinline__ int opq(int i) { int r; asm volatile("s_mov_b32 %0, %1" : "=s"(r) : "i"(i)); return r; }
enum { I_X = 0, I_P, I_POS, I_NMIX, I_WIN, I_GNW, I_CPOS, I_KW1, I_KW2, I_VW1, I_VW2, I_WOUT, I_NFFN, I_WUP, I_CONVW, I_CONVB, I_WDN, I_PLEW, I_PLEG, I_FNW };

constexpr int RS = 144;
__device__ __forceinline__ void attn_tile(const int MODE, const LAS unsigned char* Kl, const LAS unsigned char* Vl, const bf16x8 (&Qf)[2][2],
                                          float (&mx)[2], f32x4 (&ls)[2], f32x4 (&O)[2][4], int fr, int fq, int toff, const bool (&rsel)[2]) {
    const bf16x8 ones8 = {0x3f80, 0x3f80, 0x3f80, 0x3f80, 0x3f80, 0x3f80, 0x3f80, 0x3f80};
    f32x4 S[2][4];
#pragma unroll
    for (int qg = 0; qg < 2; ++qg) {
        const float ci = (MODE == 0 && !rsel[qg]) ? -INFINITY : -mx[qg];
#pragma unroll
        for (int kt = 0; kt < 4; ++kt) S[qg][kt] = (f32x4){ci, ci, ci, ci};
    }
    const LAS unsigned char* kb = Kl + fr * RS + fq * 16;
#pragma unroll
    for (int ks = 0; ks < 2; ++ks) {
        bf16x8 kf[4];
#pragma unroll
        for (int kt = 0; kt < 4; ++kt) kf[kt] = *(const LAS bf16x8*)(kb + kt * 16 * RS + ks * 64);
        __builtin_amdgcn_sched_barrier(0);
#pragma unroll
        for (int kt = 0; kt < 4; ++kt) { S[0][kt] = mfma16(kf[kt], Qf[0][ks], S[0][kt]); S[1][kt] = mfma16(kf[kt], Qf[1][ks], S[1][kt]); }
    }
    const LAS unsigned char* vb = Vl + (4 * fq + (fr >> 2)) * RS + (fr & 3) * 8;
    bf16x8 Pf[2][2];
#pragma unroll
    for (int qg = 0; qg < 2; ++qg) {
        const int to = toff + 4 * qg;
        float rm = -INFINITY;
        if (MODE != 0) {
#pragma unroll
            for (int kt = 0; kt < 4; ++kt)
#pragma unroll
                for (int e = 0; e < 4; ++e) { const int ko = 16 * kt + 4 * fq + e; const bool ok = (MODE == 1) ? (ko <= to) : (ko > to); S[qg][kt][e] = ok ? S[qg][kt][e] : -INFINITY; }
        }
#pragma unroll
        for (int kt = 0; kt < 4; ++kt)
#pragma unroll
            for (int e = 0; e < 4; ++e) rm = fmaxf(rm, S[qg][kt][e]);
        rm = rows_max(rm);
        const bool was = __float_as_uint(mx[qg]) != 0x80000000u;
        const bool need = was ? (rm > 8.f) : (rm > -INFINITY);
        if (__builtin_amdgcn_ballot_w64(need) != 0ull) {
            const float delta = need ? rm : 0.f, f = (need && was) ? fexp2(-delta) : 1.f;
            mx[qg] += delta;
            ls[qg] = ls[qg] * f;
#pragma unroll
            for (int dt = 0; dt < 4; ++dt) O[qg][dt] = O[qg][dt] * f;
#pragma unroll
            for (int kt = 0; kt < 4; ++kt) S[qg][kt] = S[qg][kt] - delta;
        }
#pragma unroll
        for (int kt = 0; kt < 4; ++kt)
#pragma unroll
            for (int e = 0; e < 4; ++e) S[qg][kt][e] = fexp2(S[qg][kt][e]);
        Pf[qg][0] = pack8(S[qg][0], S[qg][1]); Pf[qg][1] = pack8(S[qg][2], S[qg][3]);
    }
#pragma unroll
    for (int kk = 0; kk < 2; ++kk) {
        bf16x8 vf[4];
#pragma unroll
        for (int dt = 0; dt < 4; ++dt) vf[dt] = cat8(trrd(vb + (32 * kk) * RS + dt * 32), trrd(vb + (32 * kk + 16) * RS + dt * 32));
        __builtin_amdgcn_sched_barrier(0);
#pragma unroll
        for (int dt = 0; dt < 4; ++dt) { O[0][dt] = mfma16(vf[dt], Pf[0][kk], O[0][dt]); O[1][dt] = mfma16(vf[dt], Pf[1][kk], O[1][dt]); }
        ls[0] = mfma16(ones8, Pf[0][kk], ls[0]); ls[1] = mfma16(ones8, Pf[1][kk], ls[1]);
    }
}

__device__ __forceinline__ void attn_branch(LAS unsigned char* lds, const bf16_t* Kg, const bf16_t* Vg, unsigned long long tmask, int qb, int is_win,
                                            const bf16x8 (&Qf)[2][2], const unsigned long long (&selm)[2], int fr, int fq, int toff, float gate0, float gate1, f32x4 (&acc_o)[2][4], const int tid) {
    const int lrow = tid >> 3, lch = tid & 7;
    float mx[2] = {-0.f, -0.f}; f32x4 ls[2] = {(f32x4){0.f, 0.f, 0.f, 0.f}, (f32x4){0.f, 0.f, 0.f, 0.f}}; f32x4 O[2][4];
#pragma unroll
    for (int qg = 0; qg < 2; ++qg)
#pragma unroll
        for (int dt = 0; dt < 4; ++dt) O[qg][dt] = (f32x4){0.f, 0.f, 0.f, 0.f};
    int j = __builtin_ctzll(tmask); tmask &= tmask - 1;
    int cur = 0;
    {
        const u32x4 kv = *(const u32x4*)(Kg + ((size_t)(64 * j + lrow)) * 64 + lch * 8), vv = *(const u32x4*)(Vg + ((size_t)(64 * j + lrow)) * 64 + lch * 8);
        *(LAS u32x4*)(lds + lrow * RS + lch * 16) = kv; *(LAS u32x4*)(lds + 9216 + lrow * RS + lch * 16) = vv;
    }
    __syncthreads();
    for (;;) {
        const bool more = tmask != 0ull; int jn = 0; u32x4 kv, vv;
        if (more) { jn = __builtin_ctzll(tmask); tmask &= tmask - 1;
            kv = *(const u32x4*)(Kg + ((size_t)(64 * jn + lrow)) * 64 + lch * 8); vv = *(const u32x4*)(Vg + ((size_t)(64 * jn + lrow)) * 64 + lch * 8); }
        bool rsel[2] = {true, true};
        const LAS unsigned char* Kl = lds + cur * 18432; const LAS unsigned char* Vl = Kl + 9216;
        int mode = 0;
        if (j == qb) mode = 1;
        else if (is_win) { if (j == qb - 8) mode = 2; }
        else { rsel[0] = (selm[0] >> j) & 1ull; rsel[1] = (selm[1] >> j) & 1ull; }
        attn_tile(mode, Kl, Vl, Qf, mx, ls, O, fr, fq, toff, rsel);
        if (!more) break;
        cur ^= 1;
        *(LAS u32x4*)(lds + cur * 18432 + lrow * RS + lch * 16) = kv; *(LAS u32x4*)(lds + cur * 18432 + 9216 + lrow * RS + lch * 16) = vv;
        __syncthreads();
        j = jn;
    }
    __syncthreads();
#pragma unroll
    for (int qg = 0; qg < 2; ++qg) {
        const float l = ls[qg][0];
        const float sc = (qg ? gate1 : gate0) * (l > 0.f ? frcp(l) : 0.f);
#pragma unroll
        for (int dt = 0; dt < 4; ++dt) acc_o[qg][dt] = acc_o[qg][dt] + O[qg][dt] * sc;
    }
}

#define XB_TMO      128
#define XB_XCNT(j)  (256  + 64 * (j))
#define XB_XSUB(j)  (1280 + 64 * (j))
#define XB_XGEN(j)  (2304 + 64 * (j))
#define XB_TOP      3328
#define XB_TOPGEN   3392
#define XCD_BAR_WORDS 3456
#define XB_SPIN_CAP (1u << 22)
__device__ __forceinline__ unsigned xb_ld(unsigned* p)              { return __hip_atomic_load(p, __ATOMIC_RELAXED, __HIP_MEMORY_SCOPE_AGENT); }
__device__ __forceinline__ unsigned xb_add(unsigned* p, unsigned v) { return __hip_atomic_fetch_add(p, v, __ATOMIC_RELAXED, __HIP_MEMORY_SCOPE_AGENT); }
__device__ __forceinline__ unsigned xb_xcc_id() { return (unsigned)__builtin_amdgcn_s_getreg((3 << 11) | 20) & 0xFu; }
#define XB_SPIN(cond, bar) do { unsigned _sp = 0; while (cond) { __builtin_amdgcn_s_sleep(1); \
    if ((++_sp & 255u) == 0u) { if (xb_ld(&(bar)[XB_TMO])) break; if (_sp > XB_SPIN_CAP) { atomicAdd(&(bar)[XB_TMO], 1u); break; } } } } while (0)
__device__ __forceinline__ void xcd_barrier_complete(unsigned* bar, unsigned x, unsigned G, unsigned& nloc, unsigned& nx) {
    unsigned sum, cnt, mine, sp = 0u;
    for (;;) {
        sum = 0u; cnt = 0u; mine = 0u;
#pragma unroll
        for (unsigned j = 0; j < 16; ++j) { const unsigned c = xb_ld(&bar[XB_XCNT(j)]); sum += c; cnt += (c > 0u) ? 1u : 0u; mine = (j == x) ? c : mine; }
        if (sum == G) break;
        __builtin_amdgcn_s_sleep(1);
        if ((++sp & 255u) == 0u) { if (xb_ld(&bar[XB_TMO])) break; if (sp > XB_SPIN_CAP) { atomicAdd(&bar[XB_TMO], 1u); break; } }
    }
    nloc = mine > 0u ? mine : 1u; nx = cnt > 0u ? cnt : 1u;
}
__device__ __forceinline__ void xcd_barrier(unsigned* bar, unsigned x, volatile LAS unsigned* st, unsigned G, bool is_leader) {
    asm volatile("s_waitcnt vmcnt(0)" ::: "memory");
    __syncthreads();
    if (is_leader) {
        __builtin_amdgcn_s_waitcnt(0);
        unsigned nloc = st[0], nx = st[1];
        if (nloc == 0u) { xcd_barrier_complete(bar, x, G, nloc, nx); st[0] = nloc; st[1] = nx; }
        const unsigned old = xb_add(&bar[XB_XSUB(x)], 1u);
        const unsigned gen = old / nloc;
        if (old + 1u == (gen + 1u) * nloc) {
            __builtin_amdgcn_fence(__ATOMIC_RELEASE, "agent");
            asm volatile("s_waitcnt vmcnt(0)" ::: "memory");
            const unsigned og = xb_add(&bar[XB_TOP], 1u);
            const unsigned tg = og / nx;
            if (og + 1u == (tg + 1u) * nx) xb_add(&bar[XB_TOPGEN], 1u);
            else XB_SPIN(xb_ld(&bar[XB_TOPGEN]) == tg, bar);
            __builtin_amdgcn_fence(__ATOMIC_ACQUIRE, "agent");
            xb_add(&bar[XB_XGEN(x)], 1u);
            asm volatile("s_waitcnt vmcnt(0)" ::: "memory");
        } else {
            XB_SPIN(xb_ld(&bar[XB_XGEN(x)]) == gen, bar);
            __builtin_amdgcn_fence(__ATOMIC_ACQUIRE, "agent");
            asm volatile("s_waitcnt vmcnt(0)" ::: "memory");
        }
    }
    __syncthreads();
}

__global__ void __launch_bounds__(NTHR, 2) hymba_fwd(Args args) {
    extern __shared__ __attribute__((aligned(16))) unsigned char lds_raw[];
    LAS unsigned char* lds = (LAS unsigned char*)lds_raw;
    cg::grid_group grid = cg::this_grid();
    const int G0 = gridDim.x, bid0 = blockIdx.x, wave0 = __builtin_amdgcn_readfirstlane((int)threadIdx.x >> 6);
    const int lo = args.ph_lo, hi = args.ph_hi;
#define IN(k) (lo <= (k) && (k) < hi)
    unsigned* const barw = (unsigned*)(args.ws + WS_BAR);
    volatile LAS unsigned* const xst = (volatile LAS unsigned*)(lds + 147200);
    const bool xlead = (wave0 == 0) && (__builtin_amdgcn_mbcnt_hi(~0u, __builtin_amdgcn_mbcnt_lo(~0u, 0u)) == 0u);
    const unsigned xcc = xb_xcc_id();
    if (hi - lo > 1) { if (xlead) { xst[0] = 0u; xst[1] = 0u; (void)xb_add(&barw[XB_XCNT(xcc)], 1u); } __syncthreads(); }
#define SEAM(k) do { if (IN(k) && IN((k) + 1)) xcd_barrier(barw, xcc, xst, (unsigned)G0, xlead); } while (0)
    if (lo < 0) grid.sync();

    if (IN(0)) {
        PHASE_LOCALS
        for (int rep = ((REP_MASK >> 0) & 1); rep >= 0; --rep) {
        LAS float* scr = (LAS float*)(lds + wave * 16384);
        const int gw = bid * 8 + wave, NGW = G * 8;
        constexpr int I0 = 16 * (INP / 32), I1 = 16 * 32, I2 = 16 * (2 * DFF / 32), I3 = (DFF / 64) * 32, I4 = 16 * 32, I5 = 4 * 32, I6 = 32 * 8, I7 = 32 * 8, I8 = 4 * 2, I9 = 4 * 2;
        constexpr int NIT = I0 + I1 + I2 + I3 + I4 + I5 + I6 + I7 + I8 + I9;
        for (int r0_ = (P0_REP & 1); r0_ >= 0; --r0_)
        for (int it = gw; it < NIT; it += NGW) {
            int r = it;
            if (r < I0) { const int nblk = INP / 32, kb = r / nblk, nb = r % nblk, np0 = nb * 32, tile = np0 >> 8, p = np0 & 255;
                const int src = tile < 13 ? tile * 256 + 64 * ((p >> 5) & 3) + 32 * (p >> 7) : 3328 + p;
                tr_item(args.in[opq(I_WIN)], DM, INW, (bf16_t*)(ws + WS_WIN), scr, kb * 64, np0, src, lane, args.in[opq(I_NMIX)]); continue; } r -= I0;
            if (r < I1) { tr_item(args.in[opq(I_WOUT)], DM, DM, (bf16_t*)(ws + WS_WOUT), scr, (r / 32) * 64, (r % 32) * 32, (r % 32) * 32, lane); continue; } r -= I1;
            if (r < I2) { const int nblk = 2 * DFF / 32, kb = r / nblk, nb = r % nblk, np0 = nb * 32, tile = np0 >> 8, p = np0 & 255;
                const int src = (p >> 7) * DFF + tile * 128 + (p & 127);
                tr_item(args.in[opq(I_WUP)], DM, 2 * DFF, (bf16_t*)(ws + WS_WUP), scr, kb * 64, np0, src, lane, args.in[opq(I_NFFN)]); continue; } r -= I2;
            if (r < I3) { tr_item(args.in[opq(I_WDN)], DFF, DM, (bf16_t*)(ws + WS_WDN), scr, (r / 32) * 64, (r % 32) * 32, (r % 32) * 32, lane); continue; } r -= I3;
            if (r < I4) { tr_item(args.in[opq(I_PLEG)], DM, DM, (bf16_t*)(ws + WS_WG), scr, (r / 32) * 64, (r % 32) * 32, (r % 32) * 32, lane); continue; } r -= I4;
            if (r < I5) { tr_item(args.in[opq(I_PLEW)], PLE, DM, (bf16_t*)(ws + WS_WP), scr, (r / 32) * 64, (r % 32) * 32, (r % 32) * 32, lane); continue; } r -= I5;
            if (r < I6) { tr_item(args.in[opq(I_KW1)], 2048, 256, (bf16_t*)(ws + WS_W1K), scr, (r / 8) * 64, (r % 8) * 32, (r % 8) * 32, lane); continue; } r -= I6;
            if (r < I7) { tr_item(args.in[opq(I_VW1)], 2048, 256, (bf16_t*)(ws + WS_W1V), scr, (r / 8) * 64, (r % 8) * 32, (r % 8) * 32, lane); continue; } r -= I7;
            if (r < I8) { tr_item(args.in[opq(I_KW2)], 256, 64, (bf16_t*)(ws + WS_W2K), scr, (r / 2) * 64, (r % 2) * 32, (r % 2) * 32, lane); continue; } r -= I8;
            tr_item(args.in[opq(I_VW2)], 256, 64, (bf16_t*)(ws + WS_W2V), scr, (r / 2) * 64, (r % 2) * 32, (r % 2) * 32, lane);
        }
        {
            const float* x = args.in[opq(I_X)]; bf16_t* xs = (bf16_t*)(ws + WS_XS); float* r0 = (float*)(ws + WS_R0);
            for (int r1_ = ((P0_REP >> 1) & 1); r1_ >= 0; --r1_)
            for (int m0 = gw * 4; m0 < T; m0 += NGW * 4) {
                f32x4 v[4][4];
#pragma unroll
                for (int rr = 0; rr < 4; ++rr)
#pragma unroll
                    for (int j = 0; j < 4; ++j) v[rr][j] = *((const f32x4*)(x + (size_t)(m0 + rr) * DM) + lane + 64 * j);
                float s[4];
#pragma unroll
                for (int rr = 0; rr < 4; ++rr) { s[rr] = 0.f;
#pragma unroll
                    for (int j = 0; j < 4; ++j) s[rr] += (v[rr][j][0] * v[rr][j][0] + v[rr][j][1] * v[rr][j][1]) + (v[rr][j][2] * v[rr][j][2] + v[rr][j][3] * v[rr][j][3]); }
#pragma unroll
                for (int o = 1; o < 64; o <<= 1) { s[0] += __shfl_xor(s[0], o); s[1] += __shfl_xor(s[1], o); s[2] += __shfl_xor(s[2], o); s[3] += __shfl_xor(s[3], o); }
                if (lane < 4) r0[m0 + lane] = rsqrtf((lane == 0 ? s[0] : lane == 1 ? s[1] : lane == 2 ? s[2] : s[3]) * (1.f / DM) + EPS);
#pragma unroll
                for (int j = 0; j < 4; ++j) {
#pragma unroll
                    for (int rr = 0; rr < 4; ++rr) *(u32x2*)(xs + (size_t)(m0 + rr) * DM + 4 * lane + 256 * j) = pack4(v[rr][j]); }
            }
        }
        const int gt = bid * NTHR + tid, NGT = G * NTHR;
        { const f32x4* p4 = (const f32x4*)args.in[opq(I_P)]; u32x2* pb = (u32x2*)(ws + WS_PB);
            for (int r2_ = ((P0_REP >> 2) & 1); r2_ >= 0; --r2_)
#pragma unroll 8
            for (int i = gt; i < T * PLE / 4; i += NGT) pb[i] = pack4(p4[i]); }
        { float* z1 = (float*)(ws + WS_SS1); float* z3 = (float*)(ws + WS_SS3); for (int i = gt; i < T; i += NGT) { z1[i] = 0.f; z3[i] = 0.f; } }
        { float* c1p = (float*)(ws + WS_C1P); const float* cp = args.in[opq(I_CPOS)];
            for (int r4_ = ((P0_REP >> 4) & 1); r4_ >= 0; --r4_)
            for (int i = gt; i < 16 * 512; i += NGT) { const int kc = i >> 9, o = i & 511; const float* w1 = ((o >> 8) ? args.in[opq(I_VW1)] : args.in[opq(I_KW1)]); const int n = o & 255; float s = 0.f;
#pragma unroll 32
                for (int k = kc * 128; k < kc * 128 + 128; ++k) s += cp[k] * w1[(size_t)k * 256 + n];
                c1p[i] = s; } }
        if (rep > 0) { asm volatile("s_waitcnt vmcnt(0) lgkmcnt(0)" ::: "memory"); __syncthreads(); }
        }
    }
    SEAM(0);
    for (int xb = 0; xb < XBAR; ++xb) { SEAM(0); }

    if (IN(1)) {
        PHASE_LOCALS
        for (int rep = ((REP_MASK >> 1) & 1); rep >= 0; --rep) {
        if (bid == 0) { const float* c1p = (const float*)(ws + WS_C1P); float s = 0.f; for (int k = 0; k < 16; ++k) s += c1p[k * 512 + tid]; ((float*)(ws + WS_C1))[tid] = s; }
        {
            pg8::Gemm g{(const bf16_t*)(ws + WS_XS), (const bf16_t*)(ws + WS_WIN), T, INP, DM, DM, DM}; pg8::StaticOrder S; S.init(T, INP, G, bid);
            for (int rep4 = ((REP2 >> 2) & 1); rep4 >= 0; --rep4) {
            EpiIn E{(const float*)(ws + WS_R0), (const int*)args.in[opq(I_POS)], ws};
            pg8::gemm_phase(lds, g, S, E, tid); }
        }
        if (rep > 0) { asm volatile("s_waitcnt vmcnt(0) lgkmcnt(0)" ::: "memory"); __syncthreads(); }
        }
    }
    SEAM(1);

    if (IN(2)) {
        PHASE_LOCALS
        for (int rep = ((REP_MASK >> 2) & 1); rep >= 0; --rep) {
        const int ngemm = (G >= 128) ? 64 : 0;
        {
            for (int q = bid; q < 64; q += G) {
                const int kv = q >> 5, ks = (q >> 4) & 1;
                pg8::Gemm g{(const bf16_t*)(ws + (kv ? WS_VC : WS_KC)) + ks * 1024, (const bf16_t*)(ws + (kv ? WS_W1V : WS_W1K)) + ks * 1024, 4096, 256, 1024, 1024, 2048};
                pg8::StaticOrder S; S.init(4096, 256, 16, q & 15);
                EpiF32 E{(float*)(ws + WS_SB) + (size_t)(kv * 2 + ks) * 4096 * 256, 256};
                pg8::gemm_phase(lds, g, S, E, tid);
            }
        }
        if (bid >= ngemm) {
            const bf16_t* RK = (const bf16_t*)(ws + WS_RK); const bf16_t* RV = (const bf16_t*)(ws + WS_RV); float* KV = (float*)(ws + WS_KVST);
            for (int it = bid - ngemm; it < 2048; it += G - ngemm) {
                const int n = it & 31, h = (it >> 5) & 7, b = it >> 8;
                const float lg2 = log1pf(-exp2f(-5.f - (float)h)) * 1.4426950408889634f;
#pragma unroll
                for (int i = 0; i < 2; ++i) {
                    const int ch = tid + i * NTHR, k = ch >> 3, c8 = ch & 7; const size_t src = ((size_t)(b * SEQ + n * 128 + k)) * 512 + h * 64 + c8 * 8;
                    const u32x4 kr = *(const u32x4*)(RK + src), vr = *(const u32x4*)(RV + src);
                    const float dk = fexp2((float)(127 - k) * lg2); u32x4 ko;
                    ko.x = cvt_pk_bf16(__uint_as_float(kr.x << 16) * dk, __uint_as_float(kr.x & 0xffff0000u) * dk); ko.y = cvt_pk_bf16(__uint_as_float(kr.y << 16) * dk, __uint_as_float(kr.y & 0xffff0000u) * dk);
                    ko.z = cvt_pk_bf16(__uint_as_float(kr.z << 16) * dk, __uint_as_float(kr.z & 0xffff0000u) * dk); ko.w = cvt_pk_bf16(__uint_as_float(kr.w << 16) * dk, __uint_as_float(kr.w & 0xffff0000u) * dk);
                    *(LAS u32x4*)(lds + k * RS + c8 * 16) = ko; *(LAS u32x4*)(lds + 18432 + k * RS + c8 * 16) = vr;
                }
                __syncthreads();
                const LAS unsigned char* tb = lds + (4 * fq + (fr >> 2)) * RS + (fr & 3) * 8;
#pragma unroll
                for (int tt = 0; tt < 2; ++tt) {
                    const int et = (2 * wave + tt) >> 2, dt = (2 * wave + tt) & 3; f32x4 a = (f32x4){0.f, 0.f, 0.f, 0.f};
#pragma unroll
                    for (int kk = 0; kk < 4; ++kk) {
                        const bf16x8 af = cat8(trrd(tb + 18432 + (32 * kk) * RS + et * 32), trrd(tb + 18432 + (32 * kk + 16) * RS + et * 32));
                        const bf16x8 bf = cat8(trrd(tb + (32 * kk) * RS + dt * 32), trrd(tb + (32 * kk + 16) * RS + dt * 32));
                        a = mfma16(af, bf, a);
                    }
                    float* dst = KV + (size_t)it * 4096 + (16 * et + 4 * fq) * 64 + 16 * dt + fr;
                    dst[0] = a[0]; dst[64] = a[1]; dst[128] = a[2]; dst[192] = a[3];
                }
                __syncthreads();
            }
        }
        if (rep > 0) { asm volatile("s_waitcnt vmcnt(0) lgkmcnt(0)" ::: "memory"); __syncthreads(); }
        }
    }
    SEAM(2);

    if (IN(3)) {
        PHASE_LOCALS
        for (int rep = ((REP_MASK >> 3) & 1); rep >= 0; --rep) {
        for (int it = bid * 8 + wave; it < 512; it += G * 8) {
            const int kv = it >> 8, r0 = (it & 255) * 16;
            const bf16_t* w2 = (const bf16_t*)(ws + (kv ? WS_W2V : WS_W2K)); bf16_t* o = (bf16_t*)(ws + (kv ? WS_CV : WS_CK));
            f32x4 a[4];
#pragma unroll
            for (int nt = 0; nt < 4; ++nt) a[nt] = (f32x4){0.f, 0.f, 0.f, 0.f};
#pragma unroll 2
            for (int ks = 0; ks < 8; ++ks) {
                bf16x8 hf;
                { const float* p0 = (const float*)(ws + WS_SB) + ((size_t)(kv * 2) * 4096 + r0 + fr) * 256 + 32 * ks + 8 * fq; const float* p1 = p0 + (size_t)4096 * 256;
                  const float* cb = (const float*)(ws + WS_C1) + kv * 256 + 32 * ks + 8 * fq;
                  f32x4 a0 = *(const f32x4*)p0 + *(const f32x4*)p1 + *(const f32x4*)cb, a1 = *(const f32x4*)(p0 + 4) + *(const f32x4*)(p1 + 4) + *(const f32x4*)(cb + 4);
#pragma unroll
                  for (int e = 0; e < 4; ++e) { a0[e] = gelu_tanh(a0[e]); a1[e] = gelu_tanh(a1[e]); }
                  hf = pack8(a0, a1); }
#pragma unroll
                for (int nt = 0; nt < 4; ++nt) { const bf16x8 wf = *(const bf16x8*)(w2 + (size_t)(16 * nt + fr) * 256 + 32 * ks + 8 * fq); a[nt] = mfma16(wf, hf, a[nt]); }
            }
#pragma unroll
            for (int nt = 0; nt < 4; ++nt) *(u32x2*)(o + (size_t)(r0 + fr) * 64 + 16 * nt + 4 * fq) = pack4(a[nt]);
        }
        float* KV = (float*)(ws + WS_KVST);
        for (int i = bid * NTHR + tid; i < 64 * 4096; i += G * NTHR) {
            const int bh = i >> 12, el = i & 4095, h = bh & 7;
            const float cd = fexp2(128.f * log1pf(-exp2f(-5.f - (float)h)) * 1.4426950408889634f);
            float* p = KV + (size_t)bh * 32 * 4096 + el; float s = 0.f;
#pragma unroll
            for (int n0 = 0; n0 < 32; n0 += 8) { float t[8];
#pragma unroll
                for (int n = 0; n < 8; ++n) t[n] = p[(size_t)(n0 + n) * 4096];
#pragma unroll
                for (int n = 0; n < 8; ++n) { p[(size_t)(n0 + n) * 4096] = s; s = s * cd + t[n]; } }
        }
        {
            pg8::Gemm g{(const bf16_t*)(ws + WS_PB), (const bf16_t*)(ws + WS_WP), T, DM, PLE, PLE, PLE}; pg8::StaticOrder S; S.init(T, DM, G, bid);
            EpiBf16<0> E{(bf16_t*)(ws + WS_PE), DM, nullptr};
            pg8::gemm_phase(lds, g, S, E, tid);
        }
        if (rep > 0) { asm volatile("s_waitcnt vmcnt(0) lgkmcnt(0)" ::: "memory"); __syncthreads(); }
        }
    }
    SEAM(3);

    if (IN(4)) {
        PHASE_LOCALS
        for (int rep = ((REP_MASK >> 4) & 1); rep >= 0; --rep) {
        bf16_t* MIX = (bf16_t*)out + (size_t)T * DM;
        LAS unsigned char* CKl = lds + 36864; LAS unsigned char* CVl = lds + 73728; LAS float* IMP = (LAS float*)(lds + 110592);
        LAS unsigned long long* SELM = (LAS unsigned long long*)(lds + 127232); LAS unsigned long long* UNI = (LAS unsigned long long*)(lds + 127744);
        const bf16_t* NQ = (const bf16_t*)(ws + WS_NQ); const float* NG = (const float*)(ws + WS_NG);
#ifndef DBG_SKIP
#define DBG_SKIP 0
#endif
        for (int rep2 = (REP2 & 1); rep2 >= 0; --rep2)
        for (int it = bid; it < ((DBG_SKIP & 1) ? 0 : 1024); it += G) {
            const int vb_ = it & 255, v = (G == 256) ? ((vb_ & 7) * 32 + (vb_ >> 3)) : vb_, kq = it >> 8, bg = v >> 4, s16 = v & 15;
            const int qb = (kq == 0) ? s16 : (kq == 1) ? 31 - s16 : (kq == 2) ? 32 + s16 : 63 - s16;
            const int b = bg >> 1, g = bg & 1;
            const int hr = fr >> 2, toff = 8 * wave + (fr & 3);
            const int head = g * 4 + hr;
            bf16x8 Qf[2][2]; float gate[2][3]; f32x4 acc_o[2][4];
#pragma unroll
            for (int qg = 0; qg < 2; ++qg) {
                const size_t row = (size_t)b * SEQ + 64 * qb + toff + 4 * qg;
#pragma unroll
                for (int ks = 0; ks < 2; ++ks) Qf[qg][ks] = *(const bf16x8*)(NQ + row * 512 + head * 64 + 32 * ks + 8 * fq);
#pragma unroll
                for (int br = 0; br < 3; ++br) gate[qg][br] = NG[row * 24 + head * 3 + br];
#pragma unroll
                for (int dt = 0; dt < 4; ++dt) acc_o[qg][dt] = (f32x4){0.f, 0.f, 0.f, 0.f};
                if (DBG_SKIP & 16) { gate[qg][0] = 1.f; gate[qg][1] = 1.f; gate[qg][2] = 1.f; }
                if (DBG_SKIP & 32) { const bf16x8 cq = {0x3c00, 0x3c80, 0x3d00, 0x3c00, 0x3d80, 0x3c00, 0x3c80, 0x3d00}; Qf[qg][0] = cq; Qf[qg][1] = cq; }
            }
            for (int nrep = (NSA_REP & 1); nrep >= 0; --nrep) {
            float zf = 0.f; asm volatile("" : "+v"(zf));
            const int ncv = (4 * qb + 3 < 255) ? 4 * qb + 3 : 255, NT2 = (ncv + 31) >> 5;
            {
                const bf16_t* ckg = (const bf16_t*)(ws + WS_CK) + (size_t)bg * 256 * 64; const bf16_t* cvg = (const bf16_t*)(ws + WS_CV) + (size_t)bg * 256 * 64;
                int ch0_ = tid; asm volatile("" : "+v"(ch0_));
                for (int ch = ch0_; ch < NT2 * 32 * 8; ch += NTHR) { const int r = ch >> 3, c8 = ch & 7;
                    u32x4 a_ = *(const u32x4*)(ckg + r * 64 + c8 * 8), b_ = *(const u32x4*)(cvg + r * 64 + c8 * 8);
                    if (DBG_SKIP & 128) { a_ = *(const u32x4*)((const bf16_t*)(ws + WS_HIDK) + ((size_t)bg * 256 + r) * 256 + c8 * 8); b_ = *(const u32x4*)((const bf16_t*)(ws + WS_HIDV) + ((size_t)bg * 256 + r) * 256 + c8 * 8); }
                    if (DBG_SKIP & 64) { const unsigned pz = 0x3c003c00u + ((unsigned)((r * 7 + c8 * 3) & 63) << 16) + (unsigned)((r * 5 + c8) & 31); a_ = (u32x4){pz, pz + 1u, pz + 2u, pz + 3u}; b_ = (u32x4){pz + 4u, pz + 5u, pz + 6u, pz + 7u}; }
                    *(LAS u32x4*)(CKl + r * RS + c8 * 16) = a_; *(LAS u32x4*)(CVl + r * RS + c8 * 16) = b_; }
            }
            __syncthreads();
            float cm[2] = {-1e30f, -1e30f}, cl[2] = {0.f, 0.f};
            const LAS unsigned char* kb = CKl + fr * RS + fq * 16;
            for (int kt = 0; kt < 2 * NT2; ++kt) {
                f32x4 S[2] = {(f32x4){0.f, 0.f, 0.f, 0.f}, (f32x4){0.f, 0.f, 0.f, 0.f}};
#pragma unroll
                for (int ks = 0; ks < 2; ++ks) { const bf16x8 kf = *(const LAS bf16x8*)(kb + kt * 16 * RS + ks * 64); S[0] = mfma16(kf, Qf[0][ks], S[0]); S[1] = mfma16(kf, Qf[1][ks], S[1]); }
#pragma unroll
                for (int qg = 0; qg < 2; ++qg) {
                    const int tq = 64 * qb + toff + 4 * qg; float rm = -INFINITY;
#pragma unroll
                    for (int e = 0; e < 4; ++e) { const int n = 16 * kt + 4 * fq + e; const float vv = (16 * n + 31 <= tq) ? S[qg][e] : -INFINITY; S[qg][e] = vv; rm = fmaxf(rm, vv); }
                    rm = rows_max(rm);
                    const float mn = fmaxf(cm[qg], rm); float sum = 0.f;
#pragma unroll
                    for (int e = 0; e < 4; ++e) sum += fexp2(S[qg][e] - mn);
                    cl[qg] = cl[qg] * fexp2(cm[qg] - mn) + sum; cm[qg] = mn;
                }
            }
            float cinv[2];
#pragma unroll
            for (int qg = 0; qg < 2; ++qg) { float l = cl[qg]; l = rows_sum(l); cinv[qg] = l > 0.f ? frcp(l) : 0.f; }
            {
                f32x4 O[2][4];
#pragma unroll
                for (int qg = 0; qg < 2; ++qg)
#pragma unroll
                    for (int dt = 0; dt < 4; ++dt) O[qg][dt] = (f32x4){0.f, 0.f, 0.f, 0.f};
                float carry[2] = {0.f, 0.f};
                const LAS unsigned char* vb = CVl + (4 * fq + (fr >> 2)) * RS + (fr & 3) * 8;
                for (int k2 = 0; k2 < NT2; ++k2) {
                    f32x4 S[2][2];
#pragma unroll
                    for (int qg = 0; qg < 2; ++qg) { S[qg][0] = (f32x4){0.f, 0.f, 0.f, 0.f}; S[qg][1] = (f32x4){0.f, 0.f, 0.f, 0.f}; }
#pragma unroll
                    for (int ks = 0; ks < 2; ++ks)
#pragma unroll
                        for (int t2 = 0; t2 < 2; ++t2) { const bf16x8 kf = *(const LAS bf16x8*)(kb + (2 * k2 + t2) * 16 * RS + ks * 64); S[0][t2] = mfma16(kf, Qf[0][ks], S[0][t2]); S[1][t2] = mfma16(kf, Qf[1][ks], S[1][t2]); }
                    bf16x8 Pf[2];
#pragma unroll
                    for (int qg = 0; qg < 2; ++qg) {
                        const int tq = 64 * qb + toff + 4 * qg;
#pragma unroll
                        for (int t2 = 0; t2 < 2; ++t2) {
                            const int kt = 2 * k2 + t2; float gs = 0.f;
#pragma unroll
                            for (int e = 0; e < 4; ++e) { const int n = 16 * kt + 4 * fq + e; const float p = (16 * n + 31 <= tq) ? fexp2(S[qg][t2][e] - cm[qg]) * cinv[qg] : 0.f; S[qg][t2][e] = p; gs += p; }
                            const float tsh = __shfl(S[qg][t2][3], (lane + 48) & 63);
                            float iv = gs + (fq == 0 ? carry[qg] : tsh); carry[qg] = tsh;
                            iv += __shfl_xor(iv, 4); iv += __shfl_xor(iv, 8);
                            if (hr == 0) IMP[(toff + 4 * qg) * 65 + 4 * kt + fq] = iv;
                        }
                        Pf[qg] = pack8(S[qg][0], S[qg][1]);
                    }
#pragma unroll
                    for (int dt = 0; dt < 4; ++dt) {
                        const bf16x8 vf = cat8(trrd(vb + (32 * k2) * RS + dt * 32), trrd(vb + (32 * k2 + 16) * RS + dt * 32));
                        O[0][dt] = mfma16(vf, Pf[0], O[0][dt]); O[1][dt] = mfma16(vf, Pf[1], O[1][dt]);
                    }
                }
#pragma unroll
                for (int qg = 0; qg < 2; ++qg)
#pragma unroll
                    for (int dt = 0; dt < 4; ++dt) acc_o[qg][dt] = acc_o[qg][dt] + O[qg][dt] * (nrep > 0 ? zf : gate[qg][0]);
            }
            __syncthreads();
            {
                const int tok = tid >> 3, sub = tid & 7; unsigned long long bits = 0ull;
                if (qb >= 16) {
                    for (int j = 1 + sub; j <= qb - 2; j += 8) {
                        const float vj = IMP[tok * 65 + j]; int rank = 0;
                        for (int jj = 1; jj <= qb - 2; ++jj) { const float uu = IMP[tok * 65 + jj]; rank += (uu > vj || (uu == vj && jj < j)) ? 1 : 0; }
                        if (rank < 13) bits |= 1ull << j;
                    }
                    unsigned blo = (unsigned)bits, bhi = (unsigned)(bits >> 32);
                    blo |= __shfl_xor(blo, 1); bhi |= __shfl_xor(bhi, 1); blo |= __shfl_xor(blo, 2); bhi |= __shfl_xor(bhi, 2); blo |= __shfl_xor(blo, 4); bhi |= __shfl_xor(bhi, 4);
                    bits = ((unsigned long long)bhi << 32) | blo;
                    bits |= 1ull | (1ull << qb) | (1ull << (qb - 1));
                } else bits = (2ull << qb) - 1ull;
                if (sub == 0) SELM[tok] = bits;
                __syncthreads();
                if (tid < 64) {
                    unsigned long long u = SELM[tid]; unsigned ulo = (unsigned)u, uhi = (unsigned)(u >> 32);
#pragma unroll
                    for (int o = 1; o < 64; o <<= 1) { ulo |= __shfl_xor(ulo, o); uhi |= __shfl_xor(uhi, o); }
                    if (tid == 0) UNI[0] = ((unsigned long long)uhi << 32) | ulo;
                }
                __syncthreads();
            }
            }
            unsigned long long selm[2] = {SELM[toff], SELM[toff + 4]};
            unsigned long long umask = UNI[0];
            { const unsigned ulo = __builtin_amdgcn_readfirstlane((unsigned)umask), uhi = __builtin_amdgcn_readfirstlane((unsigned)(umask >> 32)); umask = ((unsigned long long)uhi << 32) | ulo; }
            for (int nrep = ((NSA_REP >> 1) & 1); nrep >= 0; --nrep) { float zf = 0.f; asm volatile("" : "+v"(zf));
            if (!(DBG_SKIP & 4)) attn_branch(lds, (const bf16_t*)(ws + WS_KS) + (size_t)bg * SEQ * 64, (const bf16_t*)(ws + WS_VS) + (size_t)bg * SEQ * 64, umask, qb, 0, Qf, selm, fr, fq, toff, nrep > 0 ? zf : gate[0][1], nrep > 0 ? zf : gate[1][1], acc_o, tid); }
            { const int j0 = qb >= 8 ? qb - 8 : 0; const unsigned long long wm = ((2ull << qb) - 1ull) & ~((1ull << j0) - 1ull);
              for (int nrep = ((NSA_REP >> 2) & 1); nrep >= 0; --nrep) { float zf = 0.f; asm volatile("" : "+v"(zf));
              if (!(DBG_SKIP & 8)) attn_branch(lds, (const bf16_t*)(ws + WS_KW) + (size_t)bg * SEQ * 64, (const bf16_t*)(ws + WS_VW) + (size_t)bg * SEQ * 64, wm, qb, 1, Qf, selm, fr, fq, toff, nrep > 0 ? zf : gate[0][2], nrep > 0 ? zf : gate[1][2], acc_o, tid); } }
#pragma unroll
            for (int qg = 0; qg < 2; ++qg) {
                const size_t row = (size_t)b * SEQ + 64 * qb + toff + 4 * qg;
#pragma unroll
                for (int dt = 0; dt < 4; ++dt) *(u32x2*)(MIX + row * DM + 512 + head * 64 + 16 * dt + 4 * fq) = pack4(acc_o[qg][dt]);
            }
        }
        {
            int lane2_ = (int)__builtin_amdgcn_mbcnt_hi(~0u, __builtin_amdgcn_mbcnt_lo(~0u, 0u)); asm volatile("" : "+v"(lane2_));
            const int lane = lane2_, tid = wave * 64 + lane, fr = lane & 15, fq = lane >> 4;
            const bf16_t* RQ = (const bf16_t*)(ws + WS_RQ); const bf16_t* RK = (const bf16_t*)(ws + WS_RK); const bf16_t* RV = (const bf16_t*)(ws + WS_RV); const bf16_t* RG = (const bf16_t*)(ws + WS_RG);
            const float* KV = (const float*)(ws + WS_KVST); const float* gnw = args.in[opq(I_GNW)];
            u32x4 pk[2], pv[2]; f32x4 ps0, ps1; bf16x8 pq[2]; u32x2 pg[4];
#define R3_ISSUE(IT) do { const int n_ = (IT) & 31, h_ = ((IT) >> 5) & 7, b_ = (IT) >> 8; \
                _Pragma("unroll") for (int i = 0; i < 2; ++i) { const int ch = tid + i * NTHR, k = ch >> 3, c8 = ch & 7; const size_t src = ((size_t)(b_ * SEQ + n_ * 128 + k)) * 512 + h_ * 64 + c8 * 8; pk[i] = *(const u32x4*)(RK + src); pv[i] = *(const u32x4*)(RV + src); } \
                { const f32x4* sp = (const f32x4*)(KV + (size_t)(IT) * 4096 + (tid >> 3) * 64 + (tid & 7) * 8); ps0 = sp[0]; ps1 = sp[1]; } \
                { const size_t row_ = (size_t)b_ * SEQ + n_ * 128 + 16 * wave + fr; pq[0] = *(const bf16x8*)(RQ + row_ * 512 + h_ * 64 + 8 * fq); pq[1] = *(const bf16x8*)(RQ + row_ * 512 + h_ * 64 + 32 + 8 * fq); \
                  _Pragma("unroll") for (int dt = 0; dt < 4; ++dt) pg[dt] = *(const u32x2*)(RG + row_ * 512 + h_ * 64 + 16 * dt + 4 * fq); } } while (0)
            for (int rep3 = ((REP2 >> 1) & 1); rep3 >= 0; --rep3) {
            const int itend = (DBG_SKIP & 2) ? 0 : 2048;
            if (bid < itend) R3_ISSUE(bid);
            for (int it = bid; it < itend; it += G) {
                const int n = it & 31, h = (it >> 5) & 7, b = it >> 8;
                const float lg2 = log1pf(-exp2f(-5.f - (float)h)) * 1.4426950408889634f;
#pragma unroll
                for (int i = 0; i < 2; ++i) { const int ch = tid + i * NTHR, k = ch >> 3, c8 = ch & 7;
                    *(LAS u32x4*)(lds + k * RS + c8 * 16) = pk[i]; *(LAS u32x4*)(lds + 18432 + k * RS + c8 * 16) = pv[i]; }
                { const int e = tid >> 3, c8 = tid & 7;
                    u32x4 o; o.x = cvt_pk_bf16(ps0[0], ps0[1]); o.y = cvt_pk_bf16(ps0[2], ps0[3]); o.z = cvt_pk_bf16(ps1[0], ps1[1]); o.w = cvt_pk_bf16(ps1[2], ps1[3]);
                    *(LAS u32x4*)(lds + 36864 + e * RS + c8 * 16) = o; }
                bf16x8 Qf[2] = {pq[0], pq[1]}; u32x2 rgv[4] = {pg[0], pg[1], pg[2], pg[3]};
                __syncthreads();
                if (it + G < itend) R3_ISSUE(it + G);
                const int c = 16 * wave + fr; const size_t row = (size_t)b * SEQ + n * 128 + c;
                f32x4 O[4], X[4];
#pragma unroll
                for (int dt = 0; dt < 4; ++dt) { O[dt] = (f32x4){0.f, 0.f, 0.f, 0.f}; X[dt] = (f32x4){0.f, 0.f, 0.f, 0.f}; }
                const LAS unsigned char* kb = lds + fr * RS + fq * 16;
                const LAS unsigned char* vb = lds + 18432 + (4 * fq + (fr >> 2)) * RS + (fr & 3) * 8;
                for (int k2 = 0; k2 <= (wave >> 1); ++k2) {
                    f32x4 S0 = (f32x4){0.f, 0.f, 0.f, 0.f}, S1 = S0;
#pragma unroll
                    for (int ks = 0; ks < 2; ++ks) { S0 = mfma16(*(const LAS bf16x8*)(kb + (32 * k2) * RS + ks * 64), Qf[ks], S0); S1 = mfma16(*(const LAS bf16x8*)(kb + (32 * k2 + 16) * RS + ks * 64), Qf[ks], S1); }
#pragma unroll
                    for (int e = 0; e < 4; ++e) { const int d0 = c - (32 * k2 + 4 * fq + e), d1 = d0 - 16;
                        S0[e] = d0 >= 0 ? S0[e] * fexp2((float)d0 * lg2) : 0.f; S1[e] = d1 >= 0 ? S1[e] * fexp2((float)d1 * lg2) : 0.f; }
                    const bf16x8 pf = pack8(S0, S1);
#pragma unroll
                    for (int dt = 0; dt < 4; ++dt) O[dt] = mfma16(cat8(trrd(vb + (32 * k2) * RS + dt * 32), trrd(vb + (32 * k2 + 16) * RS + dt * 32)), pf, O[dt]);
                }
#pragma unroll
                for (int ks = 0; ks < 2; ++ks)
#pragma unroll
                    for (int dt = 0; dt < 4; ++dt) X[dt] = mfma16(*(const LAS bf16x8*)(lds + 36864 + (16 * dt + fr) * RS + ks * 64 + fq * 16), Qf[ks], X[dt]);
                const float qd = fexp2((float)(c + 1) * lg2);
                float s = 0.f;
#pragma unroll
                for (int dt = 0; dt < 4; ++dt) { O[dt] = O[dt] + X[dt] * qd; s += (O[dt][0] + O[dt][1]) + (O[dt][2] + O[dt][3]); }
                s += __shfl_xor(s, 16); s += __shfl_xor(s, 32);
                const float mu = s * (1.f / 64.f); float q = 0.f;
#pragma unroll
                for (int dt = 0; dt < 4; ++dt) { O[dt] = O[dt] - mu; q += (O[dt][0] * O[dt][0] + O[dt][1] * O[dt][1]) + (O[dt][2] * O[dt][2] + O[dt][3] * O[dt][3]); }
                q += __shfl_xor(q, 16); q += __shfl_xor(q, 32);
                const float rstd = rsqrtf(q * (1.f / 64.f) + EPS);
#pragma unroll
                for (int dt = 0; dt < 4; ++dt) {
                    const int e0 = h * 64 + 16 * dt + 4 * fq; const f32x4 gw = *(const f32x4*)(gnw + e0); const u32x2 rg = rgv[dt];
                    f32x4 o = O[dt] * rstd * gw;
                    o[0] *= __uint_as_float(rg.x << 16); o[1] *= __uint_as_float(rg.x & 0xffff0000u); o[2] *= __uint_as_float(rg.y << 16); o[3] *= __uint_as_float(rg.y & 0xffff0000u);
                    *(u32x2*)(MIX + row * DM + e0) = pack4(o);
                }
                __syncthreads();
            }
            }
#undef R3_ISSUE
        }
        if (rep > 0) { asm volatile("s_waitcnt vmcnt(0) lgkmcnt(0)" ::: "memory"); __syncthreads(); }
        }
    }
    SEAM(4);

    if (IN(5)) {
        PHASE_LOCALS
        for (int rep = ((REP_MASK >> 5) & 1); rep >= 0; --rep) {
        pg8::Gemm g{(const bf16_t*)out + (size_t)T * DM, (const bf16_t*)(ws + WS_WOUT), T, DM, DM, DM, DM}; pg8::StaticOrder S; S.init(T, DM, G, bid);
        EpiOut E{(const bf16_t*)(ws + WS_XS), (bf16_t*)out, (float*)(ws + WS_SS1), rep > 0 ? lnd_i(1) : 0};
        pg8::gemm_phase(lds, g, S, E, tid);
        if (rep > 0) { asm volatile("s_waitcnt vmcnt(0) lgkmcnt(0)" ::: "memory"); __syncthreads(); }
        }
    }
    SEAM(5);

    if (IN(6)) {
        PHASE_LOCALS
        for (int rep = ((REP_MASK >> 6) & 1); rep >= 0; --rep) {
        pg8::Gemm g{(const bf16_t*)out, (const bf16_t*)(ws + WS_WUP), T, 2 * DFF, DM, DM, DM}; pg8::StaticOrder S; S.init(T, 2 * DFF, G, bid);
        EpiUp E{(const float*)(ws + WS_SS1), args.in[opq(I_CONVW)], args.in[opq(I_CONVB)], (bf16_t*)(ws + WS_ACT), (float*)(ws + WS_SB)};
        pg8::gemm_phase(lds, g, S, E, tid);
        if (rep > 0) { asm volatile("s_waitcnt vmcnt(0) lgkmcnt(0)" ::: "memory"); __syncthreads(); }
        }
    }
    SEAM(6);

    if (IN(7)) {
        PHASE_LOCALS
        for (int rep = ((REP_MASK >> 7) & 1); rep >= 0; --rep) {
        const float* sb = (const float*)(ws + WS_SB); const float* cw = args.in[opq(I_CONVW)]; const float* cb = args.in[opq(I_CONVB)]; bf16_t* act = (bf16_t*)(ws + WS_ACT);
        for (int i = bid * NTHR + tid; i < 512 * 2 * DFF; i += G * NTHR) {
            const int c = i % DFF, ur = i / DFF, rr = ur & 1, u = ur >> 1; const bool first = (u & 63) == 0;
            const float* su = sb + (size_t)u * 6 * DFF + c; const float* sp = su - 6 * DFF;
            const float gt = su[rr * DFF], vt = su[(2 + rr) * DFF];
            float g1, g2;
            if (rr == 0) { g1 = first ? 0.f : sp[5 * DFF]; g2 = first ? 0.f : sp[4 * DFF]; } else { g1 = su[0]; g2 = first ? 0.f : sp[5 * DFF]; }
            const float gate = cb[c] + cw[c] * g2 + cw[DFF + c] * g1 + cw[2 * DFF + c] * gt;
            act[(size_t)(64 * u + rr) * DFF + c] = (bf16_t)(cvt_pk_bf16(siluf_(gate) * vt, 0.f) & 0xffffu);
        }
        if (rep > 0) { asm volatile("s_waitcnt vmcnt(0) lgkmcnt(0)" ::: "memory"); __syncthreads(); }
        }
    }
    SEAM(7);

    if (IN(8)) {
        PHASE_LOCALS
        for (int rep = ((REP_MASK >> 8) & 1); rep >= 0; --rep) {
        pg8::Gemm g{(const bf16_t*)(ws + WS_ACT), (const bf16_t*)(ws + WS_WDN), T, DM, DFF, DFF, DFF}; pg8::StaticOrder S; S.init(T, DM, G, bid);
        EpiDown E{(const bf16_t*)out, (bf16_t*)(ws + WS_HS), rep > 0 ? lnd_i(1) : 0};
        pg8::gemm_phase(lds, g, S, E, tid);
        if (rep > 0) { asm volatile("s_waitcnt vmcnt(0) lgkmcnt(0)" ::: "memory"); __syncthreads(); }
        }
    }
    SEAM(8);

    if (IN(9)) {
        PHASE_LOCALS
        for (int rep = ((REP_MASK >> 9) & 1); rep >= 0; --rep) {
        pg8::Gemm g{(const bf16_t*)(ws + WS_HS), (const bf16_t*)(ws + WS_WG), T, DM, DM, DM, DM}; pg8::StaticOrder S; S.init(T, DM, G, bid);
        EpiPle E{(const bf16_t*)(ws + WS_HS), (bf16_t*)(ws + WS_ACT), (const bf16_t*)(ws + WS_PE), (float*)(ws + WS_SS3), rep > 0 ? lnd_i(1) : 0};
        pg8::gemm_phase(lds, g, S, E, tid);
        if (rep > 0) { asm volatile("s_waitcnt vmcnt(0) lgkmcnt(0)" ::: "memory"); __syncthreads(); }
        }
    }
    SEAM(9);

    if (IN(10)) {
        PHASE_LOCALS
        const float* ss = (const float*)(ws + WS_SS3); const f32x4* wf = (const f32x4*)args.in[opq(I_FNW)]; f32x4* o4 = (f32x4*)out;
        const int gw = bid * 8 + wave, NGW = G * 8; const u32x2* h3 = (const u32x2*)(ws + WS_ACT);
        f32x4 wv[4];
#pragma unroll
        for (int j = 0; j < 4; ++j) wv[j] = wf[lane + 64 * j];
        for (int r0_ = gw * 4; r0_ < T; r0_ += NGW * 4) {
            u32x2 hv[4][4]; float rs[4];
#pragma unroll
            for (int rr = 0; rr < 4; ++rr) { rs[rr] = ss[r0_ + rr];
#pragma unroll
                for (int j = 0; j < 4; ++j) hv[rr][j] = h3[(size_t)(r0_ + rr) * 256 + lane + 64 * j]; }
#pragma unroll
            for (int rr = 0; rr < 4; ++rr) { const float sc = rsqrtf(rs[rr] * (1.f / DM) + EPS);
#pragma unroll
                for (int j = 0; j < 4; ++j) { const u32x2 hw = hv[rr][j];
                    o4[(size_t)(r0_ + rr) * 256 + lane + 64 * j] = (f32x4){__uint_as_float(hw.x << 16), __uint_as_float(hw.x & 0xffff0000u), __uint_as_float(hw.y << 16), __uint_as_float(hw.y & 0xffff0000u)} * sc * wv[j]; } }
        }
    }
#undef IN
#undef SEAM
}

extern "C" void kernel_launch(void* const* d_in, const int* in_sizes, int n_in, void* d_out, int out_size, void* d_ws, size_t ws_size, hipStream_t stream) {
    static int grid = 0;
    if (grid == 0) {
        if (n_in != 20 || out_size != T * DM || ws_size < WS_END) { fprintf(stderr, "kernel_launch: unexpected shapes (n_in %d out %d ws %zu)\n", n_in, out_size, ws_size); grid = -1; return; }
        int dev = 0, cus = 0, per_cu = 0;
        hipGetDevice(&dev); hipDeviceGetAttribute(&cus, hipDeviceAttributeMultiprocessorCount, dev);
        hipFuncSetAttribute((const void*)hymba_fwd, hipFuncAttributeMaxDynamicSharedMemorySize, LDS_BYTES);
        hipOccupancyMaxActiveBlocksPerMultiprocessor(&per_cu, (const void*)hymba_fwd, NTHR, LDS_BYTES);
        (void)hipGetLastError();
        if (per_cu < 1) { fprintf(stderr, "kernel_launch: occupancy query says %d blocks/CU\n", per_cu); per_cu = 1; }
        grid = cus;
    }
    if (grid < 0) return;
    Args a{};
    for (int i = 0; i < 20; ++i) a.in[i] = (const float*)d_in[i];
    a.out = (float*)d_out; a.ws = (unsigned char*)d_ws;
    const int NPH = 11;
#if N_LAUNCH_PER_PHASE
    for (int p = 0; p < NPH; ++p) {
        a.ph_lo = p; a.ph_hi = p + 1; void* args[] = {&a};
        hipError_t e = hipLaunchCooperativeKernel((const void*)hymba_fwd, dim3(grid), dim3(NTHR), args, LDS_BYTES, stream);
        if (e != hipSuccess) { fprintf(stderr, "launch %d failed: %s\n", p, hipGetErrorString(e)); break; }
    }
#else
    hipMemsetAsync((char*)d_ws + WS_BAR, 0, 16384, stream);
    a.ph_lo = 0; a.ph_hi = NPH; void* args[] = {&a};
    hipError_t e = hipLaunchCooperativeKernel((const void*)hymba_fwd, dim3(grid), dim3(NTHR), args, LDS_BYTES, stream);
    if (e != hipSuccess) fprintf(stderr, "cooperative launch failed: %s (grid %d)\n", hipGetErrorString(e), grid);
#endif
}
```

```cpp
#include <hip/hip_runtime.h>
#include <hip/hip_cooperative_groups.h>
#include <cstdio>
#include <cstdint>
namespace cg = cooperative_groups;

#ifndef XBAR
#define XBAR 0
#endif
#ifndef REP2
#define REP2 0
#endif
#ifndef NSA_REP
#define NSA_REP 0
#endif
#ifndef P0_REP
#define P0_REP 0
#endif
#ifndef REP_MASK
#define REP_MASK 0
#endif
#ifndef N_LAUNCH_PER_PHASE
#define N_LAUNCH_PER_PHASE 0
#endif

#define LAS __attribute__((address_space(3)))
typedef unsigned short bf16_t;
typedef short bf16x8 __attribute__((ext_vector_type(8)));
typedef short v4s __attribute__((ext_vector_type(4)));
typedef float f32x4 __attribute__((ext_vector_type(4)));
typedef float f32x2 __attribute__((ext_vector_type(2)));
typedef unsigned u32x4 __attribute__((ext_vector_type(4)));
typedef unsigned u32x2 __attribute__((ext_vector_type(2)));

constexpr int NB = 8, SEQ = 4096, DM = 1024, T = NB * SEQ;
constexpr int INW = 3352, INP = 3584;
constexpr int DFF = 2816, PLE = 256;
constexpr float EPS = 1e-6f;
constexpr float QSCALE = 0.125f * 1.4426950408889634f;
constexpr int NTHR = 512;

constexpr size_t MiB = 1u << 20;
constexpr size_t WS_WIN = 0, WS_WOUT = 8 * MiB, WS_WUP = 10 * MiB, WS_WDN = 22 * MiB, WS_WG = 28 * MiB, WS_WP = 30 * MiB;
constexpr size_t WS_W1K = 31 * MiB, WS_W1V = 32 * MiB, WS_W2K = 33 * MiB, WS_W2V = 33 * MiB + 65536;
constexpr size_t WS_C1P = 33 * MiB + 512 * 1024, WS_C1 = 33 * MiB + 768 * 1024;
constexpr size_t WS_COSR = 34 * MiB, WS_SINR = 38 * MiB, WS_COSN = 42 * MiB, WS_SINN = 43 * MiB;
constexpr size_t WS_R0 = 44 * MiB, WS_SS1 = 44 * MiB + 256 * 1024, WS_SS3 = 44 * MiB + 512 * 1024;
constexpr size_t WS_SB = 46 * MiB;
constexpr size_t WS_PE = 80 * MiB;
constexpr size_t WS_XS = 144 * MiB;
constexpr size_t WS_PB = 208 * MiB;
constexpr size_t WS_RQ = 224 * MiB, WS_RK = 256 * MiB, WS_RV = 288 * MiB, WS_RG = 320 * MiB, WS_NQ = 352 * MiB;
constexpr size_t WS_KC = 384 * MiB, WS_VC = 392 * MiB, WS_KS = 400 * MiB, WS_VS = 408 * MiB, WS_KW = 416 * MiB, WS_VW = 424 * MiB;
constexpr size_t WS_NG = 432 * MiB;
constexpr size_t WS_KVST = 436 * MiB;
constexpr size_t WS_HIDK = 468 * MiB, WS_HIDV = 470 * MiB, WS_CK = 472 * MiB, WS_CV = 472 * MiB + 512 * 1024;
constexpr size_t WS_HS = 224 * MiB;
constexpr size_t WS_ACT = 288 * MiB;
constexpr size_t WS_BAR = 474 * MiB;
constexpr size_t WS_END = 475 * MiB;

constexpr int LDS_BYTES = 147456;

typedef __bf16 bf16x2_t __attribute__((ext_vector_type(2)));
__device__ __forceinline__ unsigned cvt_pk_bf16(float lo, float hi) { const f32x2 v = {lo, hi}; const bf16x2_t b = __builtin_convertvector(v, bf16x2_t); return __builtin_bit_cast(unsigned, b); }
__device__ __forceinline__ float bf2f(unsigned short b) { return __uint_as_float(((unsigned)b) << 16); }
__device__ __forceinline__ float fexp2(float x) { return __builtin_amdgcn_exp2f(x); }
__device__ __forceinline__ float frcp(float x) { return __builtin_amdgcn_rcpf(x); }
__device__ __forceinline__ float sigmoidf_(float x) { return frcp(1.f + fexp2(-1.4426950408889634f * x)); }
__device__ __forceinline__ float siluf_(float x) { return x * sigmoidf_(x); }
__device__ __forceinline__ float gelu_tanh(float x) { const float u = 0.7978845608028654f * (x + 0.044715f * x * x * x); const float e = fexp2(2.f * 1.4426950408889634f * u); return 0.5f * x * (2.f - 2.f * frcp(1.f + e)); }
__device__ __forceinline__ v4s trrd(const LAS unsigned char* p) { return __builtin_amdgcn_ds_read_tr16_b64_v4i16((LAS v4s*)p); }
__device__ __forceinline__ bf16x8 cat8(v4s a, v4s b) { return __builtin_shufflevector(a, b, 0, 1, 2, 3, 4, 5, 6, 7); }
__device__ __forceinline__ f32x4 mfma16(bf16x8 a, bf16x8 b, f32x4 c) { return __builtin_amdgcn_mfma_f32_16x16x32_bf16(a, b, c, 0, 0, 0); }
__device__ __forceinline__ u32x2 pack4(f32x4 v) { u32x2 w; w.x = cvt_pk_bf16(v[0], v[1]); w.y = cvt_pk_bf16(v[2], v[3]); return w; }
__device__ __forceinline__ bf16x8 pack8(f32x4 a, f32x4 b) { u32x4 w; w.x = cvt_pk_bf16(a[0], a[1]); w.y = cvt_pk_bf16(a[2], a[3]); w.z = cvt_pk_bf16(b[0], b[1]); w.w = cvt_pk_bf16(b[2], b[3]); return __builtin_bit_cast(bf16x8, w); }
__device__ __forceinline__ float rows_max(float v) {
    auto a = __builtin_amdgcn_permlane16_swap(__float_as_uint(v), __float_as_uint(v), false, false); v = fmaxf(__uint_as_float(a[0]), __uint_as_float(a[1]));
    auto b = __builtin_amdgcn_permlane32_swap(__float_as_uint(v), __float_as_uint(v), false, false); return fmaxf(__uint_as_float(b[0]), __uint_as_float(b[1]));
}
__device__ __forceinline__ float rows_sum(float v) {
    auto a = __builtin_amdgcn_permlane16_swap(__float_as_uint(v), __float_as_uint(v), false, false); v = __uint_as_float(a[0]) + __uint_as_float(a[1]);
    auto b = __builtin_amdgcn_permlane32_swap(__float_as_uint(v), __float_as_uint(v), false, false); return __uint_as_float(b[0]) + __uint_as_float(b[1]);
}
template <int N> __device__ __forceinline__ float row_ror(float v) { return __uint_as_float((unsigned)__builtin_amdgcn_update_dpp(0, (int)__float_as_uint(v), 0x120 + N, 0xf, 0xf, false)); }
__device__ __forceinline__ void store_pair16(bf16_t* pX, bf16_t* pY, u32x2 X, u32x2 Y, int fq, bool okX, bool okY) {
    auto r0 = __builtin_amdgcn_permlane16_swap(X.x, Y.x, false, false); auto r1 = __builtin_amdgcn_permlane16_swap(X.y, Y.y, false, false);
    u32x4 o; o.x = r0[0]; o.y = r1[0]; o.z = r0[1]; o.w = r1[1];
    bf16_t* ad = (fq & 1) ? pY - 4 : pX; const bool ok = (fq & 1) ? okY : okX;
    if (ok) *(u32x4*)ad = o;
}
__device__ __forceinline__ void load_pair16(const bf16_t* pX, const bf16_t* pY, u32x2& X, u32x2& Y, int fq) {
    const u32x4 o = *(const u32x4*)((fq & 1) ? pY - 4 : pX);
    auto r0 = __builtin_amdgcn_permlane16_swap(o.x, o.z, false, false); auto r1 = __builtin_amdgcn_permlane16_swap(o.y, o.w, false, false);
    X.x = r0[0]; Y.x = r0[1]; X.y = r1[0]; Y.y = r1[1];
}
__device__ __forceinline__ float wave_sum(float v) {
#pragma unroll
    for (int o = 1; o < 64; o <<= 1) v += __shfl_xor(v, o);
    return v;
}

namespace pg8 {
constexpr int BM = 256, BK = 64, HALF = 128, HTB = HALF * BK * 2, STAGE_BYTES = 8 * HTB, NXCD = 8, WGM = 8;
__host__ __device__ __forceinline__ int lds_byte(int r, int c) { const int st = (r >> 4) * 2 + (c >> 5), rr = r & 15, cc = c & 31, ob = rr * 64 + cc * 2; return st * 1024 + (ob ^ (((ob >> 9) & 1) << 5)); }
__host__ __device__ __forceinline__ void stage_rc(int b, int& R, int& C) { const int st = b / 1024, sb = b % 1024, swz = sb ^ (((sb >> 9) & 1) << 5); R = (st >> 1) * 16 + swz / 64; C = (st & 1) * 32 + (swz % 64) / 2; }
struct Unit { int pm, pn; };
struct Gemm { const bf16_t* A; const bf16_t* Bt; int M, N, K, lda, ldb; };
struct StaticOrder {
    int nM, nN, nwg, G, c;
    __device__ void init(int M, int N, int G_, int c_) { nM = M / BM; nN = N / BM; nwg = nM * nN; G = G_; c = c_; }
    __device__ bool next(int i, Unit& u) const {
        const long L = (long)i * G + c; if (c < 0 || L >= nwg) return false;
        int wgid = (int)L; { const int q = nwg / NXCD, r = nwg % NXCD, xcd = wgid % NXCD, off = wgid / NXCD; wgid = (xcd < r ? xcd * (q + 1) : r * (q + 1) + (xcd - r) * q) + off; }
        const int nig = WGM * nN, gid = wgid / nig, fm = gid * WGM, gsz = (nM - fm) < WGM ? (nM - fm) : WGM;
        u.pm = fm + ((wgid % nig) % gsz); u.pn = (wgid % nig) / gsz; return true;
    }
};
template <class Epi>
__device__ __forceinline__ void gemm_phase(LAS unsigned char* lds, const Gemm g, const StaticOrder& S, const Epi& E, const int tid) {
    const int wid = __builtin_amdgcn_readfirstlane(tid >> 6), lane = tid & 63, wr = wid >> 2, wc = wid & 3, fr = lane & 15, fq = lane >> 4;
    const int K = g.K, nt = K / BK, lda = g.lda, ldb = g.ldb;
    unsigned voffA[2], voffB[2];
#pragma unroll
    for (int i = 0; i < 2; ++i) { int R, C; stage_rc(tid * 16 + i * 8192, R, C); voffA[i] = (unsigned)(R * lda + C) * 2u; voffB[i] = (unsigned)(R * ldb + C) * 2u; }
    const size_t kstep = (size_t)(BK * 2);
    const size_t hstepA = (size_t)HALF * lda * 2, hstepB = (size_t)HALF * ldb * 2;
    const size_t tstepA = 2 * hstepA, tstepB = 2 * hstepB;
    const unsigned ldsw = (unsigned)wid * 1024u;
    const int aoff = lds_byte(wr * 64 + fr, fq * 8), boff = lds_byte(wc * 32 + fr, fq * 8);
#define PG8_SA(b, h) (((b) * 2 + (h)) * HTB)
#define PG8_SB(b, h) ((4 + (b) * 2 + (h)) * HTB)
#define PG8_STAGE(bufoff, gbase, voff) do { _Pragma("unroll") for (int _i = 0; _i < 2; ++_i) \
        __builtin_amdgcn_global_load_lds((const unsigned*)((const char*)(gbase) + (voff)[_i]), (LAS unsigned*)(lds + (bufoff) + ldsw + _i * 8192), 16, 0, 0); } while (0)
#define PG8_LDA(dst, b, h) do { _Pragma("unroll") for (int m = 0; m < 4; ++m) _Pragma("unroll") for (int k = 0; k < 2; ++k) dst[m][k] = *(const LAS bf16x8*)(lds + PG8_SA(b, h) + aoff + m * 2048 + k * 1024); } while (0)
#define PG8_LDB(dst, b, h) do { _Pragma("unroll") for (int n = 0; n < 2; ++n) _Pragma("unroll") for (int k = 0; k < 2; ++k) dst[n][k] = *(const LAS bf16x8*)(lds + PG8_SB(b, h) + boff + n * 2048 + k * 1024); } while (0)
#define PG8_MMA(ai, bj, At, Bt) do { __builtin_amdgcn_s_setprio(1); _Pragma("unroll") for (int m = 0; m < 4; ++m) _Pragma("unroll") for (int n = 0; n < 2; ++n) _Pragma("unroll") for (int k = 0; k < 2; ++k) \
        acc[ai][bj][m][n] = __builtin_amdgcn_mfma_f32_16x16x32_bf16(Bt[n][k], At[m][k], acc[ai][bj][m][n], 0, 0, 0); __builtin_amdgcn_s_setprio(0); } while (0)
#define PG8_WAIT_V(n) asm volatile("s_waitcnt vmcnt(" #n ")" ::: "memory")
#define PG8_WAIT_L(n) asm volatile("s_waitcnt lgkmcnt(" #n ")" ::: "memory")
#define PG8_BAR __builtin_amdgcn_s_barrier()
#define PG8_SCHED __builtin_amdgcn_sched_barrier(0)
    Unit cur, nxt; int ui = 0;
    if (!S.next(0, cur)) return;
    f32x4 acc[2][2][4][2];
#pragma unroll
    for (int a = 0; a < 2; ++a)
#pragma unroll
        for (int b = 0; b < 2; ++b)
#pragma unroll
            for (int m = 0; m < 4; ++m)
#pragma unroll
                for (int n = 0; n < 2; ++n) acc[a][b][m][n] = (f32x4){0.f, 0.f, 0.f, 0.f};
    bf16x8 At[4][2], B0[2][2], B1[2][2];
    const char* cA = (const char*)g.A + (size_t)cur.pm * tstepA; const char* cB = (const char*)g.Bt + (size_t)cur.pn * tstepB;
    PG8_STAGE(PG8_SB(0, 0), cB, voffB); PG8_STAGE(PG8_SB(0, 1), cB + hstepB, voffB); PG8_STAGE(PG8_SA(0, 0), cA, voffA); PG8_STAGE(PG8_SA(0, 1), cA + hstepA, voffA);
    if (wr == 1) PG8_BAR;
    PG8_WAIT_V(2); PG8_BAR;
    PG8_STAGE(PG8_SB(1, 0), cB + kstep, voffB); PG8_STAGE(PG8_SA(1, 0), cA + kstep, voffA); PG8_STAGE(PG8_SB(1, 1), cB + hstepB + kstep, voffB);
    PG8_WAIT_V(6); PG8_BAR;
    for (;;) {
        const bool has_next = S.next(ui + 1, nxt);
        const char* nA = has_next ? (const char*)g.A + (size_t)nxt.pm * tstepA : cA; const char* nB = has_next ? (const char*)g.Bt + (size_t)nxt.pn * tstepB : cB;
        for (int t = 0; t < nt; t += 2) {
            const bool last = (t == nt - 2);
            const char* a1 = cA + (size_t)(t + 1) * kstep;
            const char* a2 = last ? nA : cA + (size_t)(t + 2) * kstep; const char* b2 = last ? nB : cB + (size_t)(t + 2) * kstep;
            const char* a3 = a2 + kstep; const char* b3 = b2 + kstep;
            PG8_LDB(B0, 0, 0); PG8_LDB(B1, 0, 1); PG8_SCHED; PG8_LDA(At, 0, 0); PG8_STAGE(PG8_SA(1, 1), a1 + hstepA, voffA);
            PG8_WAIT_V(8); PG8_WAIT_L(0); PG8_BAR; PG8_MMA(0, 0, At, B0); PG8_MMA(0, 1, At, B1); PG8_BAR; PG8_SCHED;
            PG8_LDA(At, 0, 1); PG8_STAGE(PG8_SB(0, 0), b2, voffB); PG8_STAGE(PG8_SB(0, 1), b2 + hstepB, voffB); PG8_STAGE(PG8_SA(0, 0), a2, voffA);
            PG8_WAIT_V(8); PG8_WAIT_L(0); PG8_BAR; PG8_MMA(1, 0, At, B0); PG8_MMA(1, 1, At, B1); PG8_BAR; PG8_SCHED;
            PG8_LDB(B0, 1, 0); PG8_LDB(B1, 1, 1); PG8_SCHED; PG8_LDA(At, 1, 0); PG8_STAGE(PG8_SA(0, 1), a2 + hstepA, voffA);
            PG8_WAIT_V(8); PG8_WAIT_L(0); PG8_BAR; PG8_MMA(0, 0, At, B0); PG8_MMA(0, 1, At, B1); PG8_BAR; PG8_SCHED;
            PG8_LDA(At, 1, 1); PG8_STAGE(PG8_SB(1, 0), b3, voffB); PG8_STAGE(PG8_SB(1, 1), b3 + hstepB, voffB); PG8_STAGE(PG8_SA(1, 0), a3, voffA);
            PG8_WAIT_V(8); PG8_WAIT_L(0); PG8_BAR; PG8_MMA(1, 0, At, B0); PG8_MMA(1, 1, At, B1); PG8_BAR; PG8_SCHED;
        }
        if (wr == 0) PG8_BAR;
        E(acc, cur, wr, wc, fr, fq);
        if (!has_next) break;
#pragma unroll
        for (int a = 0; a < 2; ++a)
#pragma unroll
            for (int b = 0; b < 2; ++b)
#pragma unroll
                for (int m = 0; m < 4; ++m)
#pragma unroll
                    for (int n = 0; n < 2; ++n) acc[a][b][m][n] = (f32x4){0.f, 0.f, 0.f, 0.f};
        cur = nxt; cA = nA; cB = nB; ++ui;
        if (wr == 1) PG8_BAR;
    }
    PG8_WAIT_V(0);
    PG8_BAR;
#undef PG8_SA
#undef PG8_SB
#undef PG8_STAGE
#undef PG8_LDA
#undef PG8_LDB
#undef PG8_MMA
#undef PG8_WAIT_V
#undef PG8_WAIT_L
#undef PG8_BAR
#undef PG8_SCHED
}
}
using pg8::Unit;
typedef f32x4 Acc[2][2][4][2];

struct EpiIn {
    const float* r0; const int* pos; unsigned char* ws;
    __device__ __forceinline__ void operator()(const Acc& acc, const Unit& u, int wr, int wc, int fr, int fq) const {
        const int tile = u.pn;
        f32x4 invr[2], invn;
#pragma unroll
        for (int e = 0; e < 4; ++e) { invr[0][e] = fexp2(-(float)(4 * fq + e) * (13.287712379549449f / 32.f)); invr[1][e] = fexp2(-(float)(16 + 4 * fq + e) * (13.287712379549449f / 32.f));
            invn[e] = fexp2(-(float)(4 * (fq & 1) + e) * (18.931568569324174f / 8.f)); }
        float rsv[2][4], pfv[2][4];
#pragma unroll
        for (int ai = 0; ai < 2; ++ai)
#pragma unroll
            for (int m = 0; m < 4; ++m) { const int row = u.pm * 256 + ai * 128 + wr * 64 + m * 16 + fr; rsv[ai][m] = r0[row]; pfv[ai][m] = (float)pos[row]; }
#pragma unroll
        for (int ai = 0; ai < 2; ++ai)
#pragma unroll
            for (int m = 0; m < 4; ++m) {
                const int row = u.pm * 256 + ai * 128 + wr * 64 + m * 16 + fr;
                const float rs = rsv[ai][m], pf = pfv[ai][m];
                if (tile < 4) {
                    bf16_t* dst = (bf16_t*)(ws + (tile < 2 ? WS_RQ : WS_RK)) + (size_t)row * 512 + ((tile & 1) * 4 + wc) * 64;
                    const float sc = tile < 2 ? rs : rs * 0.125f; u32x2 o1[2], o2[2];
#pragma unroll
                    for (int n = 0; n < 2; ++n) {
                        const int i0 = 16 * n + 4 * fq;
                        f32x4 c4, s4;
#pragma unroll
                        for (int e = 0; e < 4; ++e) { const float fv = __builtin_amdgcn_fractf(pf * invr[n][e] * 0.15915494309189535f); c4[e] = __builtin_amdgcn_cosf(fv); s4[e] = __builtin_amdgcn_sinf(fv); }
                        const f32x4 x1 = acc[ai][0][m][n] * sc, x2 = acc[ai][1][m][n] * sc;
                        o1[n] = pack4(x1 * c4 - x2 * s4); o2[n] = pack4(x1 * s4 + x2 * c4);
                    }
                    store_pair16(dst + 4 * fq, dst + 16 + 4 * fq, o1[0], o1[1], fq, true, true);
                    store_pair16(dst + 32 + 4 * fq, dst + 48 + 4 * fq, o2[0], o2[1], fq, true, true);
                } else if (tile < 8) {
                    bf16_t* dst = (bf16_t*)(ws + (tile < 6 ? WS_RV : WS_RG)) + (size_t)row * 512 + ((tile & 1) * 4 + wc) * 64;
#pragma unroll
                    for (int bj = 0; bj < 2; ++bj) { u32x2 ov[2];
#pragma unroll
                        for (int n = 0; n < 2; ++n) {
                            f32x4 v = acc[ai][bj][m][n] * rs;
                            if (tile >= 6) { v[0] = siluf_(v[0]); v[1] = siluf_(v[1]); v[2] = siluf_(v[2]); v[3] = siluf_(v[3]); }
                            ov[n] = pack4(v);
                        }
                        store_pair16(dst + 32 * bj + 4 * fq, dst + 32 * bj + 16 + 4 * fq, ov[0], ov[1], fq, true, true); }
                } else if (tile < 13) {
                    bf16_t* dst; bool roped; float sc = rs;
                    if (tile < 10) { dst = (bf16_t*)(ws + WS_NQ) + (size_t)row * 512 + ((tile & 1) * 4 + wc) * 64; roped = true; sc = rs * QSCALE; }
                    else { const int seg = wc >> 1, g = wc & 1, b = row >> 12, s = row & 4095;
                        const size_t base = (tile == 10 ? (seg ? WS_VC : WS_KC) : tile == 11 ? (seg ? WS_VS : WS_KS) : (seg ? WS_VW : WS_KW));
                        dst = (bf16_t*)(ws + base) + ((size_t)(b * 2 + g) * SEQ + s) * 64; roped = (seg == 0); }
                    f32x4 c4, s4;
#pragma unroll
                    for (int e = 0; e < 4; ++e) { const float fv = __builtin_amdgcn_fractf(pf * invn[e] * 0.15915494309189535f); c4[e] = __builtin_amdgcn_cosf(fv); s4[e] = __builtin_amdgcn_sinf(fv); }
#pragma unroll
                    for (int bj = 0; bj < 2; ++bj) { u32x2 ov[2];
#pragma unroll
                        for (int n = 0; n < 2; ++n) {
                            f32x4 v = acc[ai][bj][m][n] * sc;
                            if (bj == 0 && n == 0) {
                                f32x4 pr; pr[0] = __shfl_xor(v[0], 32); pr[1] = __shfl_xor(v[1], 32); pr[2] = __shfl_xor(v[2], 32); pr[3] = __shfl_xor(v[3], 32);
                                const f32x4 rot = (fq < 2) ? (v * c4 - pr * s4) : (pr * s4 + v * c4);
                                if (roped) v = rot;
                            }
                            ov[n] = pack4(v);
                        }
                        store_pair16(dst + 32 * bj + 4 * fq, dst + 32 * bj + 16 + 4 * fq, ov[0], ov[1], fq, true, true); }
                } else {
                    float* ng = (float*)(ws + WS_NG) + (size_t)row * 24;
                    if (wc == 0) {
                        const f32x4 v0 = acc[ai][0][m][0] * rs; f32x4 o;
                        o[0] = sigmoidf_(v0[0]); o[1] = sigmoidf_(v0[1]); o[2] = sigmoidf_(v0[2]); o[3] = sigmoidf_(v0[3]);
                        *(f32x4*)(ng + 4 * fq) = o;
                        if (fq < 2) { const f32x4 v1 = acc[ai][0][m][1] * rs; o[0] = sigmoidf_(v1[0]); o[1] = sigmoidf_(v1[1]); o[2] = sigmoidf_(v1[2]); o[3] = sigmoidf_(v1[3]); *(f32x4*)(ng + 16 + 4 * fq) = o; }
                    }
                }
            }
    }
};
template <int ACT> struct EpiBf16 {
    bf16_t* O; int ldc; const float* bias;
    __device__ __forceinline__ void operator()(const Acc& acc, const Unit& u, int wr, int wc, int fr, int fq) const {
#pragma unroll
        for (int ai = 0; ai < 2; ++ai)
#pragma unroll
            for (int m = 0; m < 4; ++m) {
                const int row = u.pm * 256 + ai * 128 + wr * 64 + m * 16 + fr;
#pragma unroll
                for (int bj = 0; bj < 2; ++bj) { u32x2 ov[2];
#pragma unroll
                    for (int n = 0; n < 2; ++n) {
                        const int col = u.pn * 256 + 128 * bj + 32 * wc + 16 * n + 4 * fq;
                        f32x4 v = acc[ai][bj][m][n];
                        if (ACT == 1) { const f32x4 bv = *(const f32x4*)(bias + col); v = v + bv; v[0] = gelu_tanh(v[0]); v[1] = gelu_tanh(v[1]); v[2] = gelu_tanh(v[2]); v[3] = gelu_tanh(v[3]); }
                        ov[n] = pack4(v);
                    }
                    bf16_t* pb_ = O + (size_t)row * ldc + u.pn * 256 + 128 * bj + 32 * wc + 4 * fq; store_pair16(pb_, pb_ + 16, ov[0], ov[1], fq, true, true); }
            }
    }
};
struct EpiF32 {
    float* O; int ldc;
    __device__ __forceinline__ void operator()(const Acc& acc, const Unit& u, int wr, int wc, int fr, int fq) const {
#pragma unroll
        for (int ai = 0; ai < 2; ++ai)
#pragma unroll
            for (int m = 0; m < 4; ++m) {
                const int row = u.pm * 256 + ai * 128 + wr * 64 + m * 16 + fr;
#pragma unroll
                for (int bj = 0; bj < 2; ++bj)
#pragma unroll
                    for (int n = 0; n < 2; ++n) *(f32x4*)(O + (size_t)row * ldc + u.pn * 256 + 128 * bj + 32 * wc + 16 * n + 4 * fq) = acc[ai][bj][m][n];
            }
    }
};
struct EpiOut {
    const bf16_t* xb; bf16_t* h1b; float* ss; int dry;
    __device__ __forceinline__ void operator()(const Acc& acc, const Unit& u, int wr, int wc, int fr, int fq) const {
        if (dry) { if (acc[0][0][0][0][0] == 1.2345e-30f) ss[0] = 0.f; return; }
#pragma unroll
        for (int ai = 0; ai < 2; ++ai) {
            u32x2 rv[4][2][2];
#pragma unroll
            for (int m = 0; m < 4; ++m)
#pragma unroll
                for (int bj = 0; bj < 2; ++bj) { const bf16_t* pl_ = xb + (size_t)(u.pm * 256 + ai * 128 + wr * 64 + m * 16 + fr) * DM + u.pn * 256 + 128 * bj + 32 * wc + 4 * fq; load_pair16(pl_, pl_ + 16, rv[m][bj][0], rv[m][bj][1], fq); }
#pragma unroll
            for (int m = 0; m < 4; ++m) {
                const int row = u.pm * 256 + ai * 128 + wr * 64 + m * 16 + fr; float sq = 0.f;
#pragma unroll
                for (int bj = 0; bj < 2; ++bj) { u32x2 ov[2];
#pragma unroll
                    for (int n = 0; n < 2; ++n) {
                        const u32x2 w = rv[m][bj][n];
                        const f32x4 h = (f32x4){__uint_as_float(w.x << 16), __uint_as_float(w.x & 0xffff0000u), __uint_as_float(w.y << 16), __uint_as_float(w.y & 0xffff0000u)} + acc[ai][bj][m][n];
                        ov[n] = pack4(h); sq += (h[0] * h[0] + h[1] * h[1]) + (h[2] * h[2] + h[3] * h[3]);
                    }
                    bf16_t* pb_ = h1b + (size_t)row * DM + u.pn * 256 + 128 * bj + 32 * wc + 4 * fq; store_pair16(pb_, pb_ + 16, ov[0], ov[1], fq, true, true); }
                sq += __shfl_xor(sq, 16); sq += __shfl_xor(sq, 32);
                if (fq == 0) atomicAdd(ss + row, sq);
            }
        }
    }
};
struct EpiUp {
    const float* ss1; const float* cw; const float* cb; bf16_t* act; float* sb;
    __device__ __forceinline__ void operator()(const Acc& acc, const Unit& u, int wr, int wc, int fr, int fq) const {
        float rsv[2][4];
#pragma unroll
        for (int ai = 0; ai < 2; ++ai)
#pragma unroll
            for (int m = 0; m < 4; ++m) rsv[ai][m] = ss1[u.pm * 256 + ai * 128 + wr * 64 + m * 16 + fr];
#pragma unroll
        for (int ai = 0; ai < 2; ++ai)
#pragma unroll
            for (int m = 0; m < 4; ++m) rsv[ai][m] = rsqrtf(rsv[ai][m] * (1.f / DM) + EPS);
#pragma unroll
        for (int n = 0; n < 2; ++n) {
            const int col = u.pn * 128 + wc * 32 + 16 * n + 4 * fq;
            const f32x4 w0 = *(const f32x4*)(cw + col), w1 = *(const f32x4*)(cw + DFF + col), w2 = *(const f32x4*)(cw + 2 * DFF + col), bb = *(const f32x4*)(cb + col);
#pragma unroll
            for (int ai = 0; ai < 2; ++ai) {
                const int unit = u.pm * 4 + ai * 2 + wr;
                f32x4 pg = (f32x4){0.f, 0.f, 0.f, 0.f}; u32x2 ppk = (u32x2){0u, 0u};
#pragma unroll
                for (int m = 0; m < 4; ++m) {
                    const int row = u.pm * 256 + ai * 128 + wr * 64 + m * 16 + fr;
                    const float rs = rsv[ai][m];
                    const f32x4 G = acc[ai][0][m][n] * rs, V = acc[ai][1][m][n] * rs; f32x4 a;
#pragma unroll
                    for (int e = 0; e < 4; ++e) {
                        const float a1 = row_ror<1>(G[e]), a2 = row_ror<2>(G[e]), b1 = row_ror<1>(pg[e]), b2 = row_ror<2>(pg[e]);
                        const float g1 = fr >= 1 ? a1 : b1, g2 = fr >= 2 ? a2 : b2;
                        const float gate = bb[e] + w0[e] * g2 + w1[e] * g1 + w2[e] * G[e];
                        a[e] = siluf_(gate) * V[e];
                    }
                    if (m == 0 && fr < 2) { *(f32x4*)(sb + ((size_t)unit * 6 + fr) * DFF + col) = G; *(f32x4*)(sb + ((size_t)unit * 6 + 2 + fr) * DFF + col) = V; }
                    if (m == 3 && fr >= 14) *(f32x4*)(sb + ((size_t)unit * 6 + 4 + (fr - 14)) * DFF + col) = G;
                    if ((m & 1) == 0) ppk = pack4(a);
                    else store_pair16(act + (size_t)(row - 16) * DFF + col, act + (size_t)row * DFF + col, ppk, pack4(a), fq, (m != 1) || (fr >= 2), true);
                    pg = G;
                }
            }
        }
    }
};
struct EpiDown {
    const bf16_t* h1b; bf16_t* hb; int dry;
    __device__ __forceinline__ void operator()(const Acc& acc, const Unit& u, int wr, int wc, int fr, int fq) const {
        if (dry) { if (acc[0][0][0][0][0] == 1.2345e-30f) hb[0] = 0; return; }
#pragma unroll
        for (int ai = 0; ai < 2; ++ai) {
            u32x2 rv[4][2][2];
#pragma unroll
            for (int m = 0; m < 4; ++m)
#pragma unroll
                for (int bj = 0; bj < 2; ++bj) { const bf16_t* pl_ = h1b + (size_t)(u.pm * 256 + ai * 128 + wr * 64 + m * 16 + fr) * DM + u.pn * 256 + 128 * bj + 32 * wc + 4 * fq; load_pair16(pl_, pl_ + 16, rv[m][bj][0], rv[m][bj][1], fq); }
#pragma unroll
            for (int m = 0; m < 4; ++m) {
                const int row = u.pm * 256 + ai * 128 + wr * 64 + m * 16 + fr;
#pragma unroll
                for (int bj = 0; bj < 2; ++bj) { u32x2 ov[2];
#pragma unroll
                    for (int n = 0; n < 2; ++n) { const u32x2 w = rv[m][bj][n];
                        ov[n] = pack4((f32x4){__uint_as_float(w.x << 16), __uint_as_float(w.x & 0xffff0000u), __uint_as_float(w.y << 16), __uint_as_float(w.y & 0xffff0000u)} + acc[ai][bj][m][n]); }
                    bf16_t* pb_ = hb + (size_t)row * DM + u.pn * 256 + 128 * bj + 32 * wc + 4 * fq; store_pair16(pb_, pb_ + 16, ov[0], ov[1], fq, true, true); }
            }
        }
    }
};
struct EpiPle {
    const bf16_t* h2b; bf16_t* h3b; const bf16_t* pe; float* ss; int dry;
    __device__ __forceinline__ void operator()(const Acc& acc, const Unit& u, int wr, int wc, int fr, int fq) const {
        if (dry) { if (acc[0][0][0][0][0] == 1.2345e-30f) h3b[0] = 0; return; }
#pragma unroll
        for (int ai = 0; ai < 2; ++ai)
#pragma unroll
            for (int mh = 0; mh < 2; ++mh) {
                u32x2 hv[2][2][2], pv[2][2][2];
#pragma unroll
                for (int mm = 0; mm < 2; ++mm)
#pragma unroll
                    for (int bj = 0; bj < 2; ++bj) { const size_t off = (size_t)(u.pm * 256 + ai * 128 + wr * 64 + (2 * mh + mm) * 16 + fr) * DM + u.pn * 256 + 128 * bj + 32 * wc + 4 * fq;
                        load_pair16(h2b + off, h2b + off + 16, hv[mm][bj][0], hv[mm][bj][1], fq); load_pair16(pe + off, pe + off + 16, pv[mm][bj][0], pv[mm][bj][1], fq); }
#pragma unroll
                for (int mm = 0; mm < 2; ++mm) {
                    const int m = 2 * mh + mm; const int row = u.pm * 256 + ai * 128 + wr * 64 + m * 16 + fr; float sq = 0.f;
#pragma unroll
                    for (int bj = 0; bj < 2; ++bj) { u32x2 ov[2];
#pragma unroll
                        for (int n = 0; n < 2; ++n) {
                            const u32x2 pw = pv[mm][bj][n], hw = hv[mm][bj][n]; const f32x4 a = acc[ai][bj][m][n];
                            f32x4 h = (f32x4){__uint_as_float(hw.x << 16), __uint_as_float(hw.x & 0xffff0000u), __uint_as_float(hw.y << 16), __uint_as_float(hw.y & 0xffff0000u)};
                            h[0] += sigmoidf_(a[0]) * __uint_as_float(pw.x << 16); h[1] += sigmoidf_(a[1]) * __uint_as_float(pw.x & 0xffff0000u);
                            h[2] += sigmoidf_(a[2]) * __uint_as_float(pw.y << 16); h[3] += sigmoidf_(a[3]) * __uint_as_float(pw.y & 0xffff0000u);
                            ov[n] = pack4(h); sq += (h[0] * h[0] + h[1] * h[1]) + (h[2] * h[2] + h[3] * h[3]);
                        }
                        bf16_t* pb_ = h3b + (size_t)row * DM + u.pn * 256 + 128 * bj + 32 * wc + 4 * fq; store_pair16(pb_, pb_ + 16, ov[0], ov[1], fq, true, true); }
                    sq += __shfl_xor(sq, 16); sq += __shfl_xor(sq, 32);
                    if (fq == 0) atomicAdd(ss + row, sq);
                }
            }
    }
};

__device__ __forceinline__ void tr_item(const float* W, int K, int N, bf16_t* WT, LAS float* scr, int k0, int np0, int src0, int lane, const float* ksc = nullptr) {
    const int q4 = lane & 7, kr = lane >> 3, sc = src0 + 4 * q4; const bool ok = sc < N;
#pragma unroll
    for (int i = 0; i < 8; ++i) { const int kk = 8 * i + kr; const f32x4 v = ok ? *(const f32x4*)(W + (size_t)(k0 + kk) * N + sc) : (f32x4){0.f, 0.f, 0.f, 0.f};
        LAS float* d = scr + kk * 33 + 4 * q4; d[0] = v[0]; d[1] = v[1]; d[2] = v[2]; d[3] = v[3]; }
    asm volatile("s_waitcnt lgkmcnt(0)" ::: "memory");
    const int c = lane & 7;
    f32x4 k0v = (f32x4){1.f, 1.f, 1.f, 1.f}, k1v = k0v;
    if (ksc) { k0v = *(const f32x4*)(ksc + k0 + 8 * c); k1v = *(const f32x4*)(ksc + k0 + 8 * c + 4); }
#pragma unroll
    for (int j = 0; j < 4; ++j) { const int n = (lane >> 3) + 8 * j; const LAS float* s = scr + (8 * c) * 33 + n;
        u32x4 o; o.x = cvt_pk_bf16(s[0 * 33] * k0v[0], s[1 * 33] * k0v[1]); o.y = cvt_pk_bf16(s[2 * 33] * k0v[2], s[3 * 33] * k0v[3]); o.z = cvt_pk_bf16(s[4 * 33] * k1v[0], s[5 * 33] * k1v[1]); o.w = cvt_pk_bf16(s[6 * 33] * k1v[2], s[7 * 33] * k1v[3]);
        *(u32x4*)(WT + (size_t)(np0 + n) * K + k0 + 8 * c) = o; }
    asm volatile("s_waitcnt lgkmcnt(0)" ::: "memory");
}

__device__ __forceinline__ int lnd_i(int v) { asm volatile("" : "+s"(v)); return v; }
template <class P> __device__ __forceinline__ P* lnd_p(P* p) { asm volatile("" : "+s"(p)); return p; }
#define PHASE_LOCALS const int wave = lnd_i(wave0); int lane_ = (int)__builtin_amdgcn_mbcnt_hi(~0u, __builtin_amdgcn_mbcnt_lo(~0u, 0u)); asm volatile("" : "+v"(lane_)); const int lane = lane_, tid = wave * 64 + lane, fr = lane & 15, fq = lane >> 4; (void)fr; (void)fq; (void)wave; const int G = lnd_i(G0), bid = lnd_i(bid0); unsigned char* ws = lnd_p(args.ws); float* out = lnd_p(args.out); (void)G; (void)bid; (void)ws; (void)out;
struct Args { const float* in[20]; float* out; unsigned char* ws; int ph_lo, ph_hi; };
__device__ __forceinline__ int opq(int i) { int r; asm volatile("s_mov_b32 %0, %1" : "=s"(r) : "i"(i)); return r; }
enum { I_X = 0, I_P, I_POS, I_NMIX, I_WIN, I_GNW, I_CPOS, I_KW1, I_KW2, I_VW1, I_VW2, I_WOUT, I_NFFN, I_WUP, I_CONVW, I_CONVB, I_WDN, I_PLEW, I_PLEG, I_FNW };

constexpr int RS = 144;
__device__ __forceinline__ void attn_tile(const int MODE, const LAS unsigned char* Kl, const LAS unsigned char* Vl, const bf16x8 (&Qf)[2][2],
                                          float (&mx)[2], f32x4 (&ls)[2], f32x4 (&O)[2][4], int fr, int fq, int toff, const bool (&rsel)[2]) {
    const bf16x8 ones8 = {0x3f80, 0x3f80, 0x3f80, 0x3f80, 0x3f80, 0x3f80, 0x3f80, 0x3f80};
    f32x4 S[2][4];
#pragma unroll
    for (int qg = 0; qg < 2; ++qg) {
        const float ci = (MODE == 0 && !rsel[qg]) ? -INFINITY : -mx[qg];
#pragma unroll
        for (int kt = 0; kt < 4; ++kt) S[qg][kt] = (f32x4){ci, ci, ci, ci};
    }
    const LAS unsigned char* kb = Kl + fr * RS + fq * 16;
#pragma unroll
    for (int ks = 0; ks < 2; ++ks) {
        bf16x8 kf[4];
#pragma unroll
        for (int kt = 0; kt < 4; ++kt) kf[kt] = *(const LAS bf16x8*)(kb + kt * 16 * RS + ks * 64);
        __builtin_amdgcn_sched_barrier(0);
#pragma unroll
        for (int kt = 0; kt < 4; ++kt) { S[0][kt] = mfma16(kf[kt], Qf[0][ks], S[0][kt]); S[1][kt] = mfma16(kf[kt], Qf[1][ks], S[1][kt]); }
    }
    const LAS unsigned char* vb = Vl + (4 * fq + (fr >> 2)) * RS + (fr & 3) * 8;
    bf16x8 Pf[2][2];
#pragma unroll
    for (int qg = 0; qg < 2; ++qg) {
        const int to = toff + 4 * qg;
        float rm = -INFINITY;
        if (MODE != 0) {
#pragma unroll
            for (int kt = 0; kt < 4; ++kt)
#pragma unroll
                for (int e = 0; e < 4; ++e) { const int ko = 16 * kt + 4 * fq + e; const bool ok = (MODE == 1) ? (ko <= to) : (ko > to); S[qg][kt][e] = ok ? S[qg][kt][e] : -INFINITY; }
        }
#pragma unroll
        for (int kt = 0; kt < 4; ++kt)
#pragma unroll
            for (int e = 0; e < 4; ++e) rm = fmaxf(rm, S[qg][kt][e]);
        rm = rows_max(rm);
        const bool was = __float_as_uint(mx[qg]) != 0x80000000u;
        const bool need = was ? (rm > 8.f) : (rm > -INFINITY);
        if (__builtin_amdgcn_ballot_w64(need) != 0ull) {
            const float delta = need ? rm : 0.f, f = (need && was) ? fexp2(-delta) : 1.f;
            mx[qg] += delta;
            ls[qg] = ls[qg] * f;
#pragma unroll
            for (int dt = 0; dt < 4; ++dt) O[qg][dt] = O[qg][dt] * f;
#pragma unroll
            for (int kt = 0; kt < 4; ++kt) S[qg][kt] = S[qg][kt] - delta;
        }
#pragma unroll
        for (int kt = 0; kt < 4; ++kt)
#pragma unroll
            for (int e = 0; e < 4; ++e) S[qg][kt][e] = fexp2(S[qg][kt][e]);
        Pf[qg][0] = pack8(S[qg][0], S[qg][1]); Pf[qg][1] = pack8(S[qg][2], S[qg][3]);
    }
#pragma unroll
    for (int kk = 0; kk < 2; ++kk) {
        bf16x8 vf[4];
#pragma unroll
        for (int dt = 0; dt < 4; ++dt) vf[dt] = cat8(trrd(vb + (32 * kk) * RS + dt * 32), trrd(vb + (32 * kk + 16) * RS + dt * 32));
        __builtin_amdgcn_sched_barrier(0);
#pragma unroll
        for (int dt = 0; dt < 4; ++dt) { O[0][dt] = mfma16(vf[dt], Pf[0][kk], O[0][dt]); O[1][dt] = mfma16(vf[dt], Pf[1][kk], O[1][dt]); }
        ls[0] = mfma16(ones8, Pf[0][kk], ls[0]); ls[1] = mfma16(ones8, Pf[1][kk], ls[1]);
    }
}

__device__ __forceinline__ void attn_branch(LAS unsigned char* lds, const bf16_t* Kg, const bf16_t* Vg, unsigned long long tmask, int qb, int is_win,
                                            const bf16x8 (&Qf)[2][2], const unsigned long long (&selm)[2], int fr, int fq, int toff, float gate0, float gate1, f32x4 (&acc_o)[2][4], const int tid) {
    const int lrow = tid >> 3, lch = tid & 7;
    float mx[2] = {-0.f, -0.f}; f32x4 ls[2] = {(f32x4){0.f, 0.f, 0.f, 0.f}, (f32x4){0.f, 0.f, 0.f, 0.f}}; f32x4 O[2][4];
#pragma unroll
    for (int qg = 0; qg < 2; ++qg)
#pragma unroll
        for (int dt = 0; dt < 4; ++dt) O[qg][dt] = (f32x4){0.f, 0.f, 0.f, 0.f};
    int j = __builtin_ctzll(tmask); tmask &= tmask - 1;
    int cur = 0;
    {
        const u32x4 kv = *(const u32x4*)(Kg + ((size_t)(64 * j + lrow)) * 64 + lch * 8), vv = *(const u32x4*)(Vg + ((size_t)(64 * j + lrow)) * 64 + lch * 8);
        *(LAS u32x4*)(lds + lrow * RS + lch * 16) = kv; *(LAS u32x4*)(lds + 9216 + lrow * RS + lch * 16) = vv;
    }
    __syncthreads();
    for (;;) {
        const bool more = tmask != 0ull; int jn = 0; u32x4 kv, vv;
        if (more) { jn = __builtin_ctzll(tmask); tmask &= tmask - 1;
            kv = *(const u32x4*)(Kg + ((size_t)(64 * jn + lrow)) * 64 + lch * 8); vv = *(const u32x4*)(Vg + ((size_t)(64 * jn + lrow)) * 64 + lch * 8); }
        bool rsel[2] = {true, true};
        const LAS unsigned char* Kl = lds + cur * 18432; const LAS unsigned char* Vl = Kl + 9216;
        int mode = 0;
        if (j == qb) mode = 1;
        else if (is_win) { if (j == qb - 8) mode = 2; }
        else { rsel[0] = (selm[0] >> j) & 1ull; rsel[1] = (selm[1] >> j) & 1ull; }
        attn_tile(mode, Kl, Vl, Qf, mx, ls, O, fr, fq, toff, rsel);
        if (!more) break;
        cur ^= 1;
        *(LAS u32x4*)(lds + cur * 18432 + lrow * RS + lch * 16) = kv; *(LAS u32x4*)(lds + cur * 18432 + 9216 + lrow * RS + lch * 16) = vv;
        __syncthreads();
        j = jn;
    }
    __syncthreads();
#pragma unroll
    for (int qg = 0; qg < 2; ++qg) {
        const float l = ls[qg][0];
        const float sc = (qg ? gate1 : gate0) * (l > 0.f ? frcp(l) : 0.f);
#pragma unroll
        for (int dt = 0; dt < 4; ++dt) acc_o[qg][dt] = acc_o[qg][dt] + O[qg][dt] * sc;
    }
}

#define XB_TMO      128
#define XB_XCNT(j)  (256  + 64 * (j))
#define XB_XSUB(j)  (1280 + 64 * (j))
#define XB_XGEN(j)  (2304 + 64 * (j))
#define XB_TOP      3328
#define XB_TOPGEN   3392
#define XCD_BAR_WORDS 3456
#define XB_SPIN_CAP (1u << 22)
__device__ __forceinline__ unsigned xb_ld(unsigned* p)              { return __hip_atomic_load(p, __ATOMIC_RELAXED, __HIP_MEMORY_SCOPE_AGENT); }
__device__ __forceinline__ unsigned xb_add(unsigned* p, unsigned v) { return __hip_atomic_fetch_add(p, v, __ATOMIC_RELAXED, __HIP_MEMORY_SCOPE_AGENT); }
__device__ __forceinline__ unsigned xb_xcc_id() { return (unsigned)__builtin_amdgcn_s_getreg((3 << 11) | 20) & 0xFu; }
#define XB_SPIN(cond, bar) do { unsigned _sp = 0; while (cond) { __builtin_amdgcn_s_sleep(1); \
    if ((++_sp & 255u) == 0u) { if (xb_ld(&(bar)[XB_TMO])) break; if (_sp > XB_SPIN_CAP) { atomicAdd(&(bar)[XB_TMO], 1u); break; } } } } while (0)
__device__ __forceinline__ void xcd_barrier_complete(unsigned* bar, unsigned x, unsigned G, unsigned& nloc, unsigned& nx) {
    unsigned sum, cnt, mine, sp = 0u;
    for (;;) {
        sum = 0u; cnt = 0u; mine = 0u;
#pragma unroll
        for (unsigned j = 0; j < 16; ++j) { const unsigned c = xb_ld(&bar[XB_XCNT(j)]); sum += c; cnt += (c > 0u) ? 1u : 0u; mine = (j == x) ? c : mine; }
        if (sum == G) break;
        __builtin_amdgcn_s_sleep(1);
        if ((++sp & 255u) == 0u) { if (xb_ld(&bar[XB_TMO])) break; if (sp > XB_SPIN_CAP) { atomicAdd(&bar[XB_TMO], 1u); break; } }
    }
    nloc = mine > 0u ? mine : 1u; nx = cnt > 0u ? cnt : 1u;
}
__device__ __forceinline__ void xcd_barrier(unsigned* bar, unsigned x, volatile LAS unsigned* st, unsigned G, bool is_leader) {
    asm volatile("s_waitcnt vmcnt(0)" ::: "memory");
    __syncthreads();
    if (is_leader) {
        __builtin_amdgcn_s_waitcnt(0);
        unsigned nloc = st[0], nx = st[1];
        if (nloc == 0u) { xcd_barrier_complete(bar, x, G, nloc, nx); st[0] = nloc; st[1] = nx; }
        const unsigned old = xb_add(&bar[XB_XSUB(x)], 1u);
        const unsigned gen = old / nloc;
        if (old + 1u == (gen + 1u) * nloc) {
            __builtin_amdgcn_fence(__ATOMIC_RELEASE, "agent");
            asm volatile("s_waitcnt vmcnt(0)" ::: "memory");
            const unsigned og = xb_add(&bar[XB_TOP], 1u);
            const unsigned tg = og / nx;
            if (og + 1u == (tg + 1u) * nx) xb_add(&bar[XB_TOPGEN], 1u);
            else XB_SPIN(xb_ld(&bar[XB_TOPGEN]) == tg, bar);
            __builtin_amdgcn_fence(__ATOMIC_ACQUIRE, "agent");
            xb_add(&bar[XB_XGEN(x)], 1u);
            asm volatile("s_waitcnt vmcnt(0)" ::: "memory");
        } else {
            XB_SPIN(xb_ld(&bar[XB_XGEN(x)]) == gen, bar);
            __builtin_amdgcn_fence(__ATOMIC_ACQUIRE, "agent");
            asm volatile("s_waitcnt vmcnt(0)" ::: "memory");
        }
    }
    __syncthreads();
}

__global__ void __launch_bounds__(NTHR, 2) hymba_fwd(Args args) {
    extern __shared__ __attribute__((aligned(16))) unsigned char lds_raw[];
    LAS unsigned char* lds = (LAS unsigned char*)lds_raw;
    cg::grid_group grid = cg::this_grid();
    const int G0 = gridDim.x, bid0 = blockIdx.x, wave0 = __builtin_amdgcn_readfirstlane((int)threadIdx.x >> 6);
    const int lo = args.ph_lo, hi = args.ph_hi;
#define IN(k) (lo <= (k) && (k) < hi)
    unsigned* const barw = (unsigned*)(args.ws + WS_BAR);
    volatile LAS unsigned* const xst = (volatile LAS unsigned*)(lds + 147200);
    const bool xlead = (wave0 == 0) && (__builtin_amdgcn_mbcnt_hi(~0u, __builtin_amdgcn_mbcnt_lo(~0u, 0u)) == 0u);
    const unsigned xcc = xb_xcc_id();
    if (hi - lo > 1) { if (xlead) { xst[0] = 0u; xst[1] = 0u; (void)xb_add(&barw[XB_XCNT(xcc)], 1u); } __syncthreads(); }
#define SEAM(k) do { if (IN(k) && IN((k) + 1)) xcd_barrier(barw, xcc, xst, (unsigned)G0, xlead); } while (0)
    if (lo < 0) grid.sync();

    if (IN(0)) {
        PHASE_LOCALS
        for (int rep = ((REP_MASK >> 0) & 1); rep >= 0; --rep) {
        LAS float* scr = (LAS float*)(lds + wave * 16384);
        const int gw = bid * 8 + wave, NGW = G * 8;
        constexpr int I0 = 16 * (INP / 32), I1 = 16 * 32, I2 = 16 * (2 * DFF / 32), I3 = (DFF / 64) * 32, I4 = 16 * 32, I5 = 4 * 32, I6 = 32 * 8, I7 = 32 * 8, I8 = 4 * 2, I9 = 4 * 2;
        constexpr int NIT = I0 + I1 + I2 + I3 + I4 + I5 + I6 + I7 + I8 + I9;
        for (int r0_ = (P0_REP & 1); r0_ >= 0; --r0_)
        for (int it = gw; it < NIT; it += NGW) {
            int r = it;
            if (r < I0) { const int nblk = INP / 32, kb = r / nblk, nb = r % nblk, np0 = nb * 32, tile = np0 >> 8, p = np0 & 255;
                const int src = tile < 13 ? tile * 256 + 64 * ((p >> 5) & 3) + 32 * (p >> 7) : 3328 + p;
                tr_item(args.in[opq(I_WIN)], DM, INW, (bf16_t*)(ws + WS_WIN), scr, kb * 64, np0, src, lane, args.in[opq(I_NMIX)]); continue; } r -= I0;
            if (r < I1) { tr_item(args.in[opq(I_WOUT)], DM, DM, (bf16_t*)(ws + WS_WOUT), scr, (r / 32) * 64, (r % 32) * 32, (r % 32) * 32, lane); continue; } r -= I1;
            if (r < I2) { const int nblk = 2 * DFF / 32, kb = r / nblk, nb = r % nblk, np0 = nb * 32, tile = np0 >> 8, p = np0 & 255;
                const int src = (p >> 7) * DFF + tile * 128 + (p & 127);
                tr_item(args.in[opq(I_WUP)], DM, 2 * DFF, (bf16_t*)(ws + WS_WUP), scr, kb * 64, np0, src, lane, args.in[opq(I_NFFN)]); continue; } r -= I2;
            if (r < I3) { tr_item(args.in[opq(I_WDN)], DFF, DM, (bf16_t*)(ws + WS_WDN), scr, (r / 32) * 64, (r % 32) * 32, (r % 32) * 32, lane); continue; } r -= I3;
            if (r < I4) { tr_item(args.in[opq(I_PLEG)], DM, DM, (bf16_t*)(ws + WS_WG), scr, (r / 32) * 64, (r % 32) * 32, (r % 32) * 32, lane); continue; } r -= I4;
            if (r < I5) { tr_item(args.in[opq(I_PLEW)], PLE, DM, (bf16_t*)(ws + WS_WP), scr, (r / 32) * 64, (r % 32) * 32, (r % 32) * 32, lane); continue; } r -= I5;
            if (r < I6) { tr_item(args.in[opq(I_KW1)], 2048, 256, (bf16_t*)(ws + WS_W1K), scr, (r / 8) * 64, (r % 8) * 32, (r % 8) * 32, lane); continue; } r -= I6;
            if (r < I7) { tr_item(args.in[opq(I_VW1)], 2048, 256, (bf16_t*)(ws + WS_W1V), scr, (r / 8) * 64, (r % 8) * 32, (r % 8) * 32, lane); continue; } r -= I7;
            if (r < I8) { tr_item(args.in[opq(I_KW2)], 256, 64, (bf16_t*)(ws + WS_W2K), scr, (r / 2) * 64, (r % 2) * 32, (r % 2) * 32, lane); continue; } r -= I8;
            tr_item(args.in[opq(I_VW2)], 256, 64, (bf16_t*)(ws + WS_W2V), scr, (r / 2) * 64, (r % 2) * 32, (r % 2) * 32, lane);
        }
        {
            const float* x = args.in[opq(I_X)]; bf16_t* xs = (bf16_t*)(ws + WS_XS); float* r0 = (float*)(ws + WS_R0);
            for (int r1_ = ((P0_REP >> 1) & 1); r1_ >= 0; --r1_)
            for (int m0 = gw * 4; m0 < T; m0 += NGW * 4) {
                f32x4 v[4][4];
#pragma unroll
                for (int rr = 0; rr < 4; ++rr)
#pragma unroll
                    for (int j = 0; j < 4; ++j) v[rr][j] = *((const f32x4*)(x + (size_t)(m0 + rr) * DM) + lane + 64 * j);
                float s[4];
#pragma unroll
                for (int rr = 0; rr < 4; ++rr) { s[rr] = 0.f;
#pragma unroll
                    for (int j = 0; j < 4; ++j) s[rr] += (v[rr][j][0] * v[rr][j][0] + v[rr][j][1] * v[rr][j][1]) + (v[rr][j][2] * v[rr][j][2] + v[rr][j][3] * v[rr][j][3]); }
#pragma unroll
                for (int o = 1; o < 64; o <<= 1) { s[0] += __shfl_xor(s[0], o); s[1] += __shfl_xor(s[1], o); s[2] += __shfl_xor(s[2], o); s[3] += __shfl_xor(s[3], o); }
                if (lane < 4) r0[m0 + lane] = rsqrtf((lane == 0 ? s[0] : lane == 1 ? s[1] : lane == 2 ? s[2] : s[3]) * (1.f / DM) + EPS);
#pragma unroll
                for (int j = 0; j < 4; ++j) {
#pragma unroll
                    for (int rr = 0; rr < 4; ++rr) *(u32x2*)(xs + (size_t)(m0 + rr) * DM + 4 * lane + 256 * j) = pack4(v[rr][j]); }
            }
        }
        const int gt = bid * NTHR + tid, NGT = G * NTHR;
        { const f32x4* p4 = (const f32x4*)args.in[opq(I_P)]; u32x2* pb = (u32x2*)(ws + WS_PB);
            for (int r2_ = ((P0_REP >> 2) & 1); r2_ >= 0; --r2_)
#pragma unroll 8
            for (int i = gt; i < T * PLE / 4; i += NGT) pb[i] = pack4(p4[i]); }
        { float* z1 = (float*)(ws + WS_SS1); float* z3 = (float*)(ws + WS_SS3); for (int i = gt; i < T; i += NGT) { z1[i] = 0.f; z3[i] = 0.f; } }
        { float* c1p = (float*)(ws + WS_C1P); const float* cp = args.in[opq(I_CPOS)];
            for (int r4_ = ((P0_REP >> 4) & 1); r4_ >= 0; --r4_)
            for (int i = gt; i < 16 * 512; i += NGT) { const int kc = i >> 9, o = i & 511; const float* w1 = ((o >> 8) ? args.in[opq(I_VW1)] : args.in[opq(I_KW1)]); const int n = o & 255; float s = 0.f;
#pragma unroll 32
                for (int k = kc * 128; k < kc * 128 + 128; ++k) s += cp[k] * w1[(size_t)k * 256 + n];
                c1p[i] = s; } }
        if (rep > 0) { asm volatile("s_waitcnt vmcnt(0) lgkmcnt(0)" ::: "memory"); __syncthreads(); }
        }
    }
    SEAM(0);
    for (int xb = 0; xb < XBAR; ++xb) { SEAM(0); }

    if (IN(1)) {
        PHASE_LOCALS
        for (int rep = ((REP_MASK >> 1) & 1); rep >= 0; --rep) {
        if (bid == 0) { const float* c1p = (const float*)(ws + WS_C1P); float s = 0.f; for (int k = 0; k < 16; ++k) s += c1p[k * 512 + tid]; ((float*)(ws + WS_C1))[tid] = s; }
        {
            pg8::Gemm g{(const bf16_t*)(ws + WS_XS), (const bf16_t*)(ws + WS_WIN), T, INP, DM, DM, DM}; pg8::StaticOrder S; S.init(T, INP, G, bid);
            for (int rep4 = ((REP2 >> 2) & 1); rep4 >= 0; --rep4) {
            EpiIn E{(const float*)(ws + WS_R0), (const int*)args.in[opq(I_POS)], ws};
            pg8::gemm_phase(lds, g, S, E, tid); }
        }
        if (rep > 0) { asm volatile("s_waitcnt vmcnt(0) lgkmcnt(0)" ::: "memory"); __syncthreads(); }
        }
    }
    SEAM(1);

    if (IN(2)) {
        PHASE_LOCALS
        for (int rep = ((REP_MASK >> 2) & 1); rep >= 0; --rep) {
        const int ngemm = (G >= 128) ? 64 : 0;
        {
            for (int q = bid; q < 64; q += G) {
                const int kv = q >> 5, ks = (q >> 4) & 1;
                pg8::Gemm g{(const bf16_t*)(ws + (kv ? WS_VC : WS_KC)) + ks * 1024, (const bf16_t*)(ws + (kv ? WS_W1V : WS_W1K)) + ks * 1024, 4096, 256, 1024, 1024, 2048};
                pg8::StaticOrder S; S.init(4096, 256, 16, q & 15);
                EpiF32 E{(float*)(ws + WS_SB) + (size_t)(kv * 2 + ks) * 4096 * 256, 256};
                pg8::gemm_phase(lds, g, S, E, tid);
            }
        }
        if (bid >= ngemm) {
            const bf16_t* RK = (const bf16_t*)(ws + WS_RK); const bf16_t* RV = (const bf16_t*)(ws + WS_RV); float* KV = (float*)(ws + WS_KVST);
            for (int it = bid - ngemm; it < 2048; it += G - ngemm) {
                const int n = it & 31, h = (it >> 5) & 7, b = it >> 8;
                const float lg2 = log1pf(-exp2f(-5.f - (float)h)) * 1.4426950408889634f;
#pragma unroll
                for (int i = 0; i < 2; ++i) {
                    const int ch = tid + i * NTHR, k = ch >> 3, c8 = ch & 7; const size_t src = ((size_t)(b * SEQ + n * 128 + k)) * 512 + h * 64 + c8 * 8;
                    const u32x4 kr = *(const u32x4*)(RK + src), vr = *(const u32x4*)(RV + src);
                    const float dk = fexp2((float)(127 - k) * lg2); u32x4 ko;
                    ko.x = cvt_pk_bf16(__uint_as_float(kr.x << 16) * dk, __uint_as_float(kr.x & 0xffff0000u) * dk); ko.y = cvt_pk_bf16(__uint_as_float(kr.y << 16) * dk, __uint_as_float(kr.y & 0xffff0000u) * dk);
                    ko.z = cvt_pk_bf16(__uint_as_float(kr.z << 16) * dk, __uint_as_float(kr.z & 0xffff0000u) * dk); ko.w = cvt_pk_bf16(__uint_as_float(kr.w << 16) * dk, __uint_as_float(kr.w & 0xffff0000u) * dk);
                    *(LAS u32x4*)(lds + k * RS + c8 * 16) = ko; *(LAS u32x4*)(lds + 18432 + k * RS + c8 * 16) = vr;
                }
                __syncthreads();
                const LAS unsigned char* tb = lds + (4 * fq + (fr >> 2)) * RS + (fr & 3) * 8;
#pragma unroll
                for (int tt = 0; tt < 2; ++tt) {
                    const int et = (2 * wave + tt) >> 2, dt = (2 * wave + tt) & 3; f32x4 a = (f32x4){0.f, 0.f, 0.f, 0.f};
#pragma unroll
                    for (int kk = 0; kk < 4; ++kk) {
                        const bf16x8 af = cat8(trrd(tb + 18432 + (32 * kk) * RS + et * 32), trrd(tb + 18432 + (32 * kk + 16) * RS + et * 32));
                        const bf16x8 bf = cat8(trrd(tb + (32 * kk) * RS + dt * 32), trrd(tb + (32 * kk + 16) * RS + dt * 32));
                        a = mfma16(af, bf, a);
                    }
                    float* dst = KV + (size_t)it * 4096 + (16 * et + 4 * fq) * 64 + 16 * dt + fr;
                    dst[0] = a[0]; dst[64] = a[1]; dst[128] = a[2]; dst[192] = a[3];
                }
                __syncthreads();
            }
        }
        if (rep > 0) { asm volatile("s_waitcnt vmcnt(0) lgkmcnt(0)" ::: "memory"); __syncthreads(); }
        }
    }
    SEAM(2);

    if (IN(3)) {
        PHASE_LOCALS
        for (int rep = ((REP_MASK >> 3) & 1); rep >= 0; --rep) {
        for (int it = bid * 8 + wave; it < 512; it += G * 8) {
            const int kv = it >> 8, r0 = (it & 255) * 16;
            const bf16_t* w2 = (const bf16_t*)(ws + (kv ? WS_W2V : WS_W2K)); bf16_t* o = (bf16_t*)(ws + (kv ? WS_CV : WS_CK));
            f32x4 a[4];
#pragma unroll
            for (int nt = 0; nt < 4; ++nt) a[nt] = (f32x4){0.f, 0.f, 0.f, 0.f};
#pragma unroll 2
            for (int ks = 0; ks < 8; ++ks) {
                bf16x8 hf;
                { const float* p0 = (const float*)(ws + WS_SB) + ((size_t)(kv * 2) * 4096 + r0 + fr) * 256 + 32 * ks + 8 * fq; const float* p1 = p0 + (size_t)4096 * 256;
                  const float* cb = (const float*)(ws + WS_C1) + kv * 256 + 32 * ks + 8 * fq;
                  f32x4 a0 = *(const f32x4*)p0 + *(const f32x4*)p1 + *(const f32x4*)cb, a1 = *(const f32x4*)(p0 + 4) + *(const f32x4*)(p1 + 4) + *(const f32x4*)(cb + 4);
#pragma unroll
                  for (int e = 0; e < 4; ++e) { a0[e] = gelu_tanh(a0[e]); a1[e] = gelu_tanh(a1[e]); }
                  hf = pack8(a0, a1); }
#pragma unroll
                for (int nt = 0; nt < 4; ++nt) { const bf16x8 wf = *(const bf16x8*)(w2 + (size_t)(16 * nt + fr) * 256 + 32 * ks + 8 * fq); a[nt] = mfma16(wf, hf, a[nt]); }
            }
#pragma unroll
            for (int nt = 0; nt < 4; ++nt) *(u32x2*)(o + (size_t)(r0 + fr) * 64 + 16 * nt + 4 * fq) = pack4(a[nt]);
        }
        float* KV = (float*)(ws + WS_KVST);
        for (int i = bid * NTHR + tid; i < 64 * 4096; i += G * NTHR) {
            const int bh = i >> 12, el = i & 4095, h = bh & 7;
            const float cd = fexp2(128.f * log1pf(-exp2f(-5.f - (float)h)) * 1.4426950408889634f);
            float* p = KV + (size_t)bh * 32 * 4096 + el; float s = 0.f;
#pragma unroll
            for (int n0 = 0; n0 < 32; n0 += 8) { float t[8];
#pragma unroll
                for (int n = 0; n < 8; ++n) t[n] = p[(size_t)(n0 + n) * 4096];
#pragma unroll
                for (int n = 0; n < 8; ++n) { p[(size_t)(n0 + n) * 4096] = s; s = s * cd + t[n]; } }
        }
        {
            pg8::Gemm g{(const bf16_t*)(ws + WS_PB), (const bf16_t*)(ws + WS_WP), T, DM, PLE, PLE, PLE}; pg8::StaticOrder S; S.init(T, DM, G, bid);
            EpiBf16<0> E{(bf16_t*)(ws + WS_PE), DM, nullptr};
            pg8::gemm_phase(lds, g, S, E, tid);
        }
        if (rep > 0) { asm volatile("s_waitcnt vmcnt(0) lgkmcnt(0)" ::: "memory"); __syncthreads(); }
        }
    }
    SEAM(3);

    if (IN(4)) {
        PHASE_LOCALS
        for (int rep = ((REP_MASK >> 4) & 1); rep >= 0; --rep) {
        bf16_t* MIX = (bf16_t*)out + (size_t)T * DM;
        LAS unsigned char* CKl = lds + 36864; LAS unsigned char* CVl = lds + 73728; LAS float* IMP = (LAS float*)(lds + 110592);
        LAS unsigned long long* SELM = (LAS unsigned long long*)(lds + 127232); LAS unsigned long long* UNI = (LAS unsigned long long*)(lds + 127744);
        const bf16_t* NQ = (const bf16_t*)(ws + WS_NQ); const float* NG = (const float*)(ws + WS_NG);
#ifndef DBG_SKIP
#define DBG_SKIP 0
#endif
        for (int rep2 = (REP2 & 1); rep2 >= 0; --rep2)
        for (int it = bid; it < ((DBG_SKIP & 1) ? 0 : 1024); it += G) {
            const int vb_ = it & 255, v = (G == 256) ? ((vb_ & 7) * 32 + (vb_ >> 3)) : vb_, kq = it >> 8, bg = v >> 4, s16 = v & 15;
            const int qb = (kq == 0) ? s16 : (kq == 1) ? 31 - s16 : (kq == 2) ? 32 + s16 : 63 - s16;
            const int b = bg >> 1, g = bg & 1;
            const int hr = fr >> 2, toff = 8 * wave + (fr & 3);
            const int head = g * 4 + hr;
            bf16x8 Qf[2][2]; float gate[2][3]; f32x4 acc_o[2][4];
#pragma unroll
            for (int qg = 0; qg < 2; ++qg) {
                const size_t row = (size_t)b * SEQ + 64 * qb + toff + 4 * qg;
#pragma unroll
                for (int ks = 0; ks < 2; ++ks) Qf[qg][ks] = *(const bf16x8*)(NQ + row * 512 + head * 64 + 32 * ks + 8 * fq);
#pragma unroll
                for (int br = 0; br < 3; ++br) gate[qg][br] = NG[row * 24 + head * 3 + br];
#pragma unroll
                for (int dt = 0; dt < 4; ++dt) acc_o[qg][dt] = (f32x4){0.f, 0.f, 0.f, 0.f};
                if (DBG_SKIP & 16) { gate[qg][0] = 1.f; gate[qg][1] = 1.f; gate[qg][2] = 1.f; }
                if (DBG_SKIP & 32) { const bf16x8 cq = {0x3c00, 0x3c80, 0x3d00, 0x3c00, 0x3d80, 0x3c00, 0x3c80, 0x3d00}; Qf[qg][0] = cq; Qf[qg][1] = cq; }
            }
            for (int nrep = (NSA_REP & 1); nrep >= 0; --nrep) {
            float zf = 0.f; asm volatile("" : "+v"(zf));
            const int ncv = (4 * qb + 3 < 255) ? 4 * qb + 3 : 255, NT2 = (ncv + 31) >> 5;
            {
                const bf16_t* ckg = (const bf16_t*)(ws + WS_CK) + (size_t)bg * 256 * 64; const bf16_t* cvg = (const bf16_t*)(ws + WS_CV) + (size_t)bg * 256 * 64;
                int ch0_ = tid; asm volatile("" : "+v"(ch0_));
                for (int ch = ch0_; ch < NT2 * 32 * 8; ch += NTHR) { const int r = ch >> 3, c8 = ch & 7;
                    u32x4 a_ = *(const u32x4*)(ckg + r * 64 + c8 * 8), b_ = *(const u32x4*)(cvg + r * 64 + c8 * 8);
                    if (DBG_SKIP & 128) { a_ = *(const u32x4*)((const bf16_t*)(ws + WS_HIDK) + ((size_t)bg * 256 + r) * 256 + c8 * 8); b_ = *(const u32x4*)((const bf16_t*)(ws + WS_HIDV) + ((size_t)bg * 256 + r) * 256 + c8 * 8); }
                    if (DBG_SKIP & 64) { const unsigned pz = 0x3c003c00u + ((unsigned)((r * 7 + c8 * 3) & 63) << 16) + (unsigned)((r * 5 + c8) & 31); a_ = (u32x4){pz, pz + 1u, pz + 2u, pz + 3u}; b_ = (u32x4){pz + 4u, pz + 5u, pz + 6u, pz + 7u}; }
                    *(LAS u32x4*)(CKl + r * RS + c8 * 16) = a_; *(LAS u32x4*)(CVl + r * RS + c8 * 16) = b_; }
            }
            __syncthreads();
            float cm[2] = {-1e30f, -1e30f}, cl[2] = {0.f, 0.f};
            const LAS unsigned char* kb = CKl + fr * RS + fq * 16;
            for (int kt = 0; kt < 2 * NT2; ++kt) {
                f32x4 S[2] = {(f32x4){0.f, 0.f, 0.f, 0.f}, (f32x4){0.f, 0.f, 0.f, 0.f}};
#pragma unroll
                for (int ks = 0; ks < 2; ++ks) { const bf16x8 kf = *(const LAS bf16x8*)(kb + kt * 16 * RS + ks * 64); S[0] = mfma16(kf, Qf[0][ks], S[0]); S[1] = mfma16(kf, Qf[1][ks], S[1]); }
#pragma unroll
                for (int qg = 0; qg < 2; ++qg) {
                    const int tq = 64 * qb + toff + 4 * qg; float rm = -INFINITY;
#pragma unroll
                    for (int e = 0; e < 4; ++e) { const int n = 16 * kt + 4 * fq + e; const float vv = (16 * n + 31 <= tq) ? S[qg][e] : -INFINITY; S[qg][e] = vv; rm = fmaxf(rm, vv); }
                    rm = rows_max(rm);
                    const float mn = fmaxf(cm[qg], rm); float sum = 0.f;
#pragma unroll
                    for (int e = 0; e < 4; ++e) sum += fexp2(S[qg][e] - mn);
                    cl[qg] = cl[qg] * fexp2(cm[qg] - mn) + sum; cm[qg] = mn;
                }
            }
            float cinv[2];
#pragma unroll
            for (int qg = 0; qg < 2; ++qg) { float l = cl[qg]; l = rows_sum(l); cinv[qg] = l > 0.f ? frcp(l) : 0.f; }
            {
                f32x4 O[2][4];
#pragma unroll
                for (int qg = 0; qg < 2; ++qg)
#pragma unroll
                    for (int dt = 0; dt < 4; ++dt) O[qg][dt] = (f32x4){0.f, 0.f, 0.f, 0.f};
                float carry[2] = {0.f, 0.f};
                const LAS unsigned char* vb = CVl + (4 * fq + (fr >> 2)) * RS + (fr & 3) * 8;
                for (int k2 = 0; k2 < NT2; ++k2) {
                    f32x4 S[2][2];
#pragma unroll
                    for (int qg = 0; qg < 2; ++qg) { S[qg][0] = (f32x4){0.f, 0.f, 0.f, 0.f}; S[qg][1] = (f32x4){0.f, 0.f, 0.f, 0.f}; }
#pragma unroll
                    for (int ks = 0; ks < 2; ++ks)
#pragma unroll
                        for (int t2 = 0; t2 < 2; ++t2) { const bf16x8 kf = *(const LAS bf16x8*)(kb + (2 * k2 + t2) * 16 * RS + ks * 64); S[0][t2] = mfma16(kf, Qf[0][ks], S[0][t2]); S[1][t2] = mfma16(kf, Qf[1][ks], S[1][t2]); }
                    bf16x8 Pf[2];
#pragma unroll
                    for (int qg = 0; qg < 2; ++qg) {
                        const int tq = 64 * qb + toff + 4 * qg;
#pragma unroll
                        for (int t2 = 0; t2 < 2; ++t2) {
                            const int kt = 2 * k2 + t2; float gs = 0.f;
#pragma unroll
                            for (int e = 0; e < 4; ++e) { const int n = 16 * kt + 4 * fq + e; const float p = (16 * n + 31 <= tq) ? fexp2(S[qg][t2][e] - cm[qg]) * cinv[qg] : 0.f; S[qg][t2][e] = p; gs += p; }
                            const float tsh = __shfl(S[qg][t2][3], (lane + 48) & 63);
                            float iv = gs + (fq == 0 ? carry[qg] : tsh); carry[qg] = tsh;
                            iv += __shfl_xor(iv, 4); iv += __shfl_xor(iv, 8);
                            if (hr == 0) IMP[(toff + 4 * qg) * 65 + 4 * kt + fq] = iv;
                        }
                        Pf[qg] = pack8(S[qg][0], S[qg][1]);
                    }
#pragma unroll
                    for (int dt = 0; dt < 4; ++dt) {
                        const bf16x8 vf = cat8(trrd(vb + (32 * k2) * RS + dt * 32), trrd(vb + (32 * k2 + 16) * RS + dt * 32));
                        O[0][dt] = mfma16(vf, Pf[0], O[0][dt]); O[1][dt] = mfma16(vf, Pf[1], O[1][dt]);
                    }
                }
#pragma unroll
                for (int qg = 0; qg < 2; ++qg)
#pragma unroll
                    for (int dt = 0; dt < 4; ++dt) acc_o[qg][dt] = acc_o[qg][dt] + O[qg][dt] * (nrep > 0 ? zf : gate[qg][0]);
            }
            __syncthreads();
            {
                const int tok = tid >> 3, sub = tid & 7; unsigned long long bits = 0ull;
                if (qb >= 16) {
                    for (int j = 1 + sub; j <= qb - 2; j += 8) {
                        const float vj = IMP[tok * 65 + j]; int rank = 0;
                        for (int jj = 1; jj <= qb - 2; ++jj) { const float uu = IMP[tok * 65 + jj]; rank += (uu > vj || (uu == vj && jj < j)) ? 1 : 0; }
                        if (rank < 13) bits |= 1ull << j;
                    }
                    unsigned blo = (unsigned)bits, bhi = (unsigned)(bits >> 32);
                    blo |= __shfl_xor(blo, 1); bhi |= __shfl_xor(bhi, 1); blo |= __shfl_xor(blo, 2); bhi |= __shfl_xor(bhi, 2); blo |= __shfl_xor(blo, 4); bhi |= __shfl_xor(bhi, 4);
                    bits = ((unsigned long long)bhi << 32) | blo;
                    bits |= 1ull | (1ull << qb) | (1ull << (qb - 1));
                } else bits = (2ull << qb) - 1ull;
                if (sub == 0) SELM[tok] = bits;
                __syncthreads();
                if (tid < 64) {
                    unsigned long long u = SELM[tid]; unsigned ulo = (unsigned)u, uhi = (unsigned)(u >> 32);
#pragma unroll
                    for (int o = 1; o < 64; o <<= 1) { ulo |= __shfl_xor(ulo, o); uhi |= __shfl_xor(uhi, o); }
                    if (tid == 0) UNI[0] = ((unsigned long long)uhi << 32) | ulo;
                }
                __syncthreads();
            }
            }
            unsigned long long selm[2] = {SELM[toff], SELM[toff + 4]};
            unsigned long long umask = UNI[0];
            { const unsigned ulo = __builtin_amdgcn_readfirstlane((unsigned)umask), uhi = __builtin_amdgcn_readfirstlane((unsigned)(umask >> 32)); umask = ((unsigned long long)uhi << 32) | ulo; }
            for (int nrep = ((NSA_REP >> 1) & 1); nrep >= 0; --nrep) { float zf = 0.f; asm volatile("" : "+v"(zf));
            if (!(DBG_SKIP & 4)) attn_branch(lds, (const bf16_t*)(ws + WS_KS) + (size_t)bg * SEQ * 64, (const bf16_t*)(ws + WS_VS) + (size_t)bg * SEQ * 64, umask, qb, 0, Qf, selm, fr, fq, toff, nrep > 0 ? zf : gate[0][1], nrep > 0 ? zf : gate[1][1], acc_o, tid); }
            { const int j0 = qb >= 8 ? qb - 8 : 0; const unsigned long long wm = ((2ull << qb) - 1ull) & ~((1ull << j0) - 1ull);
              for (int nrep = ((NSA_REP >> 2) & 1); nrep >= 0; --nrep) { float zf = 0.f; asm volatile("" : "+v"(zf));
              if (!(DBG_SKIP & 8)) attn_branch(lds, (const bf16_t*)(ws + WS_KW) + (size_t)bg * SEQ * 64, (const bf16_t*)(ws + WS_VW) + (size_t)bg * SEQ * 64, wm, qb, 1, Qf, selm, fr, fq, toff, nrep > 0 ? zf : gate[0][2], nrep > 0 ? zf : gate[1][2], acc_o, tid); } }
#pragma unroll
            for (int qg = 0; qg < 2; ++qg) {
                const size_t row = (size_t)b * SEQ + 64 * qb + toff + 4 * qg;
#pragma unroll
                for (int dt = 0; dt < 4; ++dt) *(u32x2*)(MIX + row * DM + 512 + head * 64 + 16 * dt + 4 * fq) = pack4(acc_o[qg][dt]);
            }
        }
        {
            int lane2_ = (int)__builtin_amdgcn_mbcnt_hi(~0u, __builtin_amdgcn_mbcnt_lo(~0u, 0u)); asm volatile("" : "+v"(lane2_));
            const int lane = lane2_, tid = wave * 64 + lane, fr = lane & 15, fq = lane >> 4;
            const bf16_t* RQ = (const bf16_t*)(ws + WS_RQ); const bf16_t* RK = (const bf16_t*)(ws + WS_RK); const bf16_t* RV = (const bf16_t*)(ws + WS_RV); const bf16_t* RG = (const bf16_t*)(ws + WS_RG);
            const float* KV = (const float*)(ws + WS_KVST); const float* gnw = args.in[opq(I_GNW)];
            u32x4 pk[2], pv[2]; f32x4 ps0, ps1; bf16x8 pq[2]; u32x2 pg[4];
#define R3_ISSUE(IT) do { const int n_ = (IT) & 31, h_ = ((IT) >> 5) & 7, b_ = (IT) >> 8; \
                _Pragma("unroll") for (int i = 0; i < 2; ++i) { const int ch = tid + i * NTHR, k = ch >> 3, c8 = ch & 7; const size_t src = ((size_t)(b_ * SEQ + n_ * 128 + k)) * 512 + h_ * 64 + c8 * 8; pk[i] = *(const u32x4*)(RK + src); pv[i] = *(const u32x4*)(RV + src); } \
                { const f32x4* sp = (const f32x4*)(KV + (size_t)(IT) * 4096 + (tid >> 3) * 64 + (tid & 7) * 8); ps0 = sp[0]; ps1 = sp[1]; } \
                { const size_t row_ = (size_t)b_ * SEQ + n_ * 128 + 16 * wave + fr; pq[0] = *(const bf16x8*)(RQ + row_ * 512 + h_ * 64 + 8 * fq); pq[1] = *(const bf16x8*)(RQ + row_ * 512 + h_ * 64 + 32 + 8 * fq); \
                  _Pragma("unroll") for (int dt = 0; dt < 4; ++dt) pg[dt] = *(const u32x2*)(RG + row_ * 512 + h_ * 64 + 16 * dt + 4 * fq); } } while (0)
            for (int rep3 = ((REP2 >> 1) & 1); rep3 >= 0; --rep3) {
            const int itend = (DBG_SKIP & 2) ? 0 : 2048;
            if (bid < itend) R3_ISSUE(bid);
            for (int it = bid; it < itend; it += G) {
                const int n = it & 31, h = (it >> 5) & 7, b = it >> 8;
                const float lg2 = log1pf(-exp2f(-5.f - (float)h)) * 1.4426950408889634f;
#pragma unroll
                for (int i = 0; i < 2; ++i) { const int ch = tid + i * NTHR, k = ch >> 3, c8 = ch & 7;
                    *(LAS u32x4*)(lds + k * RS + c8 * 16) = pk[i]; *(LAS u32x4*)(lds + 18432 + k * RS + c8 * 16) = pv[i]; }
                { const int e = tid >> 3, c8 = tid & 7;
                    u32x4 o; o.x = cvt_pk_bf16(ps0[0], ps0[1]); o.y = cvt_pk_bf16(ps0[2], ps0[3]); o.z = cvt_pk_bf16(ps1[0], ps1[1]); o.w = cvt_pk_bf16(ps1[2], ps1[3]);
                    *(LAS u32x4*)(lds + 36864 + e * RS + c8 * 16) = o; }
                bf16x8 Qf[2] = {pq[0], pq[1]}; u32x2 rgv[4] = {pg[0], pg[1], pg[2], pg[3]};
                __syncthreads();
                if (it + G < itend) R3_ISSUE(it + G);
                const int c = 16 * wave + fr; const size_t row = (size_t)b * SEQ + n * 128 + c;
                f32x4 O[4], X[4];
#pragma unroll
                for (int dt = 0; dt < 4; ++dt) { O[dt] = (f32x4){0.f, 0.f, 0.f, 0.f}; X[dt] = (f32x4){0.f, 0.f, 0.f, 0.f}; }
                const LAS unsigned char* kb = lds + fr * RS + fq * 16;
                const LAS unsigned char* vb = lds + 18432 + (4 * fq + (fr >> 2)) * RS + (fr & 3) * 8;
                for (int k2 = 0; k2 <= (wave >> 1); ++k2) {
                    f32x4 S0 = (f32x4){0.f, 0.f, 0.f, 0.f}, S1 = S0;
#pragma unroll
                    for (int ks = 0; ks < 2; ++ks) { S0 = mfma16(*(const LAS bf16x8*)(kb + (32 * k2) * RS + ks * 64), Qf[ks], S0); S1 = mfma16(*(const LAS bf16x8*)(kb + (32 * k2 + 16) * RS + ks * 64), Qf[ks], S1); }
#pragma unroll
                    for (int e = 0; e < 4; ++e) { const int d0 = c - (32 * k2 + 4 * fq + e), d1 = d0 - 16;
                        S0[e] = d0 >= 0 ? S0[e] * fexp2((float)d0 * lg2) : 0.f; S1[e] = d1 >= 0 ? S1[e] * fexp2((float)d1 * lg2) : 0.f; }
                    const bf16x8 pf = pack8(S0, S1);
#pragma unroll
                    for (int dt = 0; dt < 4; ++dt) O[dt] = mfma16(cat8(trrd(vb + (32 * k2) * RS + dt * 32), trrd(vb + (32 * k2 + 16) * RS + dt * 32)), pf, O[dt]);
                }
#pragma unroll
                for (int ks = 0; ks < 2; ++ks)
#pragma unroll
                    for (int dt = 0; dt < 4; ++dt) X[dt] = mfma16(*(const LAS bf16x8*)(lds + 36864 + (16 * dt + fr) * RS + ks * 64 + fq * 16), Qf[ks], X[dt]);
                const float qd = fexp2((float)(c + 1) * lg2);
                float s = 0.f;
#pragma unroll
                for (int dt = 0; dt < 4; ++dt) { O[dt] = O[dt] + X[dt] * qd; s += (O[dt][0] + O[dt][1]) + (O[dt][2] + O[dt][3]); }
                s += __shfl_xor(s, 16); s += __shfl_xor(s, 32);
                const float mu = s * (1.f / 64.f); float q = 0.f;
#pragma unroll
                for (int dt = 0; dt < 4; ++dt) { O[dt] = O[dt] - mu; q += (O[dt][0] * O[dt][0] + O[dt][1] * O[dt][1]) + (O[dt][2] * O[dt][2] + O[dt][3] * O[dt][3]); }
                q += __shfl_xor(q, 16); q += __shfl_xor(q, 32);
                const float rstd = rsqrtf(q * (1.f / 64.f) + EPS);
#pragma unroll
                for (int dt = 0; dt < 4; ++dt) {
                    const int e0 = h * 64 + 16 * dt + 4 * fq; const f32x4 gw = *(const f32x4*)(gnw + e0); const u32x2 rg = rgv[dt];
                    f32x4 o = O[dt] * rstd * gw;
                    o[0] *= __uint_as_float(rg.x << 16); o[1] *= __uint_as_float(rg.x & 0xffff0000u); o[2] *= __uint_as_float(rg.y << 16); o[3] *= __uint_as_float(rg.y & 0xffff0000u);
                    *(u32x2*)(MIX + row * DM + e0) = pack4(o);
                }
                __syncthreads();
            }
            }
#undef R3_ISSUE
        }
        if (rep > 0) { asm volatile("s_waitcnt vmcnt(0) lgkmcnt(0)" ::: "memory"); __syncthreads(); }
        }
    }
    SEAM(4);

    if (IN(5)) {
        PHASE_LOCALS
        for (int rep = ((REP_MASK >> 5) & 1); rep >= 0; --rep) {
        pg8::Gemm g{(const bf16_t*)out + (size_t)T * DM, (const bf16_t*)(ws + WS_WOUT), T, DM, DM, DM, DM}; pg8::StaticOrder S; S.init(T, DM, G, bid);
        EpiOut E{(const bf16_t*)(ws + WS_XS), (bf16_t*)out, (float*)(ws + WS_SS1), rep > 0 ? lnd_i(1) : 0};
        pg8::gemm_phase(lds, g, S, E, tid);
        if (rep > 0) { asm volatile("s_waitcnt vmcnt(0) lgkmcnt(0)" ::: "memory"); __syncthreads(); }
        }
    }
    SEAM(5);

    if (IN(6)) {
        PHASE_LOCALS
        for (int rep = ((REP_MASK >> 6) & 1); rep >= 0; --rep) {
        pg8::Gemm g{(const bf16_t*)out, (const bf16_t*)(ws + WS_WUP), T, 2 * DFF, DM, DM, DM}; pg8::StaticOrder S; S.init(T, 2 * DFF, G, bid);
        EpiUp E{(const float*)(ws + WS_SS1), args.in[opq(I_CONVW)], args.in[opq(I_CONVB)], (bf16_t*)(ws + WS_ACT), (float*)(ws + WS_SB)};
        pg8::gemm_phase(lds, g, S, E, tid);
        if (rep > 0) { asm volatile("s_waitcnt vmcnt(0) lgkmcnt(0)" ::: "memory"); __syncthreads(); }
        }
    }
    SEAM(6);

    if (IN(7)) {
        PHASE_LOCALS
        for (int rep = ((REP_MASK >> 7) & 1); rep >= 0; --rep) {
        const float* sb = (const float*)(ws + WS_SB); const float* cw = args.in[opq(I_CONVW)]; const float* cb = args.in[opq(I_CONVB)]; bf16_t* act = (bf16_t*)(ws + WS_ACT);
        for (int i = bid * NTHR + tid; i < 512 * 2 * (DFF / 4); i += G * NTHR) {
            const int c = (i % (DFF / 4)) * 4, ur = i / (DFF / 4), rr = ur & 1, u = ur >> 1; const bool first = (u & 63) == 0;
            const float* su = sb + (size_t)u * 6 * DFF + c; const float* sp = su - 6 * DFF;
            const f32x4 z4 = (f32x4){0.f, 0.f, 0.f, 0.f};
            const f32x4 gt = *(const f32x4*)(su + rr * DFF), vt = *(const f32x4*)(su + (2 + rr) * DFF);
            f32x4 g1, g2;
            if (rr == 0) { g1 = first ? z4 : *(const f32x4*)(sp + 5 * DFF); g2 = first ? z4 : *(const f32x4*)(sp + 4 * DFF); } else { g1 = *(const f32x4*)su; g2 = first ? z4 : *(const f32x4*)(sp + 5 * DFF); }
            const f32x4 gate = *(const f32x4*)(cb + c) + *(const f32x4*)(cw + c) * g2 + *(const f32x4*)(cw + DFF + c) * g1 + *(const f32x4*)(cw + 2 * DFF + c) * gt;
            f32x4 o; o[0] = siluf_(gate[0]) * vt[0]; o[1] = siluf_(gate[1]) * vt[1]; o[2] = siluf_(gate[2]) * vt[2]; o[3] = siluf_(gate[3]) * vt[3];
            *(u32x2*)(act + (size_t)(64 * u + rr) * DFF + c) = pack4(o);
        }
        if (rep > 0) { asm volatile("s_waitcnt vmcnt(0) lgkmcnt(0)" ::: "memory"); __syncthreads(); }
        }
    }
    SEAM(7);

    if (IN(8)) {
        PHASE_LOCALS
        for (int rep = ((REP_MASK >> 8) & 1); rep >= 0; --rep) {
        pg8::Gemm g{(const bf16_t*)(ws + WS_ACT), (const bf16_t*)(ws + WS_WDN), T, DM, DFF, DFF, DFF}; pg8::StaticOrder S; S.init(T, DM, G, bid);
        EpiDown E{(const bf16_t*)out, (bf16_t*)(ws + WS_HS), rep > 0 ? lnd_i(1) : 0};
        pg8::gemm_phase(lds, g, S, E, tid);
        if (rep > 0) { asm volatile("s_waitcnt vmcnt(0) lgkmcnt(0)" ::: "memory"); __syncthreads(); }
        }
    }
    SEAM(8);

    if (IN(9)) {
        PHASE_LOCALS
        for (int rep = ((REP_MASK >> 9) & 1); rep >= 0; --rep) {
        pg8::Gemm g{(const bf16_t*)(ws + WS_HS), (const bf16_t*)(ws + WS_WG), T, DM, DM, DM, DM}; pg8::StaticOrder S; S.init(T, DM, G, bid);
        EpiPle E{(const bf16_t*)(ws + WS_HS), (bf16_t*)(ws + WS_ACT), (const bf16_t*)(ws + WS_PE), (float*)(ws + WS_SS3), rep > 0 ? lnd_i(1) : 0};
        pg8::gemm_phase(lds, g, S, E, tid);
        if (rep > 0) { asm volatile("s_waitcnt vmcnt(0) lgkmcnt(0)" ::: "memory"); __syncthreads(); }
        }
    }
    SEAM(9);

    if (IN(10)) {
        PHASE_LOCALS
        const float* ss = (const float*)(ws + WS_SS3); const f32x4* wf = (const f32x4*)args.in[opq(I_FNW)]; f32x4* o4 = (f32x4*)out;
        const int gw = bid * 8 + wave, NGW = G * 8; const u32x2* h3 = (const u32x2*)(ws + WS_ACT);
        f32x4 wv[4];
#pragma unroll
        for (int j = 0; j < 4; ++j) wv[j] = wf[lane + 64 * j];
        for (int r0_ = gw * 4; r0_ < T; r0_ += NGW * 4) {
            u32x2 hv[4][4]; float rs[4];
#pragma unroll
            for (int rr = 0; rr < 4; ++rr) { rs[rr] = ss[r0_ + rr];
#pragma unroll
                for (int j = 0; j < 4; ++j) hv[rr][j] = h3[(size_t)(r0_ + rr) * 256 + lane + 64 * j]; }
#pragma unroll
            for (int rr = 0; rr < 4; ++rr) { const float sc = rsqrtf(rs[rr] * (1.f / DM) + EPS);
#pragma unroll
                for (int j = 0; j < 4; ++j) { const u32x2 hw = hv[rr][j];
                    o4[(size_t)(r0_ + rr) * 256 + lane + 64 * j] = (f32x4){__uint_as_float(hw.x << 16), __uint_as_float(hw.x & 0xffff0000u), __uint_as_float(hw.y << 16), __uint_as_float(hw.y & 0xffff0000u)} * sc * wv[j]; } }
        }
    }
#undef IN
#undef SEAM
}

extern "C" void kernel_launch(void* const* d_in, const int* in_sizes, int n_in, void* d_out, int out_size, void* d_ws, size_t ws_size, hipStream_t stream) {
    static int grid = 0;
    if (grid == 0) {
        if (n_in != 20 || out_size != T * DM || ws_size < WS_END) { fprintf(stderr, "kernel_launch: unexpected shapes (n_in %d out %d ws %zu)\n", n_in, out_size, ws_size); grid = -1; return; }
        int dev = 0, cus = 0, per_cu = 0;
        hipGetDevice(&dev); hipDeviceGetAttribute(&cus, hipDeviceAttributeMultiprocessorCount, dev);
        hipFuncSetAttribute((const void*)hymba_fwd, hipFuncAttributeMaxDynamicSharedMemorySize, LDS_BYTES);
        hipOccupancyMaxActiveBlocksPerMultiprocessor(&per_cu, (const void*)hymba_fwd, NTHR, LDS_BYTES);
        (void)hipGetLastError();
        if (per_cu < 1) { fprintf(stderr, "kernel_launch: occupancy query says %d blocks/CU\n", per_cu); per_cu = 1; }
        grid = cus;
    }
    if (grid < 0) return;
    Args a{};
    for (int i = 0; i < 20; ++i) a.in[i] = (const float*)d_in[i];
    a.out = (float*)d_out; a.ws = (unsigned char*)d_ws;
    const int NPH = 11;
#if N_LAUNCH_PER_PHASE
    for (int p = 0; p < NPH; ++p) {
        a.ph_lo = p; a.ph_hi = p + 1; void* args[] = {&a};
        hipError_t e = hipLaunchCooperativeKernel((const void*)hymba_fwd, dim3(grid), dim3(NTHR), args, LDS_BYTES, stream);
        if (e != hipSuccess) { fprintf(stderr, "launch %d failed: %s\n", p, hipGetErrorString(e)); break; }
    }
#else
    hipMemsetAsync((char*)d_ws + WS_BAR, 0, 16384, stream);
    a.ph_lo = 0; a.ph_hi = NPH; void* args[] = {&a};
    hipError_t e = hipLaunchCooperativeKernel((const void*)hymba_fwd, dim3(grid), dim3(NTHR), args, LDS_BYTES, stream);
    if (e != hipSuccess) fprintf(stderr, "cooperative launch failed: %s (grid %d)\n", hipGetErrorString(e), grid);
#endif
}
```

```cpp
#include <hip/hip_runtime.h>
#include <hip/hip_cooperative_groups.h>
#include <cstdio>
#include <cstdint>
namespace cg = cooperative_groups;

#ifndef XBAR
#define XBAR 0
#endif
#ifndef REP2
#define REP2 0
#endif
#ifndef NSA_REP
#define NSA_REP 0
#endif
#ifndef P0_REP
#define P0_REP 0
#endif
#ifndef REP_MASK
#define REP_MASK 0
#endif
#ifndef N_LAUNCH_PER_PHASE
#define N_LAUNCH_PER_PHASE 0
#endif

#define LAS __attribute__((address_space(3)))
typedef unsigned short bf16_t;
typedef short bf16x8 __attribute__((ext_vector_type(8)));
typedef short v4s __attribute__((ext_vector_type(4)));
typedef float f32x4 __attribute__((ext_vector_type(4)));
typedef float f32x2 __attribute__((ext_vector_type(2)));
typedef unsigned u32x4 __attribute__((ext_vector_type(4)));
typedef unsigned u32x2 __attribute__((ext_vector_type(2)));

constexpr int NB = 8, SEQ = 4096, DM = 1024, T = NB * SEQ;
constexpr int INW = 3352, INP = 3584;
constexpr int DFF = 2816, PLE = 256;
constexpr float EPS = 1e-6f;
constexpr float QSCALE = 0.125f * 1.4426950408889634f;
constexpr int NTHR = 512;

constexpr size_t MiB = 1u << 20;
constexpr size_t WS_WIN = 0, WS_WOUT = 8 * MiB, WS_WUP = 10 * MiB, WS_WDN = 22 * MiB, WS_WG = 28 * MiB, WS_WP = 30 * MiB;
constexpr size_t WS_W1K = 31 * MiB, WS_W1V = 32 * MiB, WS_W2K = 33 * MiB, WS_W2V = 33 * MiB + 65536;
constexpr size_t WS_C1P = 33 * MiB + 512 * 1024, WS_C1 = 33 * MiB + 768 * 1024;
constexpr size_t WS_COSR = 34 * MiB, WS_SINR = 38 * MiB, WS_COSN = 42 * MiB, WS_SINN = 43 * MiB;
constexpr size_t WS_R0 = 44 * MiB, WS_SS1 = 44 * MiB + 256 * 1024, WS_SS3 = 44 * MiB + 512 * 1024;
constexpr size_t WS_SB = 46 * MiB;
constexpr size_t WS_PE = 80 * MiB;
constexpr size_t WS_XS = 144 * MiB;
constexpr size_t WS_PB = 208 * MiB;
constexpr size_t WS_RQ = 224 * MiB, WS_RK = 256 * MiB, WS_RV = 288 * MiB, WS_RG = 320 * MiB, WS_NQ = 352 * MiB;
constexpr size_t WS_KC = 384 * MiB, WS_VC = 392 * MiB, WS_KS = 400 * MiB, WS_VS = 408 * MiB, WS_KW = 416 * MiB, WS_VW = 424 * MiB;
constexpr size_t WS_NG = 432 * MiB;
constexpr size_t WS_KVST = 436 * MiB;
constexpr size_t WS_HIDK = 468 * MiB, WS_HIDV = 470 * MiB, WS_CK = 472 * MiB, WS_CV = 472 * MiB + 512 * 1024;
constexpr size_t WS_HS = 224 * MiB;
constexpr size_t WS_ACT = 288 * MiB;
constexpr size_t WS_BAR = 474 * MiB;
constexpr size_t WS_END = 475 * MiB;

constexpr int LDS_BYTES = 147456;

typedef __bf16 bf16x2_t __attribute__((ext_vector_type(2)));
__device__ __forceinline__ unsigned cvt_pk_bf16(float lo, float hi) { const f32x2 v = {lo, hi}; const bf16x2_t b = __builtin_convertvector(v, bf16x2_t); return __builtin_bit_cast(unsigned, b); }
__device__ __forceinline__ float bf2f(unsigned short b) { return __uint_as_float(((unsigned)b) << 16); }
__device__ __forceinline__ float fexp2(float x) { return __builtin_amdgcn_exp2f(x); }
__device__ __forceinline__ float frcp(float x) { return __builtin_amdgcn_rcpf(x); }
__device__ __forceinline__ float sigmoidf_(float x) { return frcp(1.f + fexp2(-1.4426950408889634f * x)); }
__device__ __forceinline__ float siluf_(float x) { return x * sigmoidf_(x); }
__device__ __forceinline__ float gelu_tanh(float x) { const float u = 0.7978845608028654f * (x + 0.044715f * x * x * x); const float e = fexp2(2.f * 1.4426950408889634f * u); return 0.5f * x * (2.f - 2.f * frcp(1.f + e)); }
__device__ __forceinline__ v4s trrd(const LAS unsigned char* p) { return __builtin_amdgcn_ds_read_tr16_b64_v4i16((LAS v4s*)p); }
__device__ __forceinline__ bf16x8 cat8(v4s a, v4s b) { return __builtin_shufflevector(a, b, 0, 1, 2, 3, 4, 5, 6, 7); }
__device__ __forceinline__ f32x4 mfma16(bf16x8 a, bf16x8 b, f32x4 c) { return __builtin_amdgcn_mfma_f32_16x16x32_bf16(a, b, c, 0, 0, 0); }
__device__ __forceinline__ u32x2 pack4(f32x4 v) { u32x2 w; w.x = cvt_pk_bf16(v[0], v[1]); w.y = cvt_pk_bf16(v[2], v[3]); return w; }
__device__ __forceinline__ bf16x8 pack8(f32x4 a, f32x4 b) { u32x4 w; w.x = cvt_pk_bf16(a[0], a[1]); w.y = cvt_pk_bf16(a[2], a[3]); w.z = cvt_pk_bf16(b[0], b[1]); w.w = cvt_pk_bf16(b[2], b[3]); return __builtin_bit_cast(bf16x8, w); }
__device__ __forceinline__ float rows_max(float v) {
    auto a = __builtin_amdgcn_permlane16_swap(__float_as_uint(v), __float_as_uint(v), false, false); v = fmaxf(__uint_as_float(a[0]), __uint_as_float(a[1]));
    auto b = __builtin_amdgcn_permlane32_swap(__float_as_uint(v), __float_as_uint(v), false, false); return fmaxf(__uint_as_float(b[0]), __uint_as_float(b[1]));
}
__device__ __forceinline__ float rows_sum(float v) {
    auto a = __builtin_amdgcn_permlane16_swap(__float_as_uint(v), __float_as_uint(v), false, false); v = __uint_as_float(a[0]) + __uint_as_float(a[1]);
    auto b = __builtin_amdgcn_permlane32_swap(__float_as_uint(v), __float_as_uint(v), false, false); return __uint_as_float(b[0]) + __uint_as_float(b[1]);
}
template <int N> __device__ __forceinline__ float row_ror(float v) { return __uint_as_float((unsigned)__builtin_amdgcn_update_dpp(0, (int)__float_as_uint(v), 0x120 + N, 0xf, 0xf, false)); }
__device__ __forceinline__ void store_pair16(bf16_t* pX, bf16_t* pY, u32x2 X, u32x2 Y, int fq, bool okX, bool okY) {
    auto r0 = __builtin_amdgcn_permlane16_swap(X.x, Y.x, false, false); auto r1 = __builtin_amdgcn_permlane16_swap(X.y, Y.y, false, false);
    u32x4 o; o.x = r0[0]; o.y = r1[0]; o.z = r0[1]; o.w = r1[1];
    bf16_t* ad = (fq & 1) ? pY - 4 : pX; const bool ok = (fq & 1) ? okY : okX;
    if (ok) *(u32x4*)ad = o;
}
__device__ __forceinline__ void load_pair16(const bf16_t* pX, const bf16_t* pY, u32x2& X, u32x2& Y, int fq) {
    const u32x4 o = *(const u32x4*)((fq & 1) ? pY - 4 : pX);
    auto r0 = __builtin_amdgcn_permlane16_swap(o.x, o.z, false, false); auto r1 = __builtin_amdgcn_permlane16_swap(o.y, o.w, false, false);
    X.x = r0[0]; Y.x = r0[1]; X.y = r1[0]; Y.y = r1[1];
}
__device__ __forceinline__ float wave_sum(float v) {
#pragma unroll
    for (int o = 1; o < 64; o <<= 1) v += __shfl_xor(v, o);
    return v;
}

namespace pg8 {
constexpr int BM = 256, BK = 64, HALF = 128, HTB = HALF * BK * 2, STAGE_BYTES = 8 * HTB, NXCD = 8, WGM = 8;
__host__ __device__ __forceinline__ int lds_byte(int r, int c) { const int st = (r >> 4) * 2 + (c >> 5), rr = r & 15, cc = c & 31, ob = rr * 64 + cc * 2; return st * 1024 + (ob ^ (((ob >> 9) & 1) << 5)); }
__host__ __device__ __forceinline__ void stage_rc(int b, int& R, int& C) { const int st = b / 1024, sb = b % 1024, swz = sb ^ (((sb >> 9) & 1) << 5); R = (st >> 1) * 16 + swz / 64; C = (st & 1) * 32 + (swz % 64) / 2; }
struct Unit { int pm, pn; };
struct Gemm { const bf16_t* A; const bf16_t* Bt; int M, N, K, lda, ldb; };
struct StaticOrder {
    int nM, nN, nwg, G, c;
    __device__ void init(int M, int N, int G_, int c_) { nM = M / BM; nN = N / BM; nwg = nM * nN; G = G_; c = c_; }
    __device__ bool next(int i, Unit& u) const {
        const long L = (long)i * G + c; if (c < 0 || L >= nwg) return false;
        int wgid = (int)L; { const int q = nwg / NXCD, r = nwg % NXCD, xcd = wgid % NXCD, off = wgid / NXCD; wgid = (xcd < r ? xcd * (q + 1) : r * (q + 1) + (xcd - r) * q) + off; }
        const int nig = WGM * nN, gid = wgid / nig, fm = gid * WGM, gsz = (nM - fm) < WGM ? (nM - fm) : WGM;
        u.pm = fm + ((wgid % nig) % gsz); u.pn = (wgid % nig) / gsz; return true;
    }
};
template <class Epi>
__device__ __forceinline__ void gemm_phase(LAS unsigned char* lds, const Gemm g, const StaticOrder& S, const Epi& E, const int tid) {
    const int wid = __builtin_amdgcn_readfirstlane(tid >> 6), lane = tid & 63, wr = wid >> 2, wc = wid & 3, fr = lane & 15, fq = lane >> 4;
    const int K = g.K, nt = K / BK, lda = g.lda, ldb = g.ldb;
    unsigned voffA[2], voffB[2];
#pragma unroll
    for (int i = 0; i < 2; ++i) { int R, C; stage_rc(tid * 16 + i * 8192, R, C); voffA[i] = (unsigned)(R * lda + C) * 2u; voffB[i] = (unsigned)(R * ldb + C) * 2u; }
    const size_t kstep = (size_t)(BK * 2);
    const size_t hstepA = (size_t)HALF * lda * 2, hstepB = (size_t)HALF * ldb * 2;
    const size_t tstepA = 2 * hstepA, tstepB = 2 * hstepB;
    const unsigned ldsw = (unsigned)wid * 1024u;
    const int aoff = lds_byte(wr * 64 + fr, fq * 8), boff = lds_byte(wc * 32 + fr, fq * 8);
#define PG8_SA(b, h) (((b) * 2 + (h)) * HTB)
#define PG8_SB(b, h) ((4 + (b) * 2 + (h)) * HTB)
#define PG8_STAGE(bufoff, gbase, voff) do { _Pragma("unroll") for (int _i = 0; _i < 2; ++_i) \
        __builtin_amdgcn_global_load_lds((const unsigned*)((const char*)(gbase) + (voff)[_i]), (LAS unsigned*)(lds + (bufoff) + ldsw + _i * 8192), 16, 0, 0); } while (0)
#define PG8_LDA(dst, b, h) do { _Pragma("unroll") for (int m = 0; m < 4; ++m) _Pragma("unroll") for (int k = 0; k < 2; ++k) dst[m][k] = *(const LAS bf16x8*)(lds + PG8_SA(b, h) + aoff + m * 2048 + k * 1024); } while (0)
#define PG8_LDB(dst, b, h) do { _Pragma("unroll") for (int n = 0; n < 2; ++n) _Pragma("unroll") for (int k = 0; k < 2; ++k) dst[n][k] = *(const LAS bf16x8*)(lds + PG8_SB(b, h) + boff + n * 2048 + k * 1024); } while (0)
#define PG8_MMA(ai, bj, At, Bt) do { __builtin_amdgcn_s_setprio(1); _Pragma("unroll") for (int m = 0; m < 4; ++m) _Pragma("unroll") for (int n = 0; n < 2; ++n) _Pragma("unroll") for (int k = 0; k < 2; ++k) \
        acc[ai][bj][m][n] = __builtin_amdgcn_mfma_f32_16x16x32_bf16(Bt[n][k], At[m][k], acc[ai][bj][m][n], 0, 0, 0); __builtin_amdgcn_s_setprio(0); } while (0)
#define PG8_WAIT_V(n) asm volatile("s_waitcnt vmcnt(" #n ")" ::: "memory")
#define PG8_WAIT_L(n) asm volatile("s_waitcnt lgkmcnt(" #n ")" ::: "memory")
#define PG8_BAR __builtin_amdgcn_s_barrier()
#define PG8_SCHED __builtin_amdgcn_sched_barrier(0)
    Unit cur, nxt; int ui = 0;
    if (!S.next(0, cur)) return;
    f32x4 acc[2][2][4][2];
#pragma unroll
    for (int a = 0; a < 2; ++a)
#pragma unroll
        for (int b = 0; b < 2; ++b)
#pragma unroll
            for (int m = 0; m < 4; ++m)
#pragma unroll
                for (int n = 0; n < 2; ++n) acc[a][b][m][n] = (f32x4){0.f, 0.f, 0.f, 0.f};
    bf16x8 At[4][2], B0[2][2], B1[2][2];
    const char* cA = (const char*)g.A + (size_t)cur.pm * tstepA; const char* cB = (const char*)g.Bt + (size_t)cur.pn * tstepB;
    PG8_STAGE(PG8_SB(0, 0), cB, voffB); PG8_STAGE(PG8_SB(0, 1), cB + hstepB, voffB); PG8_STAGE(PG8_SA(0, 0), cA, voffA); PG8_STAGE(PG8_SA(0, 1), cA + hstepA, voffA);
    if (wr == 1) PG8_BAR;
    PG8_WAIT_V(2); PG8_BAR;
    PG8_STAGE(PG8_SB(1, 0), cB + kstep, voffB); PG8_STAGE(PG8_SA(1, 0), cA + kstep, voffA); PG8_STAGE(PG8_SB(1, 1), cB + hstepB + kstep, voffB);
    PG8_WAIT_V(6); PG8_BAR;
    for (;;) {
        const bool has_next = S.next(ui + 1, nxt);
        const char* nA = has_next ? (const char*)g.A + (size_t)nxt.pm * tstepA : cA; const char* nB = has_next ? (const char*)g.Bt + (size_t)nxt.pn * tstepB : cB;
        for (int t = 0; t < nt; t += 2) {
            const bool last = (t == nt - 2);
            const char* a1 = cA + (size_t)(t + 1) * kstep;
            const char* a2 = last ? nA : cA + (size_t)(t + 2) * kstep; const char* b2 = last ? nB : cB + (size_t)(t + 2) * kstep;
            const char* a3 = a2 + kstep; const char* b3 = b2 + kstep;
            PG8_LDB(B0, 0, 0); PG8_LDB(B1, 0, 1); PG8_SCHED; PG8_LDA(At, 0, 0); PG8_STAGE(PG8_SA(1, 1), a1 + hstepA, voffA);
            PG8_WAIT_V(8); PG8_WAIT_L(0); PG8_BAR; PG8_MMA(0, 0, At, B0); PG8_MMA(0, 1, At, B1); PG8_BAR; PG8_SCHED;
            PG8_LDA(At, 0, 1); PG8_STAGE(PG8_SB(0, 0), b2, voffB); PG8_STAGE(PG8_SB(0, 1), b2 + hstepB, voffB); PG8_STAGE(PG8_SA(0, 0), a2, voffA);
            PG8_WAIT_V(8); PG8_WAIT_L(0); PG8_BAR; PG8_MMA(1, 0, At, B0); PG8_MMA(1, 1, At, B1); PG8_BAR; PG8_SCHED;
            PG8_LDB(B0, 1, 0); PG8_LDB(B1, 1, 1); PG8_SCHED; PG8_LDA(At, 1, 0); PG8_STAGE(PG8_SA(0, 1), a2 + hstepA, voffA);
            PG8_WAIT_V(8); PG8_WAIT_L(0); PG8_BAR; PG8_MMA(0, 0, At, B0); PG8_MMA(0, 1, At, B1); PG8_BAR; PG8_SCHED;
            PG8_LDA(At, 1, 1); PG8_STAGE(PG8_SB(1, 0), b3, voffB); PG8_STAGE(PG8_SB(1, 1), b3 + hstepB, voffB); PG8_STAGE(PG8_SA(1, 0), a3, voffA);
            PG8_WAIT_V(8); PG8_WAIT_L(0); PG8_BAR; PG8_MMA(1, 0, At, B0); PG8_MMA(1, 1, At, B1); PG8_BAR; PG8_SCHED;
        }
        if (wr == 0) PG8_BAR;
        E(acc, cur, wr, wc, fr, fq);
        if (!has_next) break;
#pragma unroll
        for (int a = 0; a < 2; ++a)
#pragma unroll
            for (int b = 0; b < 2; ++b)
#pragma unroll
                for (int m = 0; m < 4; ++m)
#pragma unroll
                    for (int n = 0; n < 2; ++n) acc[a][b][m][n] = (f32x4){0.f, 0.f, 0.f, 0.f};
        cur = nxt; cA = nA; cB = nB; ++ui;
        if (wr == 1) PG8_BAR;
    }
    PG8_WAIT_V(0);
    PG8_BAR;
#undef PG8_SA
#undef PG8_SB
#undef PG8_STAGE
#undef PG8_LDA
#undef PG8_LDB
#undef PG8_MMA
#undef PG8_WAIT_V
#undef PG8_WAIT_L
#undef PG8_BAR
#undef PG8_SCHED
}
}
using pg8::Unit;
typedef f32x4 Acc[2][2][4][2];

struct EpiIn {
    const float* r0; const int* pos; unsigned char* ws;
    __device__ __forceinline__ void operator()(const Acc& acc, const Unit& u, int wr, int wc, int fr, int fq) const {
        const int tile = u.pn;
        f32x4 invr[2], invn;
#pragma unroll
        for (int e = 0; e < 4; ++e) { invr[0][e] = fexp2(-(float)(4 * fq + e) * (13.287712379549449f / 32.f)); invr[1][e] = fexp2(-(float)(16 + 4 * fq + e) * (13.287712379549449f / 32.f));
            invn[e] = fexp2(-(float)(4 * (fq & 1) + e) * (18.931568569324174f / 8.f)); }
        float rsv[2][4], pfv[2][4];
#pragma unroll
        for (int ai = 0; ai < 2; ++ai)
#pragma unroll
            for (int m = 0; m < 4; ++m) { const int row = u.pm * 256 + ai * 128 + wr * 64 + m * 16 + fr; rsv[ai][m] = r0[row]; pfv[ai][m] = (float)pos[row]; }
#pragma unroll
        for (int ai = 0; ai < 2; ++ai)
#pragma unroll
            for (int m = 0; m < 4; ++m) {
                const int row = u.pm * 256 + ai * 128 + wr * 64 + m * 16 + fr;
                const float rs = rsv[ai][m], pf = pfv[ai][m];
                if (tile < 4) {
                    bf16_t* dst = (bf16_t*)(ws + (tile < 2 ? WS_RQ : WS_RK)) + (size_t)row * 512 + ((tile & 1) * 4 + wc) * 64;
                    const float sc = tile < 2 ? rs : rs * 0.125f; u32x2 o1[2], o2[2];
#pragma unroll
                    for (int n = 0; n < 2; ++n) {
                        const int i0 = 16 * n + 4 * fq;
                        f32x4 c4, s4;
#pragma unroll
                        for (int e = 0; e < 4; ++e) { const float fv = __builtin_amdgcn_fractf(pf * invr[n][e] * 0.15915494309189535f); c4[e] = __builtin_amdgcn_cosf(fv); s4[e] = __builtin_amdgcn_sinf(fv); }
                        const f32x4 x1 = acc[ai][0][m][n] * sc, x2 = acc[ai][1][m][n] * sc;
                        o1[n] = pack4(x1 * c4 - x2 * s4); o2[n] = pack4(x1 * s4 + x2 * c4);
                    }
                    store_pair16(dst + 4 * fq, dst + 16 + 4 * fq, o1[0], o1[1], fq, true, true);
                    store_pair16(dst + 32 + 4 * fq, dst + 48 + 4 * fq, o2[0], o2[1], fq, true, true);
                } else if (tile < 8) {
                    bf16_t* dst = (bf16_t*)(ws + (tile < 6 ? WS_RV : WS_RG)) + (size_t)row * 512 + ((tile & 1) * 4 + wc) * 64;
#pragma unroll
                    for (int bj = 0; bj < 2; ++bj) { u32x2 ov[2];
#pragma unroll
                        for (int n = 0; n < 2; ++n) {
                            f32x4 v = acc[ai][bj][m][n] * rs;
                            if (tile >= 6) { v[0] = siluf_(v[0]); v[1] = siluf_(v[1]); v[2] = siluf_(v[2]); v[3] = siluf_(v[3]); }
                            ov[n] = pack4(v);
                        }
                        store_pair16(dst + 32 * bj + 4 * fq, dst + 32 * bj + 16 + 4 * fq, ov[0], ov[1], fq, true, true); }
                } else if (tile < 13) {
                    bf16_t* dst; bool roped; float sc = rs;
                    if (tile < 10) { dst = (bf16_t*)(ws + WS_NQ) + (size_t)row * 512 + ((tile & 1) * 4 + wc) * 64; roped = true; sc = rs * QSCALE; }
                    else { const int seg = wc >> 1, g = wc & 1, b = row >> 12, s = row & 4095;
                        const size_t base = (tile == 10 ? (seg ? WS_VC : WS_KC) : tile == 11 ? (seg ? WS_VS : WS_KS) : (seg ? WS_VW : WS_KW));
                        dst = (bf16_t*)(ws + base) + ((size_t)(b * 2 + g) * SEQ + s) * 64; roped = (seg == 0); }
                    f32x4 c4, s4;
#pragma unroll
                    for (int e = 0; e < 4; ++e) { const float fv = __builtin_amdgcn_fractf(pf * invn[e] * 0.15915494309189535f); c4[e] = __builtin_amdgcn_cosf(fv); s4[e] = __builtin_amdgcn_sinf(fv); }
#pragma unroll
                    for (int bj = 0; bj < 2; ++bj) { u32x2 ov[2];
#pragma unroll
                        for (int n = 0; n < 2; ++n) {
                            f32x4 v = acc[ai][bj][m][n] * sc;
                            if (bj == 0 && n == 0) {
                                f32x4 pr; pr[0] = __shfl_xor(v[0], 32); pr[1] = __shfl_xor(v[1], 32); pr[2] = __shfl_xor(v[2], 32); pr[3] = __shfl_xor(v[3], 32);
                                const f32x4 rot = (fq < 2) ? (v * c4 - pr * s4) : (pr * s4 + v * c4);
                                if (roped) v = rot;
                            }
                            ov[n] = pack4(v);
                        }
                        store_pair16(dst + 32 * bj + 4 * fq, dst + 32 * bj + 16 + 4 * fq, ov[0], ov[1], fq, true, true); }
                } else {
                    float* ng = (float*)(ws + WS_NG) + (size_t)row * 24;
                    if (wc == 0) {
                        const f32x4 v0 = acc[ai][0][m][0] * rs; f32x4 o;
                        o[0] = sigmoidf_(v0[0]); o[1] = sigmoidf_(v0[1]); o[2] = sigmoidf_(v0[2]); o[3] = sigmoidf_(v0[3]);
                        *(f32x4*)(ng + 4 * fq) = o;
                        if (fq < 2) { const f32x4 v1 = acc[ai][0][m][1] * rs; o[0] = sigmoidf_(v1[0]); o[1] = sigmoidf_(v1[1]); o[2] = sigmoidf_(v1[2]); o[3] = sigmoidf_(v1[3]); *(f32x4*)(ng + 16 + 4 * fq) = o; }
                    }
                }
            }
    }
};
template <int ACT> struct EpiBf16 {
    bf16_t* O; int ldc; const float* bias;
    __device__ __forceinline__ void operator()(const Acc& acc, const Unit& u, int wr, int wc, int fr, int fq) const {
#pragma unroll
        for (int ai = 0; ai < 2; ++ai)
#pragma unroll
            for (int m = 0; m < 4; ++m) {
                const int row = u.pm * 256 + ai * 128 + wr * 64 + m * 16 + fr;
#pragma unroll
                for (int bj = 0; bj < 2; ++bj) { u32x2 ov[2];
#pragma unroll
                    for (int n = 0; n < 2; ++n) {
                        const int col = u.pn * 256 + 128 * bj + 32 * wc + 16 * n + 4 * fq;
                        f32x4 v = acc[ai][bj][m][n];
                        if (ACT == 1) { const f32x4 bv = *(const f32x4*)(bias + col); v = v + bv; v[0] = gelu_tanh(v[0]); v[1] = gelu_tanh(v[1]); v[2] = gelu_tanh(v[2]); v[3] = gelu_tanh(v[3]); }
                        ov[n] = pack4(v);
                    }
                    bf16_t* pb_ = O + (size_t)row * ldc + u.pn * 256 + 128 * bj + 32 * wc + 4 * fq; store_pair16(pb_, pb_ + 16, ov[0], ov[1], fq, true, true); }
            }
    }
};
struct EpiF32 {
    float* O; int ldc;
    __device__ __forceinline__ void operator()(const Acc& acc, const Unit& u, int wr, int wc, int fr, int fq) const {
#pragma unroll
        for (int ai = 0; ai < 2; ++ai)
#pragma unroll
            for (int m = 0; m < 4; ++m) {
                const int row = u.pm * 256 + ai * 128 + wr * 64 + m * 16 + fr;
#pragma unroll
                for (int bj = 0; bj < 2; ++bj)
#pragma unroll
                    for (int n = 0; n < 2; ++n) *(f32x4*)(O + (size_t)row * ldc + u.pn * 256 + 128 * bj + 32 * wc + 16 * n + 4 * fq) = acc[ai][bj][m][n];
            }
    }
};
struct EpiOut {
    const bf16_t* xb; bf16_t* h1b; float* ss; int dry;
    __device__ __forceinline__ void operator()(const Acc& acc, const Unit& u, int wr, int wc, int fr, int fq) const {
        if (dry) { if (acc[0][0][0][0][0] == 1.2345e-30f) ss[0] = 0.f; return; }
#pragma unroll
        for (int ai = 0; ai < 2; ++ai) {
            u32x2 rv[4][2][2];
#pragma unroll
            for (int m = 0; m < 4; ++m)
#pragma unroll
                for (int bj = 0; bj < 2; ++bj) { const bf16_t* pl_ = xb + (size_t)(u.pm * 256 + ai * 128 + wr * 64 + m * 16 + fr) * DM + u.pn * 256 + 128 * bj + 32 * wc + 4 * fq; load_pair16(pl_, pl_ + 16, rv[m][bj][0], rv[m][bj][1], fq); }
#pragma unroll
            for (int m = 0; m < 4; ++m) {
                const int row = u.pm * 256 + ai * 128 + wr * 64 + m * 16 + fr; float sq = 0.f;
#pragma unroll
                for (int bj = 0; bj < 2; ++bj) { u32x2 ov[2];
#pragma unroll
                    for (int n = 0; n < 2; ++n) {
                        const u32x2 w = rv[m][bj][n];
                        const f32x4 h = (f32x4){__uint_as_float(w.x << 16), __uint_as_float(w.x & 0xffff0000u), __uint_as_float(w.y << 16), __uint_as_float(w.y & 0xffff0000u)} + acc[ai][bj][m][n];
                        ov[n] = pack4(h); sq += (h[0] * h[0] + h[1] * h[1]) + (h[2] * h[2] + h[3] * h[3]);
                    }
                    bf16_t* pb_ = h1b + (size_t)row * DM + u.pn * 256 + 128 * bj + 32 * wc + 4 * fq; store_pair16(pb_, pb_ + 16, ov[0], ov[1], fq, true, true); }
                sq += __shfl_xor(sq, 16); sq += __shfl_xor(sq, 32);
                if (fq == 0) atomicAdd(ss + row, sq);
            }
        }
    }
};
struct EpiUp {
    const float* ss1; const float* cw; const float* cb; bf16_t* act; float* sb;
    __device__ __forceinline__ void operator()(const Acc& acc, const Unit& u, int wr, int wc, int fr, int fq) const {
        float rsv[2][4];
#pragma unroll
        for (int ai = 0; ai < 2; ++ai)
#pragma unroll
            for (int m = 0; m < 4; ++m) rsv[ai][m] = ss1[u.pm * 256 + ai * 128 + wr * 64 + m * 16 + fr];
#pragma unroll
        for (int ai = 0; ai < 2; ++ai)
#pragma unroll
            for (int m = 0; m < 4; ++m) rsv[ai][m] = rsqrtf(rsv[ai][m] * (1.f / DM) + EPS);
#pragma unroll
        for (int n = 0; n < 2; ++n) {
            const int col = u.pn * 128 + wc * 32 + 16 * n + 4 * fq;
            const f32x4 w0 = *(const f32x4*)(cw + col), w1 = *(const f32x4*)(cw + DFF + col), w2 = *(const f32x4*)(cw + 2 * DFF + col), bb = *(const f32x4*)(cb + col);
#pragma unroll
            for (int ai = 0; ai < 2; ++ai) {
                const int unit = u.pm * 4 + ai * 2 + wr;
                f32x4 pg = (f32x4){0.f, 0.f, 0.f, 0.f}; u32x2 ppk = (u32x2){0u, 0u};
#pragma unroll
                for (int m = 0; m < 4; ++m) {
                    const int row = u.pm * 256 + ai * 128 + wr * 64 + m * 16 + fr;
                    const float rs = rsv[ai][m];
                    const f32x4 G = acc[ai][0][m][n] * rs, V = acc[ai][1][m][n] * rs; f32x4 a;
#pragma unroll
                    for (int e = 0; e < 4; ++e) {
                        const float a1 = row_ror<1>(G[e]), a2 = row_ror<2>(G[e]), b1 = row_ror<1>(pg[e]), b2 = row_ror<2>(pg[e]);
                        const float g1 = fr >= 1 ? a1 : b1, g2 = fr >= 2 ? a2 : b2;
                        const float gate = bb[e] + w0[e] * g2 + w1[e] * g1 + w2[e] * G[e];
                        a[e] = siluf_(gate) * V[e];
                    }
                    if (m == 0 && fr < 2) { *(f32x4*)(sb + ((size_t)unit * 6 + fr) * DFF + col) = G; *(f32x4*)(sb + ((size_t)unit * 6 + 2 + fr) * DFF + col) = V; }
                    if (m == 3 && fr >= 14) *(f32x4*)(sb + ((size_t)unit * 6 + 4 + (fr - 14)) * DFF + col) = G;
                    if ((m & 1) == 0) ppk = pack4(a);
                    else store_pair16(act + (size_t)(row - 16) * DFF + col, act + (size_t)row * DFF + col, ppk, pack4(a), fq, (m != 1) || (fr >= 2), true);
                    pg = G;
                }
            }
        }
    }
};
struct EpiDown {
    const bf16_t* h1b; bf16_t* hb; int dry;
    __device__ __forceinline__ void operator()(const Acc& acc, const Unit& u, int wr, int wc, int fr, int fq) const {
        if (dry) { if (acc[0][0][0][0][0] == 1.2345e-30f) hb[0] = 0; return; }
#pragma unroll
        for (int ai = 0; ai < 2; ++ai) {
            u32x2 rv[4][2][2];
#pragma unroll
            for (int m = 0; m < 4; ++m)
#pragma unroll
                for (int bj = 0; bj < 2; ++bj) { const bf16_t* pl_ = h1b + (size_t)(u.pm * 256 + ai * 128 + wr * 64 + m * 16 + fr) * DM + u.pn * 256 + 128 * bj + 32 * wc + 4 * fq; load_pair16(pl_, pl_ + 16, rv[m][bj][0], rv[m][bj][1], fq); }
#pragma unroll
            for (int m = 0; m < 4; ++m) {
                const int row = u.pm * 256 + ai * 128 + wr * 64 + m * 16 + fr;
#pragma unroll
                for (int bj = 0; bj < 2; ++bj) { u32x2 ov[2];
#pragma unroll
                    for (int n = 0; n < 2; ++n) { const u32x2 w = rv[m][bj][n];
                        ov[n] = pack4((f32x4){__uint_as_float(w.x << 16), __uint_as_float(w.x & 0xffff0000u), __uint_as_float(w.y << 16), __uint_as_float(w.y & 0xffff0000u)} + acc[ai][bj][m][n]); }
                    bf16_t* pb_ = hb + (size_t)row * DM + u.pn * 256 + 128 * bj + 32 * wc + 4 * fq; store_pair16(pb_, pb_ + 16, ov[0], ov[1], fq, true, true); }
            }
        }
    }
};
struct EpiPle {
    const bf16_t* h2b; bf16_t* h3b; const bf16_t* pe; float* ss; int dry;
    __device__ __forceinline__ void operator()(const Acc& acc, const Unit& u, int wr, int wc, int fr, int fq) const {
        if (dry) { if (acc[0][0][0][0][0] == 1.2345e-30f) h3b[0] = 0; return; }
#pragma unroll
        for (int ai = 0; ai < 2; ++ai)
#pragma unroll
            for (int mh = 0; mh < 2; ++mh) {
                u32x2 hv[2][2][2], pv[2][2][2];
#pragma unroll
                for (int mm = 0; mm < 2; ++mm)
#pragma unroll
                    for (int bj = 0; bj < 2; ++bj) { const size_t off = (size_t)(u.pm * 256 + ai * 128 + wr * 64 + (2 * mh + mm) * 16 + fr) * DM + u.pn * 256 + 128 * bj + 32 * wc + 4 * fq;
                        load_pair16(h2b + off, h2b + off + 16, hv[mm][bj][0], hv[mm][bj][1], fq); load_pair16(pe + off, pe + off + 16, pv[mm][bj][0], pv[mm][bj][1], fq); }
#pragma unroll
                for (int mm = 0; mm < 2; ++mm) {
                    const int m = 2 * mh + mm; const int row = u.pm * 256 + ai * 128 + wr * 64 + m * 16 + fr; float sq = 0.f;
#pragma unroll
                    for (int bj = 0; bj < 2; ++bj) { u32x2 ov[2];
#pragma unroll
                        for (int n = 0; n < 2; ++n) {
                            const u32x2 pw = pv[mm][bj][n], hw = hv[mm][bj][n]; const f32x4 a = acc[ai][bj][m][n];
                            f32x4 h = (f32x4){__uint_as_float(hw.x << 16), __uint_as_float(hw.x & 0xffff0000u), __uint_as_float(hw.y << 16), __uint_as_float(hw.y & 0xffff0000u)};
                            h[0] += sigmoidf_(a[0]) * __uint_as_float(pw.x << 16); h[1] += sigmoidf_(a[1]) * __uint_as_float(pw.x & 0xffff0000u);
                            h[2] += sigmoidf_(a[2]) * __uint_as_float(pw.y << 16); h[3] += sigmoidf_(a[3]) * __uint_as_float(pw.y & 0xffff0000u);
                            ov[n] = pack4(h); sq += (h[0] * h[0] + h[1] * h[1]) + (h[2] * h[2] + h[3] * h[3]);
                        }
                        bf16_t* pb_ = h3b + (size_t)row * DM + u.pn * 256 + 128 * bj + 32 * wc + 4 * fq; store_pair16(pb_, pb_ + 16, ov[0], ov[1], fq, true, true); }
                    sq += __shfl_xor(sq, 16); sq += __shfl_xor(sq, 32);
                    if (fq == 0) atomicAdd(ss + row, sq);
                }
            }
    }
};

__device__ __forceinline__ void tr_item(const float* W, int K, int N, bf16_t* WT, LAS float* scr, int k0, int np0, int src0, int lane, const float* ksc = nullptr) {
    const int q4 = lane & 7, kr = lane >> 3, sc = src0 + 4 * q4; const bool ok = sc < N;
#pragma unroll
    for (int i = 0; i < 8; ++i) { const int kk = 8 * i + kr; const f32x4 v = ok ? *(const f32x4*)(W + (size_t)(k0 + kk) * N + sc) : (f32x4){0.f, 0.f, 0.f, 0.f};
        LAS float* d = scr + kk * 33 + 4 * q4; d[0] = v[0]; d[1] = v[1]; d[2] = v[2]; d[3] = v[3]; }
    asm volatile("s_waitcnt lgkmcnt(0)" ::: "memory");
    const int c = lane & 7;
    f32x4 k0v = (f32x4){1.f, 1.f, 1.f, 1.f}, k1v = k0v;
    if (ksc) { k0v = *(const f32x4*)(ksc + k0 + 8 * c); k1v = *(const f32x4*)(ksc + k0 + 8 * c + 4); }
#pragma unroll
    for (int j = 0; j < 4; ++j) { const int n = (lane >> 3) + 8 * j; const LAS float* s = scr + (8 * c) * 33 + n;
        u32x4 o; o.x = cvt_pk_bf16(s[0 * 33] * k0v[0], s[1 * 33] * k0v[1]); o.y = cvt_pk_bf16(s[2 * 33] * k0v[2], s[3 * 33] * k0v[3]); o.z = cvt_pk_bf16(s[4 * 33] * k1v[0], s[5 * 33] * k1v[1]); o.w = cvt_pk_bf16(s[6 * 33] * k1v[2], s[7 * 33] * k1v[3]);
        *(u32x4*)(WT + (size_t)(np0 + n) * K + k0 + 8 * c) = o; }
    asm volatile("s_waitcnt lgkmcnt(0)" ::: "memory");
}

__device__ __forceinline__ int lnd_i(int v) { asm volatile("" : "+s"(v)); return v; }
template <class P> __device__ __forceinline__ P* lnd_p(P* p) { asm volatile("" : "+s"(p)); return p; }
#define PHASE_LOCALS const int wave = lnd_i(wave0); int lane_ = (int)__builtin_amdgcn_mbcnt_hi(~0u, __builtin_amdgcn_mbcnt_lo(~0u, 0u)); asm volatile("" : "+v"(lane_)); const int lane = lane_, tid = wave * 64 + lane, fr = lane & 15, fq = lane >> 4; (void)fr; (void)fq; (void)wave; const int G = lnd_i(G0), bid = lnd_i(bid0); unsigned char* ws = lnd_p(args.ws); float* out = lnd_p(args.out); (void)G; (void)bid; (void)ws; (void)out;
struct Args { const float* in[20]; float* out; unsigned char* ws; int ph_lo, ph_hi; };
__device__ __forceinline__ int opq(int i) { int r; asm volatile("s_mov_b32 %0, %1" : "=s"(r) : "i"(i)); return r; }
enum { I_X = 0, I_P, I_POS, I_NMIX, I_WIN, I_GNW, I_CPOS, I_KW1, I_KW2, I_VW1, I_VW2, I_WOUT, I_NFFN, I_WUP, I_CONVW, I_CONVB, I_WDN, I_PLEW, I_PLEG, I_FNW };

constexpr int RS = 144;
__device__ __forceinline__ void attn_tile(const int MODE, const LAS unsigned char* Kl, const LAS unsigned char* Vl, const bf16x8 (&Qf)[2][2],
                                          float (&mx)[2], f32x4 (&ls)[2], f32x4 (&O)[2][4], int fr, int fq, int toff, const bool (&rsel)[2]) {
    const bf16x8 ones8 = {0x3f80, 0x3f80, 0x3f80, 0x3f80, 0x3f80, 0x3f80, 0x3f80, 0x3f80};
    f32x4 S[2][4];
#pragma unroll
    for (int qg = 0; qg < 2; ++qg) {
        const float ci = (MODE == 0 && !rsel[qg]) ? -INFINITY : -mx[qg];
#pragma unroll
        for (int kt = 0; kt < 4; ++kt) S[qg][kt] = (f32x4){ci, ci, ci, ci};
    }
    const LAS unsigned char* kb = Kl + fr * RS + fq * 16;
#pragma unroll
    for (int ks = 0; ks < 2; ++ks) {
        bf16x8 kf[4];
#pragma unroll
        for (int kt = 0; kt < 4; ++kt) kf[kt] = *(const LAS bf16x8*)(kb + kt * 16 * RS + ks * 64);
        __builtin_amdgcn_sched_barrier(0);
#pragma unroll
        for (int kt = 0; kt < 4; ++kt) { S[0][kt] = mfma16(kf[kt], Qf[0][ks], S[0][kt]); S[1][kt] = mfma16(kf[kt], Qf[1][ks], S[1][kt]); }
    }
    const LAS unsigned char* vb = Vl + (4 * fq + (fr >> 2)) * RS + (fr & 3) * 8;
    bf16x8 Pf[2][2];
#pragma unroll
    for (int qg = 0; qg < 2; ++qg) {
        const int to = toff + 4 * qg;
        float rm = -INFINITY;
        if (MODE != 0) {
#pragma unroll
            for (int kt = 0; kt < 4; ++kt)
#pragma unroll
                for (int e = 0; e < 4; ++e) { const int ko = 16 * kt + 4 * fq + e; const bool ok = (MODE == 1) ? (ko <= to) : (ko > to); S[qg][kt][e] = ok ? S[qg][kt][e] : -INFINITY; }
        }
#pragma unroll
        for (int kt = 0; kt < 4; ++kt)
#pragma unroll
            for (int e = 0; e < 4; ++e) rm = fmaxf(rm, S[qg][kt][e]);
        rm = rows_max(rm);
        const bool was = __float_as_uint(mx[qg]) != 0x80000000u;
        const bool need = was ? (rm > 8.f) : (rm > -INFINITY);
        if (__builtin_amdgcn_ballot_w64(need) != 0ull) {
            const float delta = need ? rm : 0.f, f = (need && was) ? fexp2(-delta) : 1.f;
            mx[qg] += delta;
            ls[qg] = ls[qg] * f;
#pragma unroll
            for (int dt = 0; dt < 4; ++dt) O[qg][dt] = O[qg][dt] * f;
#pragma unroll
            for (int kt = 0; kt < 4; ++kt) S[qg][kt] = S[qg][kt] - delta;
        }
#pragma unroll
        for (int kt = 0; kt < 4; ++kt)
#pragma unroll
            for (int e = 0; e < 4; ++e) S[qg][kt][e] = fexp2(S[qg][kt][e]);
        Pf[qg][0] = pack8(S[qg][0], S[qg][1]); Pf[qg][1] = pack8(S[qg][2], S[qg][3]);
    }
#pragma unroll
    for (int kk = 0; kk < 2; ++kk) {
        bf16x8 vf[4];
#pragma unroll
        for (int dt = 0; dt < 4; ++dt) vf[dt] = cat8(trrd(vb + (32 * kk) * RS + dt * 32), trrd(vb + (32 * kk + 16) * RS + dt * 32));
        __builtin_amdgcn_sched_barrier(0);
#pragma unroll
        for (int dt = 0; dt < 4; ++dt) { O[0][dt] = mfma16(vf[dt], Pf[0][kk], O[0][dt]); O[1][dt] = mfma16(vf[dt], Pf[1][kk], O[1][dt]); }
        ls[0] = mfma16(ones8, Pf[0][kk], ls[0]); ls[1] = mfma16(ones8, Pf[1][kk], ls[1]);
    }
}

__device__ __forceinline__ void attn_branch(LAS unsigned char* lds, const bf16_t* Kg, const bf16_t* Vg, unsigned long long tmask, int qb, int is_win,
                                            const bf16x8 (&Qf)[2][2], const unsigned long long (&selm)[2], int fr, int fq, int toff, float gate0, float gate1, f32x4 (&acc_o)[2][4], const int tid) {
    const int lrow = tid >> 3, lch = tid & 7;
    float mx[2] = {-0.f, -0.f}; f32x4 ls[2] = {(f32x4){0.f, 0.f, 0.f, 0.f}, (f32x4){0.f, 0.f, 0.f, 0.f}}; f32x4 O[2][4];
#pragma unroll
    for (int qg = 0; qg < 2; ++qg)
#pragma unroll
        for (int dt = 0; dt < 4; ++dt) O[qg][dt] = (f32x4){0.f, 0.f, 0.f, 0.f};
    int j = __builtin_ctzll(tmask); tmask &= tmask - 1;
    int cur = 0;
    {
        const u32x4 kv = *(const u32x4*)(Kg + ((size_t)(64 * j + lrow)) * 64 + lch * 8), vv = *(const u32x4*)(Vg + ((size_t)(64 * j + lrow)) * 64 + lch * 8);
        *(LAS u32x4*)(lds + lrow * RS + lch * 16) = kv; *(LAS u32x4*)(lds + 9216 + lrow * RS + lch * 16) = vv;
    }
    __syncthreads();
    for (;;) {
        const bool more = tmask != 0ull; int jn = 0; u32x4 kv, vv;
        if (more) { jn = __builtin_ctzll(tmask); tmask &= tmask - 1;
            kv = *(const u32x4*)(Kg + ((size_t)(64 * jn + lrow)) * 64 + lch * 8); vv = *(const u32x4*)(Vg + ((size_t)(64 * jn + lrow)) * 64 + lch * 8); }
        bool rsel[2] = {true, true};
        const LAS unsigned char* Kl = lds + cur * 18432; const LAS unsigned char* Vl = Kl + 9216;
        int mode = 0;
        if (j == qb) mode = 1;
        else if (is_win) { if (j == qb - 8) mode = 2; }
        else { rsel[0] = (selm[0] >> j) & 1ull; rsel[1] = (selm[1] >> j) & 1ull; }
        attn_tile(mode, Kl, Vl, Qf, mx, ls, O, fr, fq, toff, rsel);
        if (!more) break;
        cur ^= 1;
        *(LAS u32x4*)(lds + cur * 18432 + lrow * RS + lch * 16) = kv; *(LAS u32x4*)(lds + cur * 18432 + 9216 + lrow * RS + lch * 16) = vv;
        __syncthreads();
        j = jn;
    }
    __syncthreads();
#pragma unroll
    for (int qg = 0; qg < 2; ++qg) {
        const float l = ls[qg][0];
        const float sc = (qg ? gate1 : gate0) * (l > 0.f ? frcp(l) : 0.f);
#pragma unroll
        for (int dt = 0; dt < 4; ++dt) acc_o[qg][dt] = acc_o[qg][dt] + O[qg][dt] * sc;
    }
}

#define XB_TMO      128
#define XB_XCNT(j)  (256  + 64 * (j))
#define XB_XSUB(j)  (1280 + 64 * (j))
#define XB_XGEN(j)  (2304 + 64 * (j))
#define XB_TOP      3328
#define XB_TOPGEN   3392
#define XCD_BAR_WORDS 3456
#define XB_SPIN_CAP (1u << 22)
__device__ __forceinline__ unsigned xb_ld(unsigned* p)              { return __hip_atomic_load(p, __ATOMIC_RELAXED, __HIP_MEMORY_SCOPE_AGENT); }
__device__ __forceinline__ unsigned xb_add(unsigned* p, unsigned v) { return __hip_atomic_fetch_add(p, v, __ATOMIC_RELAXED, __HIP_MEMORY_SCOPE_AGENT); }
__device__ __forceinline__ unsigned xb_xcc_id() { return (unsigned)__builtin_amdgcn_s_getreg((3 << 11) | 20) & 0xFu; }
#define XB_SPIN(cond, bar) do { unsigned _sp = 0; while (cond) { __builtin_amdgcn_s_sleep(1); \
    if ((++_sp & 255u) == 0u) { if (xb_ld(&(bar)[XB_TMO])) break; if (_sp > XB_SPIN_CAP) { atomicAdd(&(bar)[XB_TMO], 1u); break; } } } } while (0)
__device__ __forceinline__ void xcd_barrier_complete(unsigned* bar, unsigned x, unsigned G, unsigned& nloc, unsigned& nx) {
    unsigned sum, cnt, mine, sp = 0u;
    for (;;) {
        sum = 0u; cnt = 0u; mine = 0u;
#pragma unroll
        for (unsigned j = 0; j < 16; ++j) { const unsigned c = xb_ld(&bar[XB_XCNT(j)]); sum += c; cnt += (c > 0u) ? 1u : 0u; mine = (j == x) ? c : mine; }
        if (sum == G) break;
        __builtin_amdgcn_s_sleep(1);
        if ((++sp & 255u) == 0u) { if (xb_ld(&bar[XB_TMO])) break; if (sp > XB_SPIN_CAP) { atomicAdd(&bar[XB_TMO], 1u); break; } }
    }
    nloc = mine > 0u ? mine : 1u; nx = cnt > 0u ? cnt : 1u;
}
__device__ __forceinline__ void xcd_barrier(unsigned* bar, unsigned x, volatile LAS unsigned* st, unsigned G, bool is_leader) {
    asm volatile("s_waitcnt vmcnt(0)" ::: "memory");
    __syncthreads();
    if (is_leader) {
        __builtin_amdgcn_s_waitcnt(0);
        unsigned nloc = st[0], nx = st[1];
        if (nloc == 0u) { xcd_barrier_complete(bar, x, G, nloc, nx); st[0] = nloc; st[1] = nx; }
        const unsigned old = xb_add(&bar[XB_XSUB(x)], 1u);
        const unsigned gen = old / nloc;
        if (old + 1u == (gen + 1u) * nloc) {
            __builtin_amdgcn_fence(__ATOMIC_RELEASE, "agent");
            asm volatile("s_waitcnt vmcnt(0)" ::: "memory");
            const unsigned og = xb_add(&bar[XB_TOP], 1u);
            const unsigned tg = og / nx;
            if (og + 1u == (tg + 1u) * nx) xb_add(&bar[XB_TOPGEN], 1u);
            else XB_SPIN(xb_ld(&bar[XB_TOPGEN]) == tg, bar);
            __builtin_amdgcn_fence(__ATOMIC_ACQUIRE, "agent");
            xb_add(&bar[XB_XGEN(x)], 1u);
            asm volatile("s_waitcnt vmcnt(0)" ::: "memory");
        } else {
            XB_SPIN(xb_ld(&bar[XB_XGEN(x)]) == gen, bar);
            __builtin_amdgcn_fence(__ATOMIC_ACQUIRE, "agent");
            asm volatile("s_waitcnt vmcnt(0)" ::: "memory");
        }
    }
    __syncthreads();
}

__global__ void __launch_bounds__(NTHR, 2) hymba_fwd(Args args) {
    extern __shared__ __attribute__((aligned(16))) unsigned char lds_raw[];
    LAS unsigned char* lds = (LAS unsigned char*)lds_raw;
    cg::grid_group grid = cg::this_grid();
    const int G0 = gridDim.x, bid0 = blockIdx.x, wave0 = __builtin_amdgcn_readfirstlane((int)threadIdx.x >> 6);
    const int lo = args.ph_lo, hi = args.ph_hi;
#define IN(k) (lo <= (k) && (k) < hi)
    unsigned* const barw = (unsigned*)(args.ws + WS_BAR);
    volatile LAS unsigned* const xst = (volatile LAS unsigned*)(lds + 147200);
    const bool xlead = (wave0 == 0) && (__builtin_amdgcn_mbcnt_hi(~0u, __builtin_amdgcn_mbcnt_lo(~0u, 0u)) == 0u);
    const unsigned xcc = xb_xcc_id();
    if (hi - lo > 1) { if (xlead) { xst[0] = 0u; xst[1] = 0u; (void)xb_add(&barw[XB_XCNT(xcc)], 1u); } __syncthreads(); }
#define SEAM(k) do { if (IN(k) && IN((k) + 1)) xcd_barrier(barw, xcc, xst, (unsigned)G0, xlead); } while (0)
    if (lo < 0) grid.sync();

    if (IN(0)) {
        PHASE_LOCALS
        for (int rep = ((REP_MASK >> 0) & 1); rep >= 0; --rep) {
        LAS float* scr = (LAS float*)(lds + wave * 16384);
        const int gw = bid * 8 + wave, NGW = G * 8;
        constexpr int I0 = 16 * (INP / 32), I1 = 16 * 32, I2 = 16 * (2 * DFF / 32), I3 = (DFF / 64) * 32, I4 = 16 * 32, I5 = 4 * 32, I6 = 32 * 8, I7 = 32 * 8, I8 = 4 * 2, I9 = 4 * 2;
        constexpr int NIT = I0 + I1 + I2 + I3 + I4 + I5 + I6 + I7 + I8 + I9;
        for (int r0_ = (P0_REP & 1); r0_ >= 0; --r0_)
        for (int it = gw; it < NIT; it += NGW) {
            int r = it;
            if (r < I0) { const int nblk = INP / 32, kb = r / nblk, nb = r % nblk, np0 = nb * 32, tile = np0 >> 8, p = np0 & 255;
                const int src = tile < 13 ? tile * 256 + 64 * ((p >> 5) & 3) + 32 * (p >> 7) : 3328 + p;
                tr_item(args.in[opq(I_WIN)], DM, INW, (bf16_t*)(ws + WS_WIN), scr, kb * 64, np0, src, lane, args.in[opq(I_NMIX)]); continue; } r -= I0;
            if (r < I1) { tr_item(args.in[opq(I_WOUT)], DM, DM, (bf16_t*)(ws + WS_WOUT), scr, (r / 32) * 64, (r % 32) * 32, (r % 32) * 32, lane); continue; } r -= I1;
            if (r < I2) { const int nblk = 2 * DFF / 32, kb = r / nblk, nb = r % nblk, np0 = nb * 32, tile = np0 >> 8, p = np0 & 255;
                const int src = (p >> 7) * DFF + tile * 128 + (p & 127);
                tr_item(args.in[opq(I_WUP)], DM, 2 * DFF, (bf16_t*)(ws + WS_WUP), scr, kb * 64, np0, src, lane, args.in[opq(I_NFFN)]); continue; } r -= I2;
            if (r < I3) { tr_item(args.in[opq(I_WDN)], DFF, DM, (bf16_t*)(ws + WS_WDN), scr, (r / 32) * 64, (r % 32) * 32, (r % 32) * 32, lane); continue; } r -= I3;
            if (r < I4) { tr_item(args.in[opq(I_PLEG)], DM, DM, (bf16_t*)(ws + WS_WG), scr, (r / 32) * 64, (r % 32) * 32, (r % 32) * 32, lane); continue; } r -= I4;
            if (r < I5) { tr_item(args.in[opq(I_PLEW)], PLE, DM, (bf16_t*)(ws + WS_WP), scr, (r / 32) * 64, (r % 32) * 32, (r % 32) * 32, lane); continue; } r -= I5;
            if (r < I6) { tr_item(args.in[opq(I_KW1)], 2048, 256, (bf16_t*)(ws + WS_W1K), scr, (r / 8) * 64, (r % 8) * 32, (r % 8) * 32, lane); continue; } r -= I6;
            if (r < I7) { tr_item(args.in[opq(I_VW1)], 2048, 256, (bf16_t*)(ws + WS_W1V), scr, (r / 8) * 64, (r % 8) * 32, (r % 8) * 32, lane); continue; } r -= I7;
            if (r < I8) { tr_item(args.in[opq(I_KW2)], 256, 64, (bf16_t*)(ws + WS_W2K), scr, (r / 2) * 64, (r % 2) * 32, (r % 2) * 32, lane); continue; } r -= I8;
            tr_item(args.in[opq(I_VW2)], 256, 64, (bf16_t*)(ws + WS_W2V), scr, (r / 2) * 64, (r % 2) * 32, (r % 2) * 32, lane);
        }
        {
            const float* x = args.in[opq(I_X)]; bf16_t* xs = (bf16_t*)(ws + WS_XS); float* r0 = (float*)(ws + WS_R0);
            for (int r1_ = ((P0_REP >> 1) & 1); r1_ >= 0; --r1_)
            for (int m0 = gw * 4; m0 < T; m0 += NGW * 4) {
                f32x4 v[4][4];
#pragma unroll
                for (int rr = 0; rr < 4; ++rr)
#pragma unroll
                    for (int j = 0; j < 4; ++j) v[rr][j] = __builtin_nontemporal_load((const f32x4*)(x + (size_t)(m0 + rr) * DM) + lane + 64 * j);
                float s[4];
#pragma unroll
                for (int rr = 0; rr < 4; ++rr) { s[rr] = 0.f;
#pragma unroll
                    for (int j = 0; j < 4; ++j) s[rr] += (v[rr][j][0] * v[rr][j][0] + v[rr][j][1] * v[rr][j][1]) + (v[rr][j][2] * v[rr][j][2] + v[rr][j][3] * v[rr][j][3]); }
#pragma unroll
                for (int o = 1; o < 64; o <<= 1) { s[0] += __shfl_xor(s[0], o); s[1] += __shfl_xor(s[1], o); s[2] += __shfl_xor(s[2], o); s[3] += __shfl_xor(s[3], o); }
                if (lane < 4) r0[m0 + lane] = rsqrtf((lane == 0 ? s[0] : lane == 1 ? s[1] : lane == 2 ? s[2] : s[3]) * (1.f / DM) + EPS);
#pragma unroll
                for (int j = 0; j < 4; ++j) {
#pragma unroll
                    for (int rr = 0; rr < 4; ++rr) *(u32x2*)(xs + (size_t)(m0 + rr) * DM + 4 * lane + 256 * j) = pack4(v[rr][j]); }
            }
        }
        const int gt = bid * NTHR + tid, NGT = G * NTHR;
        { const f32x4* p4 = (const f32x4*)args.in[opq(I_P)]; u32x2* pb = (u32x2*)(ws + WS_PB);
            for (int r2_ = ((P0_REP >> 2) & 1); r2_ >= 0; --r2_)
#pragma unroll 8
            for (int i = gt; i < T * PLE / 4; i += NGT) pb[i] = pack4(__builtin_nontemporal_load(p4 + i)); }
        { float* z1 = (float*)(ws + WS_SS1); float* z3 = (float*)(ws + WS_SS3); for (int i = gt; i < T; i += NGT) { z1[i] = 0.f; z3[i] = 0.f; } }
        { float* c1p = (float*)(ws + WS_C1P); const float* cp = args.in[opq(I_CPOS)];
            for (int r4_ = ((P0_REP >> 4) & 1); r4_ >= 0; --r4_)
            for (int i = gt; i < 16 * 512; i += NGT) { const int kc = i >> 9, o = i & 511; const float* w1 = ((o >> 8) ? args.in[opq(I_VW1)] : args.in[opq(I_KW1)]); const int n = o & 255; float s = 0.f;
#pragma unroll 32
                for (int k = kc * 128; k < kc * 128 + 128; ++k) s += cp[k] * w1[(size_t)k * 256 + n];
                c1p[i] = s; } }
        if (rep > 0) { asm volatile("s_waitcnt vmcnt(0) lgkmcnt(0)" ::: "memory"); __syncthreads(); }
        }
    }
    SEAM(0);
    for (int xb = 0; xb < XBAR; ++xb) { SEAM(0); }

    if (IN(1)) {
        PHASE_LOCALS
        for (int rep = ((REP_MASK >> 1) & 1); rep >= 0; --rep) {
        if (bid == 0) { const float* c1p = (const float*)(ws + WS_C1P); float s = 0.f; for (int k = 0; k < 16; ++k) s += c1p[k * 512 + tid]; ((float*)(ws + WS_C1))[tid] = s; }
        {
            pg8::Gemm g{(const bf16_t*)(ws + WS_XS), (const bf16_t*)(ws + WS_WIN), T, INP, DM, DM, DM}; pg8::StaticOrder S; S.init(T, INP, G, bid);
            for (int rep4 = ((REP2 >> 2) & 1); rep4 >= 0; --rep4) {
            EpiIn E{(const float*)(ws + WS_R0), (const int*)args.in[opq(I_POS)], ws};
            pg8::gemm_phase(lds, g, S, E, tid); }
        }
        if (rep > 0) { asm volatile("s_waitcnt vmcnt(0) lgkmcnt(0)" ::: "memory"); __syncthreads(); }
        }
    }
    SEAM(1);

    if (IN(2)) {
        PHASE_LOCALS
        for (int rep = ((REP_MASK >> 2) & 1); rep >= 0; --rep) {
        const int ngemm = (G >= 128) ? 64 : 0;
        {
            for (int q = bid; q < 64; q += G) {
                const int kv = q >> 5, ks = (q >> 4) & 1;
                pg8::Gemm g{(const bf16_t*)(ws + (kv ? WS_VC : WS_KC)) + ks * 1024, (const bf16_t*)(ws + (kv ? WS_W1V : WS_W1K)) + ks * 1024, 4096, 256, 1024, 1024, 2048};
                pg8::StaticOrder S; S.init(4096, 256, 16, q & 15);
                EpiF32 E{(float*)(ws + WS_SB) + (size_t)(kv * 2 + ks) * 4096 * 256, 256};
                pg8::gemm_phase(lds, g, S, E, tid);
            }
        }
        if (bid >= ngemm) {
            const bf16_t* RK = (const bf16_t*)(ws + WS_RK); const bf16_t* RV = (const bf16_t*)(ws + WS_RV); float* KV = (float*)(ws + WS_KVST);
            for (int it = bid - ngemm; it < 2048; it += G - ngemm) {
                const int n = it & 31, h = (it >> 5) & 7, b = it >> 8;
                const float lg2 = log1pf(-exp2f(-5.f - (float)h)) * 1.4426950408889634f;
#pragma unroll
                for (int i = 0; i < 2; ++i) {
                    const int ch = tid + i * NTHR, k = ch >> 3, c8 = ch & 7; const size_t src = ((size_t)(b * SEQ + n * 128 + k)) * 512 + h * 64 + c8 * 8;
                    const u32x4 kr = *(const u32x4*)(RK + src), vr = *(const u32x4*)(RV + src);
                    const float dk = fexp2((float)(127 - k) * lg2); u32x4 ko;
                    ko.x = cvt_pk_bf16(__uint_as_float(kr.x << 16) * dk, __uint_as_float(kr.x & 0xffff0000u) * dk); ko.y = cvt_pk_bf16(__uint_as_float(kr.y << 16) * dk, __uint_as_float(kr.y & 0xffff0000u) * dk);
                    ko.z = cvt_pk_bf16(__uint_as_float(kr.z << 16) * dk, __uint_as_float(kr.z & 0xffff0000u) * dk); ko.w = cvt_pk_bf16(__uint_as_float(kr.w << 16) * dk, __uint_as_float(kr.w & 0xffff0000u) * dk);
                    *(LAS u32x4*)(lds + k * RS + c8 * 16) = ko; *(LAS u32x4*)(lds + 18432 + k * RS + c8 * 16) = vr;
                }
                __syncthreads();
                const LAS unsigned char* tb = lds + (4 * fq + (fr >> 2)) * RS + (fr & 3) * 8;
#pragma unroll
                for (int tt = 0; tt < 2; ++tt) {
                    const int et = (2 * wave + tt) >> 2, dt = (2 * wave + tt) & 3; f32x4 a = (f32x4){0.f, 0.f, 0.f, 0.f};
#pragma unroll
                    for (int kk = 0; kk < 4; ++kk) {
                        const bf16x8 af = cat8(trrd(tb + 18432 + (32 * kk) * RS + et * 32), trrd(tb + 18432 + (32 * kk + 16) * RS + et * 32));
                        const bf16x8 bf = cat8(trrd(tb + (32 * kk) * RS + dt * 32), trrd(tb + (32 * kk + 16) * RS + dt * 32));
                        a = mfma16(af, bf, a);
                    }
                    float* dst = KV + (size_t)it * 4096 + (16 * et + 4 * fq) * 64 + 16 * dt + fr;
                    dst[0] = a[0]; dst[64] = a[1]; dst[128] = a[2]; dst[192] = a[3];
                }
                __syncthreads();
            }
        }
        if (rep > 0) { asm volatile("s_waitcnt vmcnt(0) lgkmcnt(0)" ::: "memory"); __syncthreads(); }
        }
    }
    SEAM(2);

    if (IN(3)) {
        PHASE_LOCALS
        for (int rep = ((REP_MASK >> 3) & 1); rep >= 0; --rep) {
        for (int it = bid * 8 + wave; it < 512; it += G * 8) {
            const int kv = it >> 8, r0 = (it & 255) * 16;
            const bf16_t* w2 = (const bf16_t*)(ws + (kv ? WS_W2V : WS_W2K)); bf16_t* o = (bf16_t*)(ws + (kv ? WS_CV : WS_CK));
            f32x4 a[4];
#pragma unroll
            for (int nt = 0; nt < 4; ++nt) a[nt] = (f32x4){0.f, 0.f, 0.f, 0.f};
#pragma unroll 2
            for (int ks = 0; ks < 8; ++ks) {
                bf16x8 hf;
                { const float* p0 = (const float*)(ws + WS_SB) + ((size_t)(kv * 2) * 4096 + r0 + fr) * 256 + 32 * ks + 8 * fq; const float* p1 = p0 + (size_t)4096 * 256;
                  const float* cb = (const float*)(ws + WS_C1) + kv * 256 + 32 * ks + 8 * fq;
                  f32x4 a0 = *(const f32x4*)p0 + *(const f32x4*)p1 + *(const f32x4*)cb, a1 = *(const f32x4*)(p0 + 4) + *(const f32x4*)(p1 + 4) + *(const f32x4*)(cb + 4);
#pragma unroll
                  for (int e = 0; e < 4; ++e) { a0[e] = gelu_tanh(a0[e]); a1[e] = gelu_tanh(a1[e]); }
                  hf = pack8(a0, a1); }
#pragma unroll
                for (int nt = 0; nt < 4; ++nt) { const bf16x8 wf = *(const bf16x8*)(w2 + (size_t)(16 * nt + fr) * 256 + 32 * ks + 8 * fq); a[nt] = mfma16(wf, hf, a[nt]); }
            }
#pragma unroll
            for (int nt = 0; nt < 4; ++nt) *(u32x2*)(o + (size_t)(r0 + fr) * 64 + 16 * nt + 4 * fq) = pack4(a[nt]);
        }
        float* KV = (float*)(ws + WS_KVST);
        for (int i = bid * NTHR + tid; i < 64 * 4096; i += G * NTHR) {
            const int bh = i >> 12, el = i & 4095, h = bh & 7;
            const float cd = fexp2(128.f * log1pf(-exp2f(-5.f - (float)h)) * 1.4426950408889634f);
            float* p = KV + (size_t)bh * 32 * 4096 + el; float s = 0.f;
#pragma unroll
            for (int n0 = 0; n0 < 32; n0 += 8) { float t[8];
#pragma unroll
                for (int n = 0; n < 8; ++n) t[n] = p[(size_t)(n0 + n) * 4096];
#pragma unroll
                for (int n = 0; n < 8; ++n) { p[(size_t)(n0 + n) * 4096] = s; s = s * cd + t[n]; } }
        }
        {
            pg8::Gemm g{(const bf16_t*)(ws + WS_PB), (const bf16_t*)(ws + WS_WP), T, DM, PLE, PLE, PLE}; pg8::StaticOrder S; S.init(T, DM, G, bid);
            EpiBf16<0> E{(bf16_t*)(ws + WS_PE), DM, nullptr};
            pg8::gemm_phase(lds, g, S, E, tid);
        }
        if (rep > 0) { asm volatile("s_waitcnt vmcnt(0) lgkmcnt(0)" ::: "memory"); __syncthreads(); }
        }
    }
    SEAM(3);

    if (IN(4)) {
        PHASE_LOCALS
        for (int rep = ((REP_MASK >> 4) & 1); rep >= 0; --rep) {
        bf16_t* MIX = (bf16_t*)out + (size_t)T * DM;
        LAS unsigned char* CKl = lds + 36864; LAS unsigned char* CVl = lds + 73728; LAS float* IMP = (LAS float*)(lds + 110592);
        LAS unsigned long long* SELM = (LAS unsigned long long*)(lds + 127232); LAS unsigned long long* UNI = (LAS unsigned long long*)(lds + 127744);
        const bf16_t* NQ = (const bf16_t*)(ws + WS_NQ); const float* NG = (const float*)(ws + WS_NG);
#ifndef DBG_SKIP
#define DBG_SKIP 0
#endif
        for (int rep2 = (REP2 & 1); rep2 >= 0; --rep2)
        for (int it = bid; it < ((DBG_SKIP & 1) ? 0 : 1024); it += G) {
            const int vb_ = it & 255, v = (G == 256) ? ((vb_ & 7) * 32 + (vb_ >> 3)) : vb_, kq = it >> 8, bg = v >> 4, s16 = v & 15;
            const int qb = (kq == 0) ? s16 : (kq == 1) ? 31 - s16 : (kq == 2) ? 32 + s16 : 63 - s16;
            const int b = bg >> 1, g = bg & 1;
            const int hr = fr >> 2, toff = 8 * wave + (fr & 3);
            const int head = g * 4 + hr;
            bf16x8 Qf[2][2]; float gate[2][3]; f32x4 acc_o[2][4];
#pragma unroll
            for (int qg = 0; qg < 2; ++qg) {
                const size_t row = (size_t)b * SEQ + 64 * qb + toff + 4 * qg;
#pragma unroll
                for (int ks = 0; ks < 2; ++ks) Qf[qg][ks] = *(const bf16x8*)(NQ + row * 512 + head * 64 + 32 * ks + 8 * fq);
#pragma unroll
                for (int br = 0; br < 3; ++br) gate[qg][br] = NG[row * 24 + head * 3 + br];
#pragma unroll
                for (int dt = 0; dt < 4; ++dt) acc_o[qg][dt] = (f32x4){0.f, 0.f, 0.f, 0.f};
                if (DBG_SKIP & 16) { gate[qg][0] = 1.f; gate[qg][1] = 1.f; gate[qg][2] = 1.f; }
                if (DBG_SKIP & 32) { const bf16x8 cq = {0x3c00, 0x3c80, 0x3d00, 0x3c00, 0x3d80, 0x3c00, 0x3c80, 0x3d00}; Qf[qg][0] = cq; Qf[qg][1] = cq; }
            }
            for (int nrep = (NSA_REP & 1); nrep >= 0; --nrep) {
            float zf = 0.f; asm volatile("" : "+v"(zf));
            const int ncv = (4 * qb + 3 < 255) ? 4 * qb + 3 : 255, NT2 = (ncv + 31) >> 5;
            {
                const bf16_t* ckg = (const bf16_t*)(ws + WS_CK) + (size_t)bg * 256 * 64; const bf16_t* cvg = (const bf16_t*)(ws + WS_CV) + (size_t)bg * 256 * 64;
                int ch0_ = tid; asm volatile("" : "+v"(ch0_));
                for (int ch = ch0_; ch < NT2 * 32 * 8; ch += NTHR) { const int r = ch >> 3, c8 = ch & 7;
                    u32x4 a_ = *(const u32x4*)(ckg + r * 64 + c8 * 8), b_ = *(const u32x4*)(cvg + r * 64 + c8 * 8);
                    if (DBG_SKIP & 128) { a_ = *(const u32x4*)((const bf16_t*)(ws + WS_HIDK) + ((size_t)bg * 256 + r) * 256 + c8 * 8); b_ = *(const u32x4*)((const bf16_t*)(ws + WS_HIDV) + ((size_t)bg * 256 + r) * 256 + c8 * 8); }
                    if (DBG_SKIP & 64) { const unsigned pz = 0x3c003c00u + ((unsigned)((r * 7 + c8 * 3) & 63) << 16) + (unsigned)((r * 5 + c8) & 31); a_ = (u32x4){pz, pz + 1u, pz + 2u, pz + 3u}; b_ = (u32x4){pz + 4u, pz + 5u, pz + 6u, pz + 7u}; }
                    *(LAS u32x4*)(CKl + r * RS + c8 * 16) = a_; *(LAS u32x4*)(CVl + r * RS + c8 * 16) = b_; }
            }
            __syncthreads();
            float cm[2] = {-1e30f, -1e30f}, cl[2] = {0.f, 0.f};
            const LAS unsigned char* kb = CKl + fr * RS + fq * 16;
            for (int kt = 0; kt < 2 * NT2; ++kt) {
                f32x4 S[2] = {(f32x4){0.f, 0.f, 0.f, 0.f}, (f32x4){0.f, 0.f, 0.f, 0.f}};
#pragma unroll
                for (int ks = 0; ks < 2; ++ks) { const bf16x8 kf = *(const LAS bf16x8*)(kb + kt * 16 * RS + ks * 64); S[0] = mfma16(kf, Qf[0][ks], S[0]); S[1] = mfma16(kf, Qf[1][ks], S[1]); }
#pragma unroll
                for (int qg = 0; qg < 2; ++qg) {
                    const int tq = 64 * qb + toff + 4 * qg; float rm = -INFINITY;
#pragma unroll
                    for (int e = 0; e < 4; ++e) { const int n = 16 * kt + 4 * fq + e; const float vv = (16 * n + 31 <= tq) ? S[qg][e] : -INFINITY; S[qg][e] = vv; rm = fmaxf(rm, vv); }
                    rm = rows_max(rm);
                    const float mn = fmaxf(cm[qg], rm); float sum = 0.f;
#pragma unroll
                    for (int e = 0; e < 4; ++e) sum += fexp2(S[qg][e] - mn);
                    cl[qg] = cl[qg] * fexp2(cm[qg] - mn) + sum; cm[qg] = mn;
                }
            }
            float cinv[2];
#pragma unroll
            for (int qg = 0; qg < 2; ++qg) { float l = cl[qg]; l = rows_sum(l); cinv[qg] = l > 0.f ? frcp(l) : 0.f; }
            {
                f32x4 O[2][4];
#pragma unroll
                for (int qg = 0; qg < 2; ++qg)
#pragma unroll
                    for (int dt = 0; dt < 4; ++dt) O[qg][dt] = (f32x4){0.f, 0.f, 0.f, 0.f};
                float carry[2] = {0.f, 0.f};
                const LAS unsigned char* vb = CVl + (4 * fq + (fr >> 2)) * RS + (fr & 3) * 8;
                for (int k2 = 0; k2 < NT2; ++k2) {
                    f32x4 S[2][2];
#pragma unroll
                    for (int qg = 0; qg < 2; ++qg) { S[qg][0] = (f32x4){0.f, 0.f, 0.f, 0.f}; S[qg][1] = (f32x4){0.f, 0.f, 0.f, 0.f}; }
#pragma unroll
                    for (int ks = 0; ks < 2; ++ks)
#pragma unroll
                        for (int t2 = 0; t2 < 2; ++t2) { const bf16x8 kf = *(const LAS bf16x8*)(kb + (2 * k2 + t2) * 16 * RS + ks * 64); S[0][t2] = mfma16(kf, Qf[0][ks], S[0][t2]); S[1][t2] = mfma16(kf, Qf[1][ks], S[1][t2]); }
                    bf16x8 Pf[2];
#pragma unroll
                    for (int qg = 0; qg < 2; ++qg) {
                        const int tq = 64 * qb + toff + 4 * qg;
#pragma unroll
                        for (int t2 = 0; t2 < 2; ++t2) {
                            const int kt = 2 * k2 + t2; float gs = 0.f;
#pragma unroll
                            for (int e = 0; e < 4; ++e) { const int n = 16 * kt + 4 * fq + e; const float p = (16 * n + 31 <= tq) ? fexp2(S[qg][t2][e] - cm[qg]) * cinv[qg] : 0.f; S[qg][t2][e] = p; gs += p; }
                            const float tsh = __shfl(S[qg][t2][3], (lane + 48) & 63);
                            float iv = gs + (fq == 0 ? carry[qg] : tsh); carry[qg] = tsh;
                            iv += __shfl_xor(iv, 4); iv += __shfl_xor(iv, 8);
                            if (hr == 0) IMP[(toff + 4 * qg) * 65 + 4 * kt + fq] = iv;
                        }
                        Pf[qg] = pack8(S[qg][0], S[qg][1]);
                    }
#pragma unroll
                    for (int dt = 0; dt < 4; ++dt) {
                        const bf16x8 vf = cat8(trrd(vb + (32 * k2) * RS + dt * 32), trrd(vb + (32 * k2 + 16) * RS + dt * 32));
                        O[0][dt] = mfma16(vf, Pf[0], O[0][dt]); O[1][dt] = mfma16(vf, Pf[1], O[1][dt]);
                    }
                }
#pragma unroll
                for (int qg = 0; qg < 2; ++qg)
#pragma unroll
                    for (int dt = 0; dt < 4; ++dt) acc_o[qg][dt] = acc_o[qg][dt] + O[qg][dt] * (nrep > 0 ? zf : gate[qg][0]);
            }
            __syncthreads();
            {
                const int tok = tid >> 3, sub = tid & 7; unsigned long long bits = 0ull;
                if (qb >= 16) {
                    for (int j = 1 + sub; j <= qb - 2; j += 8) {
                        const float vj = IMP[tok * 65 + j]; int rank = 0;
                        for (int jj = 1; jj <= qb - 2; ++jj) { const float uu = IMP[tok * 65 + jj]; rank += (uu > vj || (uu == vj && jj < j)) ? 1 : 0; }
                        if (rank < 13) bits |= 1ull << j;
                    }
                    unsigned blo = (unsigned)bits, bhi = (unsigned)(bits >> 32);
                    blo |= __shfl_xor(blo, 1); bhi |= __shfl_xor(bhi, 1); blo |= __shfl_xor(blo, 2); bhi |= __shfl_xor(bhi, 2); blo |= __shfl_xor(blo, 4); bhi |= __shfl_xor(bhi, 4);
                    bits = ((unsigned long long)bhi << 32) | blo;
                    bits |= 1ull | (1ull << qb) | (1ull << (qb - 1));
                } else bits = (2ull << qb) - 1ull;
                if (sub == 0) SELM[tok] = bits;
                __syncthreads();
                if (tid < 64) {
                    unsigned long long u = SELM[tid]; unsigned ulo = (unsigned)u, uhi = (unsigned)(u >> 32);
#pragma unroll
                    for (int o = 1; o < 64; o <<= 1) { ulo |= __shfl_xor(ulo, o); uhi |= __shfl_xor(uhi, o); }
                    if (tid == 0) UNI[0] = ((unsigned long long)uhi << 32) | ulo;
                }
                __syncthreads();
            }
            }
            unsigned long long selm[2] = {SELM[toff], SELM[toff + 4]};
            unsigned long long umask = UNI[0];
            { const unsigned ulo = __builtin_amdgcn_readfirstlane((unsigned)umask), uhi = __builtin_amdgcn_readfirstlane((unsigned)(umask >> 32)); umask = ((unsigned long long)uhi << 32) | ulo; }
            for (int nrep = ((NSA_REP >> 1) & 1); nrep >= 0; --nrep) { float zf = 0.f; asm volatile("" : "+v"(zf));
            if (!(DBG_SKIP & 4)) attn_branch(lds, (const bf16_t*)(ws + WS_KS) + (size_t)bg * SEQ * 64, (const bf16_t*)(ws + WS_VS) + (size_t)bg * SEQ * 64, umask, qb, 0, Qf, selm, fr, fq, toff, nrep > 0 ? zf : gate[0][1], nrep > 0 ? zf : gate[1][1], acc_o, tid); }
            { const int j0 = qb >= 8 ? qb - 8 : 0; const unsigned long long wm = ((2ull << qb) - 1ull) & ~((1ull << j0) - 1ull);
              for (int nrep = ((NSA_REP >> 2) & 1); nrep >= 0; --nrep) { float zf = 0.f; asm volatile("" : "+v"(zf));
              if (!(DBG_SKIP & 8)) attn_branch(lds, (const bf16_t*)(ws + WS_KW) + (size_t)bg * SEQ * 64, (const bf16_t*)(ws + WS_VW) + (size_t)bg * SEQ * 64, wm, qb, 1, Qf, selm, fr, fq, toff, nrep > 0 ? zf : gate[0][2], nrep > 0 ? zf : gate[1][2], acc_o, tid); } }
#pragma unroll
            for (int qg = 0; qg < 2; ++qg) {
                const size_t row = (size_t)b * SEQ + 64 * qb + toff + 4 * qg;
#pragma unroll
                for (int dt = 0; dt < 4; ++dt) *(u32x2*)(MIX + row * DM + 512 + head * 64 + 16 * dt + 4 * fq) = pack4(acc_o[qg][dt]);
            }
        }
        {
            int lane2_ = (int)__builtin_amdgcn_mbcnt_hi(~0u, __builtin_amdgcn_mbcnt_lo(~0u, 0u)); asm volatile("" : "+v"(lane2_));
            const int lane = lane2_, tid = wave * 64 + lane, fr = lane & 15, fq = lane >> 4;
            const bf16_t* RQ = (const bf16_t*)(ws + WS_RQ); const bf16_t* RK = (const bf16_t*)(ws + WS_RK); const bf16_t* RV = (const bf16_t*)(ws + WS_RV); const bf16_t* RG = (const bf16_t*)(ws + WS_RG);
            const float* KV = (const float*)(ws + WS_KVST); const float* gnw = args.in[opq(I_GNW)];
            u32x4 pk[2], pv[2]; f32x4 ps0, ps1; bf16x8 pq[2]; u32x2 pg[4];
#define R3_ISSUE(IT) do { const int n_ = (IT) & 31, h_ = ((IT) >> 5) & 7, b_ = (IT) >> 8; \
                _Pragma("unroll") for (int i = 0; i < 2; ++i) { const int ch = tid + i * NTHR, k = ch >> 3, c8 = ch & 7; const size_t src = ((size_t)(b_ * SEQ + n_ * 128 + k)) * 512 + h_ * 64 + c8 * 8; pk[i] = *(const u32x4*)(RK + src); pv[i] = *(const u32x4*)(RV + src); } \
                { const f32x4* sp = (const f32x4*)(KV + (size_t)(IT) * 4096 + (tid >> 3) * 64 + (tid & 7) * 8); ps0 = sp[0]; ps1 = sp[1]; } \
                { const size_t row_ = (size_t)b_ * SEQ + n_ * 128 + 16 * wave + fr; pq[0] = *(const bf16x8*)(RQ + row_ * 512 + h_ * 64 + 8 * fq); pq[1] = *(const bf16x8*)(RQ + row_ * 512 + h_ * 64 + 32 + 8 * fq); \
                  _Pragma("unroll") for (int dt = 0; dt < 4; ++dt) pg[dt] = *(const u32x2*)(RG + row_ * 512 + h_ * 64 + 16 * dt + 4 * fq); } } while (0)
            for (int rep3 = ((REP2 >> 1) & 1); rep3 >= 0; --rep3) {
            const int itend = (DBG_SKIP & 2) ? 0 : 2048;
            if (bid < itend) R3_ISSUE(bid);
            for (int it = bid; it < itend; it += G) {
                const int n = it & 31, h = (it >> 5) & 7, b = it >> 8;
                const float lg2 = log1pf(-exp2f(-5.f - (float)h)) * 1.4426950408889634f;
#pragma unroll
                for (int i = 0; i < 2; ++i) { const int ch = tid + i * NTHR, k = ch >> 3, c8 = ch & 7;
                    *(LAS u32x4*)(lds + k * RS + c8 * 16) = pk[i]; *(LAS u32x4*)(lds + 18432 + k * RS + c8 * 16) = pv[i]; }
                { const int e = tid >> 3, c8 = tid & 7;
                    u32x4 o; o.x = cvt_pk_bf16(ps0[0], ps0[1]); o.y = cvt_pk_bf16(ps0[2], ps0[3]); o.z = cvt_pk_bf16(ps1[0], ps1[1]); o.w = cvt_pk_bf16(ps1[2], ps1[3]);
                    *(LAS u32x4*)(lds + 36864 + e * RS + c8 * 16) = o; }
                bf16x8 Qf[2] = {pq[0], pq[1]}; u32x2 rgv[4] = {pg[0], pg[1], pg[2], pg[3]};
                __syncthreads();
                if (it + G < itend) R3_ISSUE(it + G);
                const int c = 16 * wave + fr; const size_t row = (size_t)b * SEQ + n * 128 + c;
                f32x4 O[4], X[4];
#pragma unroll
                for (int dt = 0; dt < 4; ++dt) { O[dt] = (f32x4){0.f, 0.f, 0.f, 0.f}; X[dt] = (f32x4){0.f, 0.f, 0.f, 0.f}; }
                const LAS unsigned char* kb = lds + fr * RS + fq * 16;
                const LAS unsigned char* vb = lds + 18432 + (4 * fq + (fr >> 2)) * RS + (fr & 3) * 8;
                for (int k2 = 0; k2 <= (wave >> 1); ++k2) {
                    f32x4 S0 = (f32x4){0.f, 0.f, 0.f, 0.f}, S1 = S0;
#pragma unroll
                    for (int ks = 0; ks < 2; ++ks) { S0 = mfma16(*(const LAS bf16x8*)(kb + (32 * k2) * RS + ks * 64), Qf[ks], S0); S1 = mfma16(*(const LAS bf16x8*)(kb + (32 * k2 + 16) * RS + ks * 64), Qf[ks], S1); }
#pragma unroll
                    for (int e = 0; e < 4; ++e) { const int d0 = c - (32 * k2 + 4 * fq + e), d1 = d0 - 16;
                        S0[e] = d0 >= 0 ? S0[e] * fexp2((float)d0 * lg2) : 0.f; S1[e] = d1 >= 0 ? S1[e] * fexp2((float)d1 * lg2) : 0.f; }
                    const bf16x8 pf = pack8(S0, S1);
#pragma unroll
                    for (int dt = 0; dt < 4; ++dt) O[dt] = mfma16(cat8(trrd(vb + (32 * k2) * RS + dt * 32), trrd(vb + (32 * k2 + 16) * RS + dt * 32)), pf, O[dt]);
                }
#pragma unroll
                for (int ks = 0; ks < 2; ++ks)
#pragma unroll
                    for (int dt = 0; dt < 4; ++dt) X[dt] = mfma16(*(const LAS bf16x8*)(lds + 36864 + (16 * dt + fr) * RS + ks * 64 + fq * 16), Qf[ks], X[dt]);
                const float qd = fexp2((float)(c + 1) * lg2);
                float s = 0.f;
#pragma unroll
                for (int dt = 0; dt < 4; ++dt) { O[dt] = O[dt] + X[dt] * qd; s += (O[dt][0] + O[dt][1]) + (O[dt][2] + O[dt][3]); }
                s += __shfl_xor(s, 16); s += __shfl_xor(s, 32);
                const float mu = s * (1.f / 64.f); float q = 0.f;
#pragma unroll
                for (int dt = 0; dt < 4; ++dt) { O[dt] = O[dt] - mu; q += (O[dt][0] * O[dt][0] + O[dt][1] * O[dt][1]) + (O[dt][2] * O[dt][2] + O[dt][3] * O[dt][3]); }
                q += __shfl_xor(q, 16); q += __shfl_xor(q, 32);
                const float rstd = rsqrtf(q * (1.f / 64.f) + EPS);
#pragma unroll
                for (int dt = 0; dt < 4; ++dt) {
                    const int e0 = h * 64 + 16 * dt + 4 * fq; const f32x4 gw = *(const f32x4*)(gnw + e0); const u32x2 rg = rgv[dt];
                    f32x4 o = O[dt] * rstd * gw;
                    o[0] *= __uint_as_float(rg.x << 16); o[1] *= __uint_as_float(rg.x & 0xffff0000u); o[2] *= __uint_as_float(rg.y << 16); o[3] *= __uint_as_float(rg.y & 0xffff0000u);
                    *(u32x2*)(MIX + row * DM + e0) = pack4(o);
                }
                __syncthreads();
            }
            }
#undef R3_ISSUE
        }
        if (rep > 0) { asm volatile("s_waitcnt vmcnt(0) lgkmcnt(0)" ::: "memory"); __syncthreads(); }
        }
    }
    SEAM(4);

    if (IN(5)) {
        PHASE_LOCALS
        for (int rep = ((REP_MASK >> 5) & 1); rep >= 0; --rep) {
        pg8::Gemm g{(const bf16_t*)out + (size_t)T * DM, (const bf16_t*)(ws + WS_WOUT), T, DM, DM, DM, DM}; pg8::StaticOrder S; S.init(T, DM, G, bid);
        EpiOut E{(const bf16_t*)(ws + WS_XS), (bf16_t*)out, (float*)(ws + WS_SS1), rep > 0 ? lnd_i(1) : 0};
        pg8::gemm_phase(lds, g, S, E, tid);
        if (rep > 0) { asm volatile("s_waitcnt vmcnt(0) lgkmcnt(0)" ::: "memory"); __syncthreads(); }
        }
    }
    SEAM(5);

    if (IN(6)) {
        PHASE_LOCALS
        for (int rep = ((REP_MASK >> 6) & 1); rep >= 0; --rep) {
        pg8::Gemm g{(const bf16_t*)out, (const bf16_t*)(ws + WS_WUP), T, 2 * DFF, DM, DM, DM}; pg8::StaticOrder S; S.init(T, 2 * DFF, G, bid);
        EpiUp E{(const float*)(ws + WS_SS1), args.in[opq(I_CONVW)], args.in[opq(I_CONVB)], (bf16_t*)(ws + WS_ACT), (float*)(ws + WS_SB)};
        pg8::gemm_phase(lds, g, S, E, tid);
        if (rep > 0) { asm volatile("s_waitcnt vmcnt(0) lgkmcnt(0)" ::: "memory"); __syncthreads(); }
        }
    }
    SEAM(6);

    if (IN(7)) {
        PHASE_LOCALS
        for (int rep = ((REP_MASK >> 7) & 1); rep >= 0; --rep) {
        const float* sb = (const float*)(ws + WS_SB); const float* cw = args.in[opq(I_CONVW)]; const float* cb = args.in[opq(I_CONVB)]; bf16_t* act = (bf16_t*)(ws + WS_ACT);
        for (int i = bid * NTHR + tid; i < 512 * 2 * (DFF / 4); i += G * NTHR) {
            const int c = (i % (DFF / 4)) * 4, ur = i / (DFF / 4), rr = ur & 1, u = ur >> 1; const bool first = (u & 63) == 0;
            const float* su = sb + (size_t)u * 6 * DFF + c; const float* sp = su - 6 * DFF;
            const f32x4 z4 = (f32x4){0.f, 0.f, 0.f, 0.f};
            const f32x4 gt = *(const f32x4*)(su + rr * DFF), vt = *(const f32x4*)(su + (2 + rr) * DFF);
            f32x4 g1, g2;
            if (rr == 0) { g1 = first ? z4 : *(const f32x4*)(sp + 5 * DFF); g2 = first ? z4 : *(const f32x4*)(sp + 4 * DFF); } else { g1 = *(const f32x4*)su; g2 = first ? z4 : *(const f32x4*)(sp + 5 * DFF); }
            const f32x4 gate = *(const f32x4*)(cb + c) + *(const f32x4*)(cw + c) * g2 + *(const f32x4*)(cw + DFF + c) * g1 + *(const f32x4*)(cw + 2 * DFF + c) * gt;
            f32x4 o; o[0] = siluf_(gate[0]) * vt[0]; o[1] = siluf_(gate[1]) * vt[1]; o[2] = siluf_(gate[2]) * vt[2]; o[3] = siluf_(gate[3]) * vt[3];
            *(u32x2*)(act + (size_t)(64 * u + rr) * DFF + c) = pack4(o);
        }
        if (rep > 0) { asm volatile("s_waitcnt vmcnt(0) lgkmcnt(0)" ::: "memory"); __syncthreads(); }
        }
    }
    SEAM(7);

    if (IN(8)) {
        PHASE_LOCALS
        for (int rep = ((REP_MASK >> 8) & 1); rep >= 0; --rep) {
        pg8::Gemm g{(const bf16_t*)(ws + WS_ACT), (const bf16_t*)(ws + WS_WDN), T, DM, DFF, DFF, DFF}; pg8::StaticOrder S; S.init(T, DM, G, bid);
        EpiDown E{(const bf16_t*)out, (bf16_t*)(ws + WS_HS), rep > 0 ? lnd_i(1) : 0};
        pg8::gemm_phase(lds, g, S, E, tid);
        if (rep > 0) { asm volatile("s_waitcnt vmcnt(0) lgkmcnt(0)" ::: "memory"); __syncthreads(); }
        }
    }
    SEAM(8);

    if (IN(9)) {
        PHASE_LOCALS
        for (int rep = ((REP_MASK >> 9) & 1); rep >= 0; --rep) {
        pg8::Gemm g{(const bf16_t*)(ws + WS_HS), (const bf16_t*)(ws + WS_WG), T, DM, DM, DM, DM}; pg8::StaticOrder S; S.init(T, DM, G, bid);
        EpiPle E{(const bf16_t*)(ws + WS_HS), (bf16_t*)(ws + WS_ACT), (const bf16_t*)(ws + WS_PE), (float*)(ws + WS_SS3), rep > 0 ? lnd_i(1) : 0};
        pg8::gemm_phase(lds, g, S, E, tid);
        if (rep > 0) { asm volatile("s_waitcnt vmcnt(0) lgkmcnt(0)" ::: "memory"); __syncthreads(); }
        }
    }
    SEAM(9);

    if (IN(10)) {
        PHASE_LOCALS
        const float* ss = (const float*)(ws + WS_SS3); const f32x4* wf = (const f32x4*)args.in[opq(I_FNW)]; f32x4* o4 = (f32x4*)out;
        const int gw = bid * 8 + wave, NGW = G * 8; const u32x2* h3 = (const u32x2*)(ws + WS_ACT);
        f32x4 wv[4];
#pragma unroll
        for (int j = 0; j < 4; ++j) wv[j] = wf[lane + 64 * j];
        for (int r0_ = gw * 4; r0_ < T; r0_ += NGW * 4) {
            u32x2 hv[4][4]; float rs[4];
#pragma unroll
            for (int rr = 0; rr < 4; ++rr) { rs[rr] = ss[r0_ + rr];
#pragma unroll
                for (int j = 0; j < 4; ++j) hv[rr][j] = __builtin_nontemporal_load(h3 + (size_t)(r0_ + rr) * 256 + lane + 64 * j); }
#pragma unroll
            for (int rr = 0; rr < 4; ++rr) { const float sc = rsqrtf(rs[rr] * (1.f / DM) + EPS);
#pragma unroll
                for (int j = 0; j < 4; ++j) { const u32x2 hw = hv[rr][j];
                    __builtin_nontemporal_store((f32x4){__uint_as_float(hw.x << 16), __uint_as_float(hw.x & 0xffff0000u), __uint_as_float(hw.y << 16), __uint_as_float(hw.y & 0xffff0000u)} * sc * wv[j], o4 + (size_t)(r0_ + rr) * 256 + lane + 64 * j); } }
        }
    }
#undef IN
#undef SEAM
}

extern "C" void kernel_launch(void* const* d_in, const int* in_sizes, int n_in, void* d_out, int out_size, void* d_ws, size_t ws_size, hipStream_t stream) {
    static int grid = 0;
    if (grid == 0) {
        if (n_in != 20 || out_size != T * DM || ws_size < WS_END) { fprintf(stderr, "kernel_launch: unexpected shapes (n_in %d out %d ws %zu)\n", n_in, out_size, ws_size); grid = -1; return; }
        int dev = 0, cus = 0, per_cu = 0;
        hipGetDevice(&dev); hipDeviceGetAttribute(&cus, hipDeviceAttributeMultiprocessorCount, dev);
        hipFuncSetAttribute((const void*)hymba_fwd, hipFuncAttributeMaxDynamicSharedMemorySize, LDS_BYTES);
        hipOccupancyMaxActiveBlocksPerMultiprocessor(&per_cu, (const void*)hymba_fwd, NTHR, LDS_BYTES);
        (void)hipGetLastError();
        if (per_cu < 1) { fprintf(stderr, "kernel_launch: occupancy query says %d blocks/CU\n", per_cu); per_cu = 1; }
        grid = cus;
    }
    if (grid < 0) return;
    Args a{};
    for (int i = 0; i < 20; ++i) a.in[i] = (const float*)d_in[i];
    a.out = (float*)d_out; a.ws = (unsigned char*)d_ws;
    const int NPH = 11;
#if N_LAUNCH_PER_PHASE
    for (int p = 0; p < NPH; ++p) {
        a.ph_lo = p; a.ph_hi = p + 1; void* args[] = {&a};
        hipError_t e = hipLaunchCooperativeKernel((const void*)hymba_fwd, dim3(grid), dim3(NTHR), args, LDS_BYTES, stream);
        if (e != hipSuccess) { fprintf(stderr, "launch %d failed: %s\n", p, hipGetErrorString(e)); break; }
    }
#else
    hipMemsetAsync((char*)d_ws + WS_BAR, 0, 16384, stream);
    a.ph_lo = 0; a.ph_hi = NPH; void* args[] = {&a};
    hipError_t e = hipLaunchCooperativeKernel((const void*)hymba_fwd, dim3(grid), dim3(NTHR), args, LDS_BYTES, stream);
    if (e != hipSuccess) fprintf(stderr, "cooperative launch failed: %s (grid %d)\n", hipGetErrorString(e), grid);
#endif
}
```

```cpp
#include <hip/hip_runtime.h>
#include <hip/hip_cooperative_groups.h>
#include <cstdio>
#include <cstdint>
namespace cg = cooperative_groups;

#ifndef XBAR
#define XBAR 0
#endif
#ifndef REP2
#define REP2 0
#endif
#ifndef NSA_REP
#define NSA_REP 0
#endif
#ifndef P0_REP
#define P0_REP 0
#endif
#ifndef REP_MASK
#define REP_MASK 0
#endif
#ifndef N_LAUNCH_PER_PHASE
#define N_LAUNCH_PER_PHASE 0
#endif

#define LAS __attribute__((address_space(3)))
typedef unsigned short bf16_t;
typedef short bf16x8 __attribute__((ext_vector_type(8)));
typedef short v4s __attribute__((ext_vector_type(4)));
typedef float f32x4 __attribute__((ext_vector_type(4)));
typedef float f32x2 __attribute__((ext_vector_type(2)));
typedef unsigned u32x4 __attribute__((ext_vector_type(4)));
typedef unsigned u32x2 __attribute__((ext_vector_type(2)));

constexpr int NB = 8, SEQ = 4096, DM = 1024, T = NB * SEQ;
constexpr int INW = 3352, INP = 3584;
constexpr int DFF = 2816, PLE = 256;
constexpr float EPS = 1e-6f;
constexpr float QSCALE = 0.125f * 1.4426950408889634f;
constexpr int NTHR = 512;

constexpr size_t MiB = 1u << 20;
constexpr size_t WS_WIN = 0, WS_WOUT = 8 * MiB, WS_WUP = 10 * MiB, WS_WDN = 22 * MiB, WS_WG = 28 * MiB, WS_WP = 30 * MiB;
constexpr size_t WS_W1K = 31 * MiB, WS_W1V = 32 * MiB, WS_W2K = 33 * MiB, WS_W2V = 33 * MiB + 65536;
constexpr size_t WS_C1P = 33 * MiB + 512 * 1024, WS_C1 = 33 * MiB + 768 * 1024;
constexpr size_t WS_COSR = 34 * MiB, WS_SINR = 38 * MiB, WS_COSN = 42 * MiB, WS_SINN = 43 * MiB;
constexpr size_t WS_R0 = 44 * MiB, WS_SS1 = 44 * MiB + 256 * 1024, WS_SS3 = 44 * MiB + 512 * 1024;
constexpr size_t WS_SB = 46 * MiB;
constexpr size_t WS_PE = 80 * MiB;
constexpr size_t WS_XS = 144 * MiB;
constexpr size_t WS_PB = 208 * MiB;
constexpr size_t WS_RQ = 224 * MiB, WS_RK = 256 * MiB, WS_RV = 288 * MiB, WS_RG = 320 * MiB, WS_NQ = 352 * MiB;
constexpr size_t WS_KC = 384 * MiB, WS_VC = 392 * MiB, WS_KS = 400 * MiB, WS_VS = 408 * MiB, WS_KW = 416 * MiB, WS_VW = 424 * MiB;
constexpr size_t WS_NG = 432 * MiB;
constexpr size_t WS_KVST = 436 * MiB;
constexpr size_t WS_HIDK = 468 * MiB, WS_HIDV = 470 * MiB, WS_CK = 472 * MiB, WS_CV = 472 * MiB + 512 * 1024;
constexpr size_t WS_HS = 224 * MiB;
constexpr size_t WS_ACT = 288 * MiB;
constexpr size_t WS_BAR = 474 * MiB;
constexpr size_t WS_END = 475 * MiB;

constexpr int LDS_BYTES = 147456;

typedef __bf16 bf16x2_t __attribute__((ext_vector_type(2)));
__device__ __forceinline__ unsigned cvt_pk_bf16(float lo, float hi) { const f32x2 v = {lo, hi}; const bf16x2_t b = __builtin_convertvector(v, bf16x2_t); return __builtin_bit_cast(unsigned, b); }
__device__ __forceinline__ float bf2f(unsigned short b) { return __uint_as_float(((unsigned)b) << 16); }
__device__ __forceinline__ float fexp2(float x) { return __builtin_amdgcn_exp2f(x); }
__device__ __forceinline__ float frcp(float x) { return __builtin_amdgcn_rcpf(x); }
__device__ __forceinline__ float sigmoidf_(float x) { return frcp(1.f + fexp2(-1.4426950408889634f * x)); }
__device__ __forceinline__ float siluf_(float x) { return x * sigmoidf_(x); }
__device__ __forceinline__ float gelu_tanh(float x) { const float u = 0.7978845608028654f * (x + 0.044715f * x * x * x); const float e = fexp2(2.f * 1.4426950408889634f * u); return 0.5f * x * (2.f - 2.f * frcp(1.f + e)); }
__device__ __forceinline__ v4s trrd(const LAS unsigned char* p) { return __builtin_amdgcn_ds_read_tr16_b64_v4i16((LAS v4s*)p); }
__device__ __forceinline__ bf16x8 cat8(v4s a, v4s b) { return __builtin_shufflevector(a, b, 0, 1, 2, 3, 4, 5, 6, 7); }
__device__ __forceinline__ f32x4 mfma16(bf16x8 a, bf16x8 b, f32x4 c) { return __builtin_amdgcn_mfma_f32_16x16x32_bf16(a, b, c, 0, 0, 0); }
__device__ __forceinline__ u32x2 pack4(f32x4 v) { u32x2 w; w.x = cvt_pk_bf16(v[0], v[1]); w.y = cvt_pk_bf16(v[2], v[3]); return w; }
__device__ __forceinline__ bf16x8 pack8(f32x4 a, f32x4 b) { u32x4 w; w.x = cvt_pk_bf16(a[0], a[1]); w.y = cvt_pk_bf16(a[2], a[3]); w.z = cvt_pk_bf16(b[0], b[1]); w.w = cvt_pk_bf16(b[2], b[3]); return __builtin_bit_cast(bf16x8, w); }
__device__ __forceinline__ float rows_max(float v) {
    auto a = __builtin_amdgcn_permlane16_swap(__float_as_uint(v), __float_as_uint(v), false, false); v = fmaxf(__uint_as_float(a[0]), __uint_as_float(a[1]));
    auto b = __builtin_amdgcn_permlane32_swap(__float_as_uint(v), __float_as_uint(v), false, false); return fmaxf(__uint_as_float(b[0]), __uint_as_float(b[1]));
}
__device__ __forceinline__ float rows_sum(float v) {
    auto a = __builtin_amdgcn_permlane16_swap(__float_as_uint(v), __float_as_uint(v), false, false); v = __uint_as_float(a[0]) + __uint_as_float(a[1]);
    auto b = __builtin_amdgcn_permlane32_swap(__float_as_uint(v), __float_as_uint(v), false, false); return __uint_as_float(b[0]) + __uint_as_float(b[1]);
}
template <int N> __device__ __forceinline__ float row_ror(float v) { return __uint_as_float((unsigned)__builtin_amdgcn_update_dpp(0, (int)__float_as_uint(v), 0x120 + N, 0xf, 0xf, false)); }
__device__ __forceinline__ void store_pair16(bf16_t* pX, bf16_t* pY, u32x2 X, u32x2 Y, int fq, bool okX, bool okY) {
    auto r0 = __builtin_amdgcn_permlane16_swap(X.x, Y.x, false, false); auto r1 = __builtin_amdgcn_permlane16_swap(X.y, Y.y, false, false);
    u32x4 o; o.x = r0[0]; o.y = r1[0]; o.z = r0[1]; o.w = r1[1];
    bf16_t* ad = (fq & 1) ? pY - 4 : pX; const bool ok = (fq & 1) ? okY : okX;
    if (ok) *(u32x4*)ad = o;
}
template <bool NT = false> __device__ __forceinline__ void load_pair16(const bf16_t* pX, const bf16_t* pY, u32x2& X, u32x2& Y, int fq) {
    const u32x4* ap = (const u32x4*)((fq & 1) ? pY - 4 : pX); const u32x4 o = NT ? __builtin_nontemporal_load(ap) : *ap;
    auto r0 = __builtin_amdgcn_permlane16_swap(o.x, o.z, false, false); auto r1 = __builtin_amdgcn_permlane16_swap(o.y, o.w, false, false);
    X.x = r0[0]; Y.x = r0[1]; X.y = r1[0]; Y.y = r1[1];
}
__device__ __forceinline__ float wave_sum(float v) {
#pragma unroll
    for (int o = 1; o < 64; o <<= 1) v += __shfl_xor(v, o);
    return v;
}

namespace pg8 {
constexpr int BM = 256, BK = 64, HALF = 128, HTB = HALF * BK * 2, STAGE_BYTES = 8 * HTB, NXCD = 8, WGM = 8;
__host__ __device__ __forceinline__ int lds_byte(int r, int c) { const int st = (r >> 4) * 2 + (c >> 5), rr = r & 15, cc = c & 31, ob = rr * 64 + cc * 2; return st * 1024 + (ob ^ (((ob >> 9) & 1) << 5)); }
__host__ __device__ __forceinline__ void stage_rc(int b, int& R, int& C) { const int st = b / 1024, sb = b % 1024, swz = sb ^ (((sb >> 9) & 1) << 5); R = (st >> 1) * 16 + swz / 64; C = (st & 1) * 32 + (swz % 64) / 2; }
struct Unit { int pm, pn; };
struct Gemm { const bf16_t* A; const bf16_t* Bt; int M, N, K, lda, ldb; };
struct StaticOrder {
    int nM, nN, nwg, G, c;
    __device__ void init(int M, int N, int G_, int c_) { nM = M / BM; nN = N / BM; nwg = nM * nN; G = G_; c = c_; }
    __device__ bool next(int i, Unit& u) const {
        const long L = (long)i * G + c; if (c < 0 || L >= nwg) return false;
        int wgid = (int)L; { const int q = nwg / NXCD, r = nwg % NXCD, xcd = wgid % NXCD, off = wgid / NXCD; wgid = (xcd < r ? xcd * (q + 1) : r * (q + 1) + (xcd - r) * q) + off; }
        const int nig = WGM * nN, gid = wgid / nig, fm = gid * WGM, gsz = (nM - fm) < WGM ? (nM - fm) : WGM;
        u.pm = fm + ((wgid % nig) % gsz); u.pn = (wgid % nig) / gsz; return true;
    }
};
template <class Epi>
__device__ __forceinline__ void gemm_phase(LAS unsigned char* lds, const Gemm g, const StaticOrder& S, const Epi& E, const int tid) {
    const int wid = __builtin_amdgcn_readfirstlane(tid >> 6), lane = tid & 63, wr = wid >> 2, wc = wid & 3, fr = lane & 15, fq = lane >> 4;
    const int K = g.K, nt = K / BK, lda = g.lda, ldb = g.ldb;
    unsigned voffA[2], voffB[2];
#pragma unroll
    for (int i = 0; i < 2; ++i) { int R, C; stage_rc(tid * 16 + i * 8192, R, C); voffA[i] = (unsigned)(R * lda + C) * 2u; voffB[i] = (unsigned)(R * ldb + C) * 2u; }
    const size_t kstep = (size_t)(BK * 2);
    const size_t hstepA = (size_t)HALF * lda * 2, hstepB = (size_t)HALF * ldb * 2;
    const size_t tstepA = 2 * hstepA, tstepB = 2 * hstepB;
    const unsigned ldsw = (unsigned)wid * 1024u;
    const int aoff = lds_byte(wr * 64 + fr, fq * 8), boff = lds_byte(wc * 32 + fr, fq * 8);
#define PG8_SA(b, h) (((b) * 2 + (h)) * HTB)
#define PG8_SB(b, h) ((4 + (b) * 2 + (h)) * HTB)
#define PG8_STAGE(bufoff, gbase, voff) do { _Pragma("unroll") for (int _i = 0; _i < 2; ++_i) \
        __builtin_amdgcn_global_load_lds((const unsigned*)((const char*)(gbase) + (voff)[_i]), (LAS unsigned*)(lds + (bufoff) + ldsw + _i * 8192), 16, 0, 0); } while (0)
#define PG8_LDA(dst, b, h) do { _Pragma("unroll") for (int m = 0; m < 4; ++m) _Pragma("unroll") for (int k = 0; k < 2; ++k) dst[m][k] = *(const LAS bf16x8*)(lds + PG8_SA(b, h) + aoff + m * 2048 + k * 1024); } while (0)
#define PG8_LDB(dst, b, h) do { _Pragma("unroll") for (int n = 0; n < 2; ++n) _Pragma("unroll") for (int k = 0; k < 2; ++k) dst[n][k] = *(const LAS bf16x8*)(lds + PG8_SB(b, h) + boff + n * 2048 + k * 1024); } while (0)
#define PG8_MMA(ai, bj, At, Bt) do { __builtin_amdgcn_s_setprio(1); _Pragma("unroll") for (int m = 0; m < 4; ++m) _Pragma("unroll") for (int n = 0; n < 2; ++n) _Pragma("unroll") for (int k = 0; k < 2; ++k) \
        acc[ai][bj][m][n] = __builtin_amdgcn_mfma_f32_16x16x32_bf16(Bt[n][k], At[m][k], acc[ai][bj][m][n], 0, 0, 0); __builtin_amdgcn_s_setprio(0); } while (0)
#define PG8_WAIT_V(n) asm volatile("s_waitcnt vmcnt(" #n ")" ::: "memory")
#define PG8_WAIT_L(n) asm volatile("s_waitcnt lgkmcnt(" #n ")" ::: "memory")
#define PG8_BAR __builtin_amdgcn_s_barrier()
#define PG8_SCHED __builtin_amdgcn_sched_barrier(0)
    Unit cur, nxt; int ui = 0;
    if (!S.next(0, cur)) return;
    f32x4 acc[2][2][4][2];
#pragma unroll
    for (int a = 0; a < 2; ++a)
#pragma unroll
        for (int b = 0; b < 2; ++b)
#pragma unroll
            for (int m = 0; m < 4; ++m)
#pragma unroll
                for (int n = 0; n < 2; ++n) acc[a][b][m][n] = (f32x4){0.f, 0.f, 0.f, 0.f};
    bf16x8 At[4][2], B0[2][2], B1[2][2];
    const char* cA = (const char*)g.A + (size_t)cur.pm * tstepA; const char* cB = (const char*)g.Bt + (size_t)cur.pn * tstepB;
    PG8_STAGE(PG8_SB(0, 0), cB, voffB); PG8_STAGE(PG8_SB(0, 1), cB + hstepB, voffB); PG8_STAGE(PG8_SA(0, 0), cA, voffA); PG8_STAGE(PG8_SA(0, 1), cA + hstepA, voffA);
    if (wr == 1) PG8_BAR;
    PG8_WAIT_V(2); PG8_BAR;
    PG8_STAGE(PG8_SB(1, 0), cB + kstep, voffB); PG8_STAGE(PG8_SA(1, 0), cA + kstep, voffA); PG8_STAGE(PG8_SB(1, 1), cB + hstepB + kstep, voffB);
    PG8_WAIT_V(6); PG8_BAR;
    for (;;) {
        const bool has_next = S.next(ui + 1, nxt);
        const char* nA = has_next ? (const char*)g.A + (size_t)nxt.pm * tstepA : cA; const char* nB = has_next ? (const char*)g.Bt + (size_t)nxt.pn * tstepB : cB;
        for (int t = 0; t < nt; t += 2) {
            const bool last = (t == nt - 2);
            const char* a1 = cA + (size_t)(t + 1) * kstep;
            const char* a2 = last ? nA : cA + (size_t)(t + 2) * kstep; const char* b2 = last ? nB : cB + (size_t)(t + 2) * kstep;
            const char* a3 = a2 + kstep; const char* b3 = b2 + kstep;
            PG8_LDB(B0, 0, 0); PG8_LDB(B1, 0, 1); PG8_SCHED; PG8_LDA(At, 0, 0); PG8_STAGE(PG8_SA(1, 1), a1 + hstepA, voffA);
            PG8_WAIT_V(8); PG8_WAIT_L(0); PG8_BAR; PG8_MMA(0, 0, At, B0); PG8_MMA(0, 1, At, B1); PG8_BAR; PG8_SCHED;
            PG8_LDA(At, 0, 1); PG8_STAGE(PG8_SB(0, 0), b2, voffB); PG8_STAGE(PG8_SB(0, 1), b2 + hstepB, voffB); PG8_STAGE(PG8_SA(0, 0), a2, voffA);
            PG8_WAIT_V(8); PG8_WAIT_L(0); PG8_BAR; PG8_MMA(1, 0, At, B0); PG8_MMA(1, 1, At, B1); PG8_BAR; PG8_SCHED;
            PG8_LDB(B0, 1, 0); PG8_LDB(B1, 1, 1); PG8_SCHED; PG8_LDA(At, 1, 0); PG8_STAGE(PG8_SA(0, 1), a2 + hstepA, voffA);
            PG8_WAIT_V(8); PG8_WAIT_L(0); PG8_BAR; PG8_MMA(0, 0, At, B0); PG8_MMA(0, 1, At, B1); PG8_BAR; PG8_SCHED;
            PG8_LDA(At, 1, 1); PG8_STAGE(PG8_SB(1, 0), b3, voffB); PG8_STAGE(PG8_SB(1, 1), b3 + hstepB, voffB); PG8_STAGE(PG8_SA(1, 0), a3, voffA);
            PG8_WAIT_V(8); PG8_WAIT_L(0); PG8_BAR; PG8_MMA(1, 0, At, B0); PG8_MMA(1, 1, At, B1); PG8_BAR; PG8_SCHED;
        }
        if (wr == 0) PG8_BAR;
        E(acc, cur, wr, wc, fr, fq);
        if (!has_next) break;
#pragma unroll
        for (int a = 0; a < 2; ++a)
#pragma unroll
            for (int b = 0; b < 2; ++b)
#pragma unroll
                for (int m = 0; m < 4; ++m)
#pragma unroll
                    for (int n = 0; n < 2; ++n) acc[a][b][m][n] = (f32x4){0.f, 0.f, 0.f, 0.f};
        cur = nxt; cA = nA; cB = nB; ++ui;
        if (wr == 1) PG8_BAR;
    }
    PG8_WAIT_V(0);
    PG8_BAR;
#undef PG8_SA
#undef PG8_SB
#undef PG8_STAGE
#undef PG8_LDA
#undef PG8_LDB
#undef PG8_MMA
#undef PG8_WAIT_V
#undef PG8_WAIT_L
#undef PG8_BAR
#undef PG8_SCHED
}
}
using pg8::Unit;
typedef f32x4 Acc[2][2][4][2];

struct EpiIn {
    const float* r0; const int* pos; unsigned char* ws;
    __device__ __forceinline__ void operator()(const Acc& acc, const Unit& u, int wr, int wc, int fr, int fq) const {
        const int tile = u.pn;
        f32x4 invr[2], invn;
#pragma unroll
        for (int e = 0; e < 4; ++e) { invr[0][e] = fexp2(-(float)(4 * fq + e) * (13.287712379549449f / 32.f)); invr[1][e] = fexp2(-(float)(16 + 4 * fq + e) * (13.287712379549449f / 32.f));
            invn[e] = fexp2(-(float)(4 * (fq & 1) + e) * (18.931568569324174f / 8.f)); }
        float rsv[2][4], pfv[2][4];
#pragma unroll
        for (int ai = 0; ai < 2; ++ai)
#pragma unroll
            for (int m = 0; m < 4; ++m) { const int row = u.pm * 256 + ai * 128 + wr * 64 + m * 16 + fr; rsv[ai][m] = r0[row]; pfv[ai][m] = (float)pos[row]; }
#pragma unroll
        for (int ai = 0; ai < 2; ++ai)
#pragma unroll
            for (int m = 0; m < 4; ++m) {
                const int row = u.pm * 256 + ai * 128 + wr * 64 + m * 16 + fr;
                const float rs = rsv[ai][m], pf = pfv[ai][m];
                if (tile < 4) {
                    bf16_t* dst = (bf16_t*)(ws + (tile < 2 ? WS_RQ : WS_RK)) + (size_t)row * 512 + ((tile & 1) * 4 + wc) * 64;
                    const float sc = tile < 2 ? rs : rs * 0.125f; u32x2 o1[2], o2[2];
#pragma unroll
                    for (int n = 0; n < 2; ++n) {
                        const int i0 = 16 * n + 4 * fq;
                        f32x4 c4, s4;
#pragma unroll
                        for (int e = 0; e < 4; ++e) { const float fv = __builtin_amdgcn_fractf(pf * invr[n][e] * 0.15915494309189535f); c4[e] = __builtin_amdgcn_cosf(fv); s4[e] = __builtin_amdgcn_sinf(fv); }
                        const f32x4 x1 = acc[ai][0][m][n] * sc, x2 = acc[ai][1][m][n] * sc;
                        o1[n] = pack4(x1 * c4 - x2 * s4); o2[n] = pack4(x1 * s4 + x2 * c4);
                    }
                    store_pair16(dst + 4 * fq, dst + 16 + 4 * fq, o1[0], o1[1], fq, true, true);
                    store_pair16(dst + 32 + 4 * fq, dst + 48 + 4 * fq, o2[0], o2[1], fq, true, true);
                } else if (tile < 8) {
                    bf16_t* dst = (bf16_t*)(ws + (tile < 6 ? WS_RV : WS_RG)) + (size_t)row * 512 + ((tile & 1) * 4 + wc) * 64;
#pragma unroll
                    for (int bj = 0; bj < 2; ++bj) { u32x2 ov[2];
#pragma unroll
                        for (int n = 0; n < 2; ++n) {
                            f32x4 v = acc[ai][bj][m][n] * rs;
                            if (tile >= 6) { v[0] = siluf_(v[0]); v[1] = siluf_(v[1]); v[2] = siluf_(v[2]); v[3] = siluf_(v[3]); }
                            ov[n] = pack4(v);
                        }
                        store_pair16(dst + 32 * bj + 4 * fq, dst + 32 * bj + 16 + 4 * fq, ov[0], ov[1], fq, true, true); }
                } else if (tile < 13) {
                    bf16_t* dst; bool roped; float sc = rs;
                    if (tile < 10) { dst = (bf16_t*)(ws + WS_NQ) + (size_t)row * 512 + ((tile & 1) * 4 + wc) * 64; roped = true; sc = rs * QSCALE; }
                    else { const int seg = wc >> 1, g = wc & 1, b = row >> 12, s = row & 4095;
                        const size_t base = (tile == 10 ? (seg ? WS_VC : WS_KC) : tile == 11 ? (seg ? WS_VS : WS_KS) : (seg ? WS_VW : WS_KW));
                        dst = (bf16_t*)(ws + base) + ((size_t)(b * 2 + g) * SEQ + s) * 64; roped = (seg == 0); }
                    f32x4 c4, s4;
#pragma unroll
                    for (int e = 0; e < 4; ++e) { const float fv = __builtin_amdgcn_fractf(pf * invn[e] * 0.15915494309189535f); c4[e] = __builtin_amdgcn_cosf(fv); s4[e] = __builtin_amdgcn_sinf(fv); }
#pragma unroll
                    for (int bj = 0; bj < 2; ++bj) { u32x2 ov[2];
#pragma unroll
                        for (int n = 0; n < 2; ++n) {
                            f32x4 v = acc[ai][bj][m][n] * sc;
                            if (bj == 0 && n == 0) {
                                f32x4 pr; pr[0] = __shfl_xor(v[0], 32); pr[1] = __shfl_xor(v[1], 32); pr[2] = __shfl_xor(v[2], 32); pr[3] = __shfl_xor(v[3], 32);
                                const f32x4 rot = (fq < 2) ? (v * c4 - pr * s4) : (pr * s4 + v * c4);
                                if (roped) v = rot;
                            }
                            ov[n] = pack4(v);
                        }
                        store_pair16(dst + 32 * bj + 4 * fq, dst + 32 * bj + 16 + 4 * fq, ov[0], ov[1], fq, true, true); }
                } else {
                    float* ng = (float*)(ws + WS_NG) + (size_t)row * 24;
                    if (wc == 0) {
                        const f32x4 v0 = acc[ai][0][m][0] * rs; f32x4 o;
                        o[0] = sigmoidf_(v0[0]); o[1] = sigmoidf_(v0[1]); o[2] = sigmoidf_(v0[2]); o[3] = sigmoidf_(v0[3]);
                        *(f32x4*)(ng + 4 * fq) = o;
                        if (fq < 2) { const f32x4 v1 = acc[ai][0][m][1] * rs; o[0] = sigmoidf_(v1[0]); o[1] = sigmoidf_(v1[1]); o[2] = sigmoidf_(v1[2]); o[3] = sigmoidf_(v1[3]); *(f32x4*)(ng + 16 + 4 * fq) = o; }
                    }
                }
            }
    }
};
template <int ACT> struct EpiBf16 {
    bf16_t* O; int ldc; const float* bias;
    __device__ __forceinline__ void operator()(const Acc& acc, const Unit& u, int wr, int wc, int fr, int fq) const {
#pragma unroll
        for (int ai = 0; ai < 2; ++ai)
#pragma unroll
            for (int m = 0; m < 4; ++m) {
                const int row = u.pm * 256 + ai * 128 + wr * 64 + m * 16 + fr;
#pragma unroll
                for (int bj = 0; bj < 2; ++bj) { u32x2 ov[2];
#pragma unroll
                    for (int n = 0; n < 2; ++n) {
                        const int col = u.pn * 256 + 128 * bj + 32 * wc + 16 * n + 4 * fq;
                        f32x4 v = acc[ai][bj][m][n];
                        if (ACT == 1) { const f32x4 bv = *(const f32x4*)(bias + col); v = v + bv; v[0] = gelu_tanh(v[0]); v[1] = gelu_tanh(v[1]); v[2] = gelu_tanh(v[2]); v[3] = gelu_tanh(v[3]); }
                        ov[n] = pack4(v);
                    }
                    bf16_t* pb_ = O + (size_t)row * ldc + u.pn * 256 + 128 * bj + 32 * wc + 4 * fq; store_pair16(pb_, pb_ + 16, ov[0], ov[1], fq, true, true); }
            }
    }
};
struct EpiF32 {
    float* O; int ldc;
    __device__ __forceinline__ void operator()(const Acc& acc, const Unit& u, int wr, int wc, int fr, int fq) const {
#pragma unroll
        for (int ai = 0; ai < 2; ++ai)
#pragma unroll
            for (int m = 0; m < 4; ++m) {
                const int row = u.pm * 256 + ai * 128 + wr * 64 + m * 16 + fr;
#pragma unroll
                for (int bj = 0; bj < 2; ++bj)
#pragma unroll
                    for (int n = 0; n < 2; ++n) *(f32x4*)(O + (size_t)row * ldc + u.pn * 256 + 128 * bj + 32 * wc + 16 * n + 4 * fq) = acc[ai][bj][m][n];
            }
    }
};
struct EpiOut {
    const bf16_t* xb; bf16_t* h1b; float* ss; int dry;
    __device__ __forceinline__ void operator()(const Acc& acc, const Unit& u, int wr, int wc, int fr, int fq) const {
        if (dry) { if (acc[0][0][0][0][0] == 1.2345e-30f) ss[0] = 0.f; return; }
#pragma unroll
        for (int ai = 0; ai < 2; ++ai) {
            u32x2 rv[4][2][2];
#pragma unroll
            for (int m = 0; m < 4; ++m)
#pragma unroll
                for (int bj = 0; bj < 2; ++bj) { const bf16_t* pl_ = xb + (size_t)(u.pm * 256 + ai * 128 + wr * 64 + m * 16 + fr) * DM + u.pn * 256 + 128 * bj + 32 * wc + 4 * fq; load_pair16<true>(pl_, pl_ + 16, rv[m][bj][0], rv[m][bj][1], fq); }
#pragma unroll
            for (int m = 0; m < 4; ++m) {
                const int row = u.pm * 256 + ai * 128 + wr * 64 + m * 16 + fr; float sq = 0.f;
#pragma unroll
                for (int bj = 0; bj < 2; ++bj) { u32x2 ov[2];
#pragma unroll
                    for (int n = 0; n < 2; ++n) {
                        const u32x2 w = rv[m][bj][n];
                        const f32x4 h = (f32x4){__uint_as_float(w.x << 16), __uint_as_float(w.x & 0xffff0000u), __uint_as_float(w.y << 16), __uint_as_float(w.y & 0xffff0000u)} + acc[ai][bj][m][n];
                        ov[n] = pack4(h); sq += (h[0] * h[0] + h[1] * h[1]) + (h[2] * h[2] + h[3] * h[3]);
                    }
                    bf16_t* pb_ = h1b + (size_t)row * DM + u.pn * 256 + 128 * bj + 32 * wc + 4 * fq; store_pair16(pb_, pb_ + 16, ov[0], ov[1], fq, true, true); }
                sq += __shfl_xor(sq, 16); sq += __shfl_xor(sq, 32);
                if (fq == 0) atomicAdd(ss + row, sq);
            }
        }
    }
};
struct EpiUp {
    const float* ss1; const float* cw; const float* cb; bf16_t* act; float* sb;
    __device__ __forceinline__ void operator()(const Acc& acc, const Unit& u, int wr, int wc, int fr, int fq) const {
        float rsv[2][4];
#pragma unroll
        for (int ai = 0; ai < 2; ++ai)
#pragma unroll
            for (int m = 0; m < 4; ++m) rsv[ai][m] = ss1[u.pm * 256 + ai * 128 + wr * 64 + m * 16 + fr];
#pragma unroll
        for (int ai = 0; ai < 2; ++ai)
#pragma unroll
            for (int m = 0; m < 4; ++m) rsv[ai][m] = rsqrtf(rsv[ai][m] * (1.f / DM) + EPS);
#pragma unroll
        for (int n = 0; n < 2; ++n) {
            const int col = u.pn * 128 + wc * 32 + 16 * n + 4 * fq;
            const f32x4 w0 = *(const f32x4*)(cw + col), w1 = *(const f32x4*)(cw + DFF + col), w2 = *(const f32x4*)(cw + 2 * DFF + col), bb = *(const f32x4*)(cb + col);
#pragma unroll
            for (int ai = 0; ai < 2; ++ai) {
                const int unit = u.pm * 4 + ai * 2 + wr;
                f32x4 pg = (f32x4){0.f, 0.f, 0.f, 0.f}; u32x2 ppk = (u32x2){0u, 0u};
#pragma unroll
                for (int m = 0; m < 4; ++m) {
                    const int row = u.pm * 256 + ai * 128 + wr * 64 + m * 16 + fr;
                    const float rs = rsv[ai][m];
                    const f32x4 G = acc[ai][0][m][n] * rs, V = acc[ai][1][m][n] * rs; f32x4 a;
#pragma unroll
                    for (int e = 0; e < 4; ++e) {
                        const float a1 = row_ror<1>(G[e]), a2 = row_ror<2>(G[e]), b1 = row_ror<1>(pg[e]), b2 = row_ror<2>(pg[e]);
                        const float g1 = fr >= 1 ? a1 : b1, g2 = fr >= 2 ? a2 : b2;
                        const float gate = bb[e] + w0[e] * g2 + w1[e] * g1 + w2[e] * G[e];
                        a[e] = siluf_(gate) * V[e];
                    }
                    if (m == 0 && fr < 2) { *(f32x4*)(sb + ((size_t)unit * 6 + fr) * DFF + col) = G; *(f32x4*)(sb + ((size_t)unit * 6 + 2 + fr) * DFF + col) = V; }
                    if (m == 3 && fr >= 14) *(f32x4*)(sb + ((size_t)unit * 6 + 4 + (fr - 14)) * DFF + col) = G;
                    if ((m & 1) == 0) ppk = pack4(a);
                    else store_pair16(act + (size_t)(row - 16) * DFF + col, act + (size_t)row * DFF + col, ppk, pack4(a), fq, (m != 1) || (fr >= 2), true);
                    pg = G;
                }
            }
        }
    }
};
struct EpiDown {
    const bf16_t* h1b; bf16_t* hb; int dry;
    __device__ __forceinline__ void operator()(const Acc& acc, const Unit& u, int wr, int wc, int fr, int fq) const {
        if (dry) { if (acc[0][0][0][0][0] == 1.2345e-30f) hb[0] = 0; return; }
#pragma unroll
        for (int ai = 0; ai < 2; ++ai) {
            u32x2 rv[4][2][2];
#pragma unroll
            for (int m = 0; m < 4; ++m)
#pragma unroll
                for (int bj = 0; bj < 2; ++bj) { const bf16_t* pl_ = h1b + (size_t)(u.pm * 256 + ai * 128 + wr * 64 + m * 16 + fr) * DM + u.pn * 256 + 128 * bj + 32 * wc + 4 * fq; load_pair16<true>(pl_, pl_ + 16, rv[m][bj][0], rv[m][bj][1], fq); }
#pragma unroll
            for (int m = 0; m < 4; ++m) {
                const int row = u.pm * 256 + ai * 128 + wr * 64 + m * 16 + fr;
#pragma unroll
                for (int bj = 0; bj < 2; ++bj) { u32x2 ov[2];
#pragma unroll
                    for (int n = 0; n < 2; ++n) { const u32x2 w = rv[m][bj][n];
                        ov[n] = pack4((f32x4){__uint_as_float(w.x << 16), __uint_as_float(w.x & 0xffff0000u), __uint_as_float(w.y << 16), __uint_as_float(w.y & 0xffff0000u)} + acc[ai][bj][m][n]); }
                    bf16_t* pb_ = hb + (size_t)row * DM + u.pn * 256 + 128 * bj + 32 * wc + 4 * fq; store_pair16(pb_, pb_ + 16, ov[0], ov[1], fq, true, true); }
            }
        }
    }
};
struct EpiPle {
    const bf16_t* h2b; bf16_t* h3b; const bf16_t* pe; float* ss; int dry;
    __device__ __forceinline__ void operator()(const Acc& acc, const Unit& u, int wr, int wc, int fr, int fq) const {
        if (dry) { if (acc[0][0][0][0][0] == 1.2345e-30f) h3b[0] = 0; return; }
#pragma unroll
        for (int ai = 0; ai < 2; ++ai)
#pragma unroll
            for (int mh = 0; mh < 2; ++mh) {
                u32x2 hv[2][2][2], pv[2][2][2];
#pragma unroll
                for (int mm = 0; mm < 2; ++mm)
#pragma unroll
                    for (int bj = 0; bj < 2; ++bj) { const size_t off = (size_t)(u.pm * 256 + ai * 128 + wr * 64 + (2 * mh + mm) * 16 + fr) * DM + u.pn * 256 + 128 * bj + 32 * wc + 4 * fq;
                        load_pair16(h2b + off, h2b + off + 16, hv[mm][bj][0], hv[mm][bj][1], fq); load_pair16<true>(pe + off, pe + off + 16, pv[mm][bj][0], pv[mm][bj][1], fq); }
#pragma unroll
                for (int mm = 0; mm < 2; ++mm) {
                    const int m = 2 * mh + mm; const int row = u.pm * 256 + ai * 128 + wr * 64 + m * 16 + fr; float sq = 0.f;
#pragma unroll
                    for (int bj = 0; bj < 2; ++bj) { u32x2 ov[2];
#pragma unroll
                        for (int n = 0; n < 2; ++n) {
                            const u32x2 pw = pv[mm][bj][n], hw = hv[mm][bj][n]; const f32x4 a = acc[ai][bj][m][n];
                            f32x4 h = (f32x4){__uint_as_float(hw.x << 16), __uint_as_float(hw.x & 0xffff0000u), __uint_as_float(hw.y << 16), __uint_as_float(hw.y & 0xffff0000u)};
                            h[0] += sigmoidf_(a[0]) * __uint_as_float(pw.x << 16); h[1] += sigmoidf_(a[1]) * __uint_as_float(pw.x & 0xffff0000u);
                            h[2] += sigmoidf_(a[2]) * __uint_as_float(pw.y << 16); h[3] += sigmoidf_(a[3]) * __uint_as_float(pw.y & 0xffff0000u);
                            ov[n] = pack4(h); sq += (h[0] * h[0] + h[1] * h[1]) + (h[2] * h[2] + h[3] * h[3]);
                        }
                        bf16_t* pb_ = h3b + (size_t)row * DM + u.pn * 256 + 128 * bj + 32 * wc + 4 * fq; store_pair16(pb_, pb_ + 16, ov[0], ov[1], fq, true, true); }
                    sq += __shfl_xor(sq, 16); sq += __shfl_xor(sq, 32);
                    if (fq == 0) atomicAdd(ss + row, sq);
                }
            }
    }
};

__device__ __forceinline__ void tr_item(const float* W, int K, int N, bf16_t* WT, LAS float* scr, int k0, int np0, int src0, int lane, const float* ksc = nullptr) {
    const int q4 = lane & 7, kr = lane >> 3, sc = src0 + 4 * q4; const bool ok = sc < N;
#pragma unroll
    for (int i = 0; i < 8; ++i) { const int kk = 8 * i + kr; const f32x4 v = ok ? __builtin_nontemporal_load((const f32x4*)(W + (size_t)(k0 + kk) * N + sc)) : (f32x4){0.f, 0.f, 0.f, 0.f};
        LAS float* d = scr + kk * 33 + 4 * q4; d[0] = v[0]; d[1] = v[1]; d[2] = v[2]; d[3] = v[3]; }
    asm volatile("s_waitcnt lgkmcnt(0)" ::: "memory");
    const int c = lane & 7;
    f32x4 k0v = (f32x4){1.f, 1.f, 1.f, 1.f}, k1v = k0v;
    if (ksc) { k0v = *(const f32x4*)(ksc + k0 + 8 * c); k1v = *(const f32x4*)(ksc + k0 + 8 * c + 4); }
#pragma unroll
    for (int j = 0; j < 4; ++j) { const int n = (lane >> 3) + 8 * j; const LAS float* s = scr + (8 * c) * 33 + n;
        u32x4 o; o.x = cvt_pk_bf16(s[0 * 33] * k0v[0], s[1 * 33] * k0v[1]); o.y = cvt_pk_bf16(s[2 * 33] * k0v[2], s[3 * 33] * k0v[3]); o.z = cvt_pk_bf16(s[4 * 33] * k1v[0], s[5 * 33] * k1v[1]); o.w = cvt_pk_bf16(s[6 * 33] * k1v[2], s[7 * 33] * k1v[3]);
        *(u32x4*)(WT + (size_t)(np0 + n) * K + k0 + 8 * c) = o; }
    asm volatile("s_waitcnt lgkmcnt(0)" ::: "memory");
}

__device__ __forceinline__ int lnd_i(int v) { asm volatile("" : "+s"(v)); return v; }
template <class P> __device__ __forceinline__ P* lnd_p(P* p) { asm volatile("" : "+s"(p)); return p; }
#define PHASE_LOCALS const int wave = lnd_i(wave0); int lane_ = (int)__builtin_amdgcn_mbcnt_hi(~0u, __builtin_amdgcn_mbcnt_lo(~0u, 0u)); asm volatile("" : "+v"(lane_)); const int lane = lane_, tid = wave * 64 + lane, fr = lane & 15, fq = lane >> 4; (void)fr; (void)fq; (void)wave; const int G = lnd_i(G0), bid = lnd_i(bid0); unsigned char* ws = lnd_p(args.ws); float* out = lnd_p(args.out); (void)G; (void)bid; (void)ws; (void)out;
struct Args { const float* in[20]; float* out; unsigned char* ws; int ph_lo, ph_hi; };
__device__ __forceinline__ int opq(int i) { int r; asm volatile("s_mov_b32 %0, %1" : "=s"(r) : "i"(i)); return r; }
enum { I_X = 0, I_P, I_POS, I_NMIX, I_WIN, I_GNW, I_CPOS, I_KW1, I_KW2, I_VW1, I_VW2, I_WOUT, I_NFFN, I_WUP, I_CONVW, I_CONVB, I_WDN, I_PLEW, I_PLEG, I_FNW };

constexpr int RS = 144;
__device__ __forceinline__ void attn_tile(const int MODE, const LAS unsigned char* Kl, const LAS unsigned char* Vl, const bf16x8 (&Qf)[2][2],
                                          float (&mx)[2], f32x4 (&ls)[2], f32x4 (&O)[2][4], int fr, int fq, int toff, const bool (&rsel)[2]) {
    const bf16x8 ones8 = {0x3f80, 0x3f80, 0x3f80, 0x3f80, 0x3f80, 0x3f80, 0x3f80, 0x3f80};
    f32x4 S[2][4];
#pragma unroll
    for (int qg = 0; qg < 2; ++qg) {
        const float ci = (MODE == 0 && !rsel[qg]) ? -INFINITY : -mx[qg];
#pragma unroll
        for (int kt = 0; kt < 4; ++kt) S[qg][kt] = (f32x4){ci, ci, ci, ci};
    }
    const LAS unsigned char* kb = Kl + fr * RS + fq * 16;
#pragma unroll
    for (int ks = 0; ks < 2; ++ks) {
        bf16x8 kf[4];
#pragma unroll
        for (int kt = 0; kt < 4; ++kt) kf[kt] = *(const LAS bf16x8*)(kb + kt * 16 * RS + ks * 64);
        __builtin_amdgcn_sched_barrier(0);
#pragma unroll
        for (int kt = 0; kt < 4; ++kt) { S[0][kt] = mfma16(kf[kt], Qf[0][ks], S[0][kt]); S[1][kt] = mfma16(kf[kt], Qf[1][ks], S[1][kt]); }
    }
    const LAS unsigned char* vb = Vl + (4 * fq + (fr >> 2)) * RS + (fr & 3) * 8;
    bf16x8 Pf[2][2];
#pragma unroll
    for (int qg = 0; qg < 2; ++qg) {
        const int to = toff + 4 * qg;
        float rm = -INFINITY;
        if (MODE != 0) {
#pragma unroll
            for (int kt = 0; kt < 4; ++kt)
#pragma unroll
                for (int e = 0; e < 4; ++e) { const int ko = 16 * kt + 4 * fq + e; const bool ok = (MODE == 1) ? (ko <= to) : (ko > to); S[qg][kt][e] = ok ? S[qg][kt][e] : -INFINITY; }
        }
#pragma unroll
        for (int kt = 0; kt < 4; ++kt)
#pragma unroll
            for (int e = 0; e < 4; ++e) rm = fmaxf(rm, S[qg][kt][e]);
        rm = rows_max(rm);
        const bool was = __float_as_uint(mx[qg]) != 0x80000000u;
        const bool need = was ? (rm > 8.f) : (rm > -INFINITY);
        if (__builtin_amdgcn_ballot_w64(need) != 0ull) {
            const float delta = need ? rm : 0.f, f = (need && was) ? fexp2(-delta) : 1.f;
            mx[qg] += delta;
            ls[qg] = ls[qg] * f;
#pragma unroll
            for (int dt = 0; dt < 4; ++dt) O[qg][dt] = O[qg][dt] * f;
#pragma unroll
            for (int kt = 0; kt < 4; ++kt) S[qg][kt] = S[qg][kt] - delta;
        }
#pragma unroll
        for (int kt = 0; kt < 4; ++kt)
#pragma unroll
            for (int e = 0; e < 4; ++e) S[qg][kt][e] = fexp2(S[qg][kt][e]);
        Pf[qg][0] = pack8(S[qg][0], S[qg][1]); Pf[qg][1] = pack8(S[qg][2], S[qg][3]);
    }
#pragma unroll
    for (int kk = 0; kk < 2; ++kk) {
        bf16x8 vf[4];
#pragma unroll
        for (int dt = 0; dt < 4; ++dt) vf[dt] = cat8(trrd(vb + (32 * kk) * RS + dt * 32), trrd(vb + (32 * kk + 16) * RS + dt * 32));
        __builtin_amdgcn_sched_barrier(0);
#pragma unroll
        for (int dt = 0; dt < 4; ++dt) { O[0][dt] = mfma16(vf[dt], Pf[0][kk], O[0][dt]); O[1][dt] = mfma16(vf[dt], Pf[1][kk], O[1][dt]); }
        ls[0] = mfma16(ones8, Pf[0][kk], ls[0]); ls[1] = mfma16(ones8, Pf[1][kk], ls[1]);
    }
}

__device__ __forceinline__ void attn_branch(LAS unsigned char* lds, const bf16_t* Kg, const bf16_t* Vg, unsigned long long tmask, int qb, int is_win,
                                            const bf16x8 (&Qf)[2][2], const unsigned long long (&selm)[2], int fr, int fq, int toff, float gate0, float gate1, f32x4 (&acc_o)[2][4], const int tid) {
    const int lrow = tid >> 3, lch = tid & 7;
    float mx[2] = {-0.f, -0.f}; f32x4 ls[2] = {(f32x4){0.f, 0.f, 0.f, 0.f}, (f32x4){0.f, 0.f, 0.f, 0.f}}; f32x4 O[2][4];
#pragma unroll
    for (int qg = 0; qg < 2; ++qg)
#pragma unroll
        for (int dt = 0; dt < 4; ++dt) O[qg][dt] = (f32x4){0.f, 0.f, 0.f, 0.f};
    int j = __builtin_ctzll(tmask); tmask &= tmask - 1;
    int cur = 0;
    {
        const u32x4 kv = *(const u32x4*)(Kg + ((size_t)(64 * j + lrow)) * 64 + lch * 8), vv = *(const u32x4*)(Vg + ((size_t)(64 * j + lrow)) * 64 + lch * 8);
        *(LAS u32x4*)(lds + lrow * RS + lch * 16) = kv; *(LAS u32x4*)(lds + 9216 + lrow * RS + lch * 16) = vv;
    }
    __syncthreads();
    for (;;) {
        const bool more = tmask != 0ull; int jn = 0; u32x4 kv, vv;
        if (more) { jn = __builtin_ctzll(tmask); tmask &= tmask - 1;
            kv = *(const u32x4*)(Kg + ((size_t)(64 * jn + lrow)) * 64 + lch * 8); vv = *(const u32x4*)(Vg + ((size_t)(64 * jn + lrow)) * 64 + lch * 8); }
        bool rsel[2] = {true, true};
        const LAS unsigned char* Kl = lds + cur * 18432; const LAS unsigned char* Vl = Kl + 9216;
        int mode = 0;
        if (j == qb) mode = 1;
        else if (is_win) { if (j == qb - 8) mode = 2; }
        else { rsel[0] = (selm[0] >> j) & 1ull; rsel[1] = (selm[1] >> j) & 1ull; }
        attn_tile(mode, Kl, Vl, Qf, mx, ls, O, fr, fq, toff, rsel);
        if (!more) break;
        cur ^= 1;
        *(LAS u32x4*)(lds + cur * 18432 + lrow * RS + lch * 16) = kv; *(LAS u32x4*)(lds + cur * 18432 + 9216 + lrow * RS + lch * 16) = vv;
        __syncthreads();
        j = jn;
    }
    __syncthreads();
#pragma unroll
    for (int qg = 0; qg < 2; ++qg) {
        const float l = ls[qg][0];
        const float sc = (qg ? gate1 : gate0) * (l > 0.f ? frcp(l) : 0.f);
#pragma unroll
        for (int dt = 0; dt < 4; ++dt) acc_o[qg][dt] = acc_o[qg][dt] + O[qg][dt] * sc;
    }
}

#define XB_TMO      128
#define XB_XCNT(j)  (256  + 64 * (j))
#define XB_XSUB(j)  (1280 + 64 * (j))
#define XB_XGEN(j)  (2304 + 64 * (j))
#define XB_TOP      3328
#define XB_TOPGEN   3392
#define XCD_BAR_WORDS 3456
#define XB_SPIN_CAP (1u << 22)
__device__ __forceinline__ unsigned xb_ld(unsigned* p)              { return __hip_atomic_load(p, __ATOMIC_RELAXED, __HIP_MEMORY_SCOPE_AGENT); }
__device__ __forceinline__ unsigned xb_add(unsigned* p, unsigned v) { return __hip_atomic_fetch_add(p, v, __ATOMIC_RELAXED, __HIP_MEMORY_SCOPE_AGENT); }
__device__ __forceinline__ unsigned xb_xcc_id() { return (unsigned)__builtin_amdgcn_s_getreg((3 << 11) | 20) & 0xFu; }
#define XB_SPIN(cond, bar) do { unsigned _sp = 0; while (cond) { __builtin_amdgcn_s_sleep(1); \
    if ((++_sp & 255u) == 0u) { if (xb_ld(&(bar)[XB_TMO])) break; if (_sp > XB_SPIN_CAP) { atomicAdd(&(bar)[XB_TMO], 1u); break; } } } } while (0)
__device__ __forceinline__ void xcd_barrier_complete(unsigned* bar, unsigned x, unsigned G, unsigned& nloc, unsigned& nx) {
    unsigned sum, cnt, mine, sp = 0u;
    for (;;) {
        sum = 0u; cnt = 0u; mine = 0u;
#pragma unroll
        for (unsigned j = 0; j < 16; ++j) { const unsigned c = xb_ld(&bar[XB_XCNT(j)]); sum += c; cnt += (c > 0u) ? 1u : 0u; mine = (j == x) ? c : mine; }
        if (sum == G) break;
        __builtin_amdgcn_s_sleep(1);
        if ((++sp & 255u) == 0u) { if (xb_ld(&bar[XB_TMO])) break; if (sp > XB_SPIN_CAP) { atomicAdd(&bar[XB_TMO], 1u); break; } }
    }
    nloc = mine > 0u ? mine : 1u; nx = cnt > 0u ? cnt : 1u;
}
__device__ __forceinline__ void xcd_barrier(unsigned* bar, unsigned x, volatile LAS unsigned* st, unsigned G, bool is_leader) {
    asm volatile("s_waitcnt vmcnt(0)" ::: "memory");
    __syncthreads();
    if (is_leader) {
        __builtin_amdgcn_s_waitcnt(0);
        unsigned nloc = st[0], nx = st[1];
        if (nloc == 0u) { xcd_barrier_complete(bar, x, G, nloc, nx); st[0] = nloc; st[1] = nx; }
        const unsigned old = xb_add(&bar[XB_XSUB(x)], 1u);
        const unsigned gen = old / nloc;
        if (old + 1u == (gen + 1u) * nloc) {
            __builtin_amdgcn_fence(__ATOMIC_RELEASE, "agent");
            asm volatile("s_waitcnt vmcnt(0)" ::: "memory");
            const unsigned og = xb_add(&bar[XB_TOP], 1u);
            const unsigned tg = og / nx;
            if (og + 1u == (tg + 1u) * nx) xb_add(&bar[XB_TOPGEN], 1u);
            else XB_SPIN(xb_ld(&bar[XB_TOPGEN]) == tg, bar);
            __builtin_amdgcn_fence(__ATOMIC_ACQUIRE, "agent");
            xb_add(&bar[XB_XGEN(x)], 1u);
            asm volatile("s_waitcnt vmcnt(0)" ::: "memory");
        } else {
            XB_SPIN(xb_ld(&bar[XB_XGEN(x)]) == gen, bar);
            __builtin_amdgcn_fence(__ATOMIC_ACQUIRE, "agent");
            asm volatile("s_waitcnt vmcnt(0)" ::: "memory");
        }
    }
    __syncthreads();
}

__global__ void __launch_bounds__(NTHR, 2) hymba_fwd(Args args) {
    extern __shared__ __attribute__((aligned(16))) unsigned char lds_raw[];
    LAS unsigned char* lds = (LAS unsigned char*)lds_raw;
    cg::grid_group grid = cg::this_grid();
    const int G0 = gridDim.x, bid0 = blockIdx.x, wave0 = __builtin_amdgcn_readfirstlane((int)threadIdx.x >> 6);
    const int lo = args.ph_lo, hi = args.ph_hi;
#define IN(k) (lo <= (k) && (k) < hi)
    unsigned* const barw = (unsigned*)(args.ws + WS_BAR);
    volatile LAS unsigned* const xst = (volatile LAS unsigned*)(lds + 147200);
    const bool xlead = (wave0 == 0) && (__builtin_amdgcn_mbcnt_hi(~0u, __builtin_amdgcn_mbcnt_lo(~0u, 0u)) == 0u);
    const unsigned xcc = xb_xcc_id();
    if (hi - lo > 1) { if (xlead) { xst[0] = 0u; xst[1] = 0u; (void)xb_add(&barw[XB_XCNT(xcc)], 1u); } __syncthreads(); }
#define SEAM(k) do { if (IN(k) && IN((k) + 1)) xcd_barrier(barw, xcc, xst, (unsigned)G0, xlead); } while (0)
    if (lo < 0) grid.sync();

    if (IN(0)) {
        PHASE_LOCALS
        for (int rep = ((REP_MASK >> 0) & 1); rep >= 0; --rep) {
        LAS float* scr = (LAS float*)(lds + wave * 16384);
        const int gw = bid * 8 + wave, NGW = G * 8;
        constexpr int I0 = 16 * (INP / 32), I1 = 16 * 32, I2 = 16 * (2 * DFF / 32), I3 = (DFF / 64) * 32, I4 = 16 * 32, I5 = 4 * 32, I6 = 32 * 8, I7 = 32 * 8, I8 = 4 * 2, I9 = 4 * 2;
        constexpr int NIT = I0 + I1 + I2 + I3 + I4 + I5 + I6 + I7 + I8 + I9;
        for (int r0_ = (P0_REP & 1); r0_ >= 0; --r0_)
        for (int it = gw; it < NIT; it += NGW) {
            int r = it;
            if (r < I0) { const int nblk = INP / 32, kb = r / nblk, nb = r % nblk, np0 = nb * 32, tile = np0 >> 8, p = np0 & 255;
                const int src = tile < 13 ? tile * 256 + 64 * ((p >> 5) & 3) + 32 * (p >> 7) : 3328 + p;
                tr_item(args.in[opq(I_WIN)], DM, INW, (bf16_t*)(ws + WS_WIN), scr, kb * 64, np0, src, lane, args.in[opq(I_NMIX)]); continue; } r -= I0;
            if (r < I1) { tr_item(args.in[opq(I_WOUT)], DM, DM, (bf16_t*)(ws + WS_WOUT), scr, (r / 32) * 64, (r % 32) * 32, (r % 32) * 32, lane); continue; } r -= I1;
            if (r < I2) { const int nblk = 2 * DFF / 32, kb = r / nblk, nb = r % nblk, np0 = nb * 32, tile = np0 >> 8, p = np0 & 255;
                const int src = (p >> 7) * DFF + tile * 128 + (p & 127);
                tr_item(args.in[opq(I_WUP)], DM, 2 * DFF, (bf16_t*)(ws + WS_WUP), scr, kb * 64, np0, src, lane, args.in[opq(I_NFFN)]); continue; } r -= I2;
            if (r < I3) { tr_item(args.in[opq(I_WDN)], DFF, DM, (bf16_t*)(ws + WS_WDN), scr, (r / 32) * 64, (r % 32) * 32, (r % 32) * 32, lane); continue; } r -= I3;
            if (r < I4) { tr_item(args.in[opq(I_PLEG)], DM, DM, (bf16_t*)(ws + WS_WG), scr, (r / 32) * 64, (r % 32) * 32, (r % 32) * 32, lane); continue; } r -= I4;
            if (r < I5) { tr_item(args.in[opq(I_PLEW)], PLE, DM, (bf16_t*)(ws + WS_WP), scr, (r / 32) * 64, (r % 32) * 32, (r % 32) * 32, lane); continue; } r -= I5;
            if (r < I6) { tr_item(args.in[opq(I_KW1)], 2048, 256, (bf16_t*)(ws + WS_W1K), scr, (r / 8) * 64, (r % 8) * 32, (r % 8) * 32, lane); continue; } r -= I6;
            if (r < I7) { tr_item(args.in[opq(I_VW1)], 2048, 256, (bf16_t*)(ws + WS_W1V), scr, (r / 8) * 64, (r % 8) * 32, (r % 8) * 32, lane); continue; } r -= I7;
            if (r < I8) { tr_item(args.in[opq(I_KW2)], 256, 64, (bf16_t*)(ws + WS_W2K), scr, (r / 2) * 64, (r % 2) * 32, (r % 2) * 32, lane); continue; } r -= I8;
            tr_item(args.in[opq(I_VW2)], 256, 64, (bf16_t*)(ws + WS_W2V), scr, (r / 2) * 64, (r % 2) * 32, (r % 2) * 32, lane);
        }
        {
            const float* x = args.in[opq(I_X)]; bf16_t* xs = (bf16_t*)(ws + WS_XS); float* r0 = (float*)(ws + WS_R0);
            for (int r1_ = ((P0_REP >> 1) & 1); r1_ >= 0; --r1_)
            for (int m0 = gw * 4; m0 < T; m0 += NGW * 4) {
                f32x4 v[4][4];
#pragma unroll
                for (int rr = 0; rr < 4; ++rr)
#pragma unroll
                    for (int j = 0; j < 4; ++j) v[rr][j] = __builtin_nontemporal_load((const f32x4*)(x + (size_t)(m0 + rr) * DM) + lane + 64 * j);
                float s[4];
#pragma unroll
                for (int rr = 0; rr < 4; ++rr) { s[rr] = 0.f;
#pragma unroll
                    for (int j = 0; j < 4; ++j) s[rr] += (v[rr][j][0] * v[rr][j][0] + v[rr][j][1] * v[rr][j][1]) + (v[rr][j][2] * v[rr][j][2] + v[rr][j][3] * v[rr][j][3]); }
#pragma unroll
                for (int o = 1; o < 64; o <<= 1) { s[0] += __shfl_xor(s[0], o); s[1] += __shfl_xor(s[1], o); s[2] += __shfl_xor(s[2], o); s[3] += __shfl_xor(s[3], o); }
                if (lane < 4) r0[m0 + lane] = rsqrtf((lane == 0 ? s[0] : lane == 1 ? s[1] : lane == 2 ? s[2] : s[3]) * (1.f / DM) + EPS);
#pragma unroll
                for (int j = 0; j < 4; ++j) {
#pragma unroll
                    for (int rr = 0; rr < 4; ++rr) *(u32x2*)(xs + (size_t)(m0 + rr) * DM + 4 * lane + 256 * j) = pack4(v[rr][j]); }
            }
        }
        const int gt = bid * NTHR + tid, NGT = G * NTHR;
        { const f32x4* p4 = (const f32x4*)args.in[opq(I_P)]; u32x2* pb = (u32x2*)(ws + WS_PB);
            for (int r2_ = ((P0_REP >> 2) & 1); r2_ >= 0; --r2_)
#pragma unroll 8
            for (int i = gt; i < T * PLE / 4; i += NGT) pb[i] = pack4(__builtin_nontemporal_load(p4 + i)); }
        { float* z1 = (float*)(ws + WS_SS1); float* z3 = (float*)(ws + WS_SS3); for (int i = gt; i < T; i += NGT) { z1[i] = 0.f; z3[i] = 0.f; } }
        { float* c1p = (float*)(ws + WS_C1P); const float* cp = args.in[opq(I_CPOS)];
            for (int r4_ = ((P0_REP >> 4) & 1); r4_ >= 0; --r4_)
            for (int i = gt; i < 16 * 512; i += NGT) { const int kc = i >> 9, o = i & 511; const float* w1 = ((o >> 8) ? args.in[opq(I_VW1)] : args.in[opq(I_KW1)]); const int n = o & 255; float s = 0.f;
#pragma unroll 32
                for (int k = kc * 128; k < kc * 128 + 128; ++k) s += cp[k] * w1[(size_t)k * 256 + n];
                c1p[i] = s; } }
        if (rep > 0) { asm volatile("s_waitcnt vmcnt(0) lgkmcnt(0)" ::: "memory"); __syncthreads(); }
        }
    }
    SEAM(0);
    for (int xb = 0; xb < XBAR; ++xb) { SEAM(0); }

    if (IN(1)) {
        PHASE_LOCALS
        for (int rep = ((REP_MASK >> 1) & 1); rep >= 0; --rep) {
        if (bid == 0) { const float* c1p = (const float*)(ws + WS_C1P); float s = 0.f; for (int k = 0; k < 16; ++k) s += c1p[k * 512 + tid]; ((float*)(ws + WS_C1))[tid] = s; }
        {
            pg8::Gemm g{(const bf16_t*)(ws + WS_XS), (const bf16_t*)(ws + WS_WIN), T, INP, DM, DM, DM}; pg8::StaticOrder S; S.init(T, INP, G, bid);
            for (int rep4 = ((REP2 >> 2) & 1); rep4 >= 0; --rep4) {
            EpiIn E{(const float*)(ws + WS_R0), (const int*)args.in[opq(I_POS)], ws};
            pg8::gemm_phase(lds, g, S, E, tid); }
        }
        if (rep > 0) { asm volatile("s_waitcnt vmcnt(0) lgkmcnt(0)" ::: "memory"); __syncthreads(); }
        }
    }
    SEAM(1);

    if (IN(2)) {
        PHASE_LOCALS
        for (int rep = ((REP_MASK >> 2) & 1); rep >= 0; --rep) {
        const int ngemm = (G >= 128) ? 64 : 0;
        {
            for (int q = bid; q < 64; q += G) {
                const int kv = q >> 5, ks = (q >> 4) & 1;
                pg8::Gemm g{(const bf16_t*)(ws + (kv ? WS_VC : WS_KC)) + ks * 1024, (const bf16_t*)(ws + (kv ? WS_W1V : WS_W1K)) + ks * 1024, 4096, 256, 1024, 1024, 2048};
                pg8::StaticOrder S; S.init(4096, 256, 16, q & 15);
                EpiF32 E{(float*)(ws + WS_SB) + (size_t)(kv * 2 + ks) * 4096 * 256, 256};
                pg8::gemm_phase(lds, g, S, E, tid);
            }
        }
        if (bid >= ngemm) {
            const bf16_t* RK = (const bf16_t*)(ws + WS_RK); const bf16_t* RV = (const bf16_t*)(ws + WS_RV); float* KV = (float*)(ws + WS_KVST);
            for (int it = bid - ngemm; it < 2048; it += G - ngemm) {
                const int n = it & 31, h = (it >> 5) & 7, b = it >> 8;
                const float lg2 = log1pf(-exp2f(-5.f - (float)h)) * 1.4426950408889634f;
#pragma unroll
                for (int i = 0; i < 2; ++i) {
                    const int ch = tid + i * NTHR, k = ch >> 3, c8 = ch & 7; const size_t src = ((size_t)(b * SEQ + n * 128 + k)) * 512 + h * 64 + c8 * 8;
                    const u32x4 kr = *(const u32x4*)(RK + src), vr = *(const u32x4*)(RV + src);
                    const float dk = fexp2((float)(127 - k) * lg2); u32x4 ko;
                    ko.x = cvt_pk_bf16(__uint_as_float(kr.x << 16) * dk, __uint_as_float(kr.x & 0xffff0000u) * dk); ko.y = cvt_pk_bf16(__uint_as_float(kr.y << 16) * dk, __uint_as_float(kr.y & 0xffff0000u) * dk);
                    ko.z = cvt_pk_bf16(__uint_as_float(kr.z << 16) * dk, __uint_as_float(kr.z & 0xffff0000u) * dk); ko.w = cvt_pk_bf16(__uint_as_float(kr.w << 16) * dk, __uint_as_float(kr.w & 0xffff0000u) * dk);
                    *(LAS u32x4*)(lds + k * RS + c8 * 16) = ko; *(LAS u32x4*)(lds + 18432 + k * RS + c8 * 16) = vr;
                }
                __syncthreads();
                const LAS unsigned char* tb = lds + (4 * fq + (fr >> 2)) * RS + (fr & 3) * 8;
#pragma unroll
                for (int tt = 0; tt < 2; ++tt) {
                    const int et = (2 * wave + tt) >> 2, dt = (2 * wave + tt) & 3; f32x4 a = (f32x4){0.f, 0.f, 0.f, 0.f};
#pragma unroll
                    for (int kk = 0; kk < 4; ++kk) {
                        const bf16x8 af = cat8(trrd(tb + 18432 + (32 * kk) * RS + et * 32), trrd(tb + 18432 + (32 * kk + 16) * RS + et * 32));
                        const bf16x8 bf = cat8(trrd(tb + (32 * kk) * RS + dt * 32), trrd(tb + (32 * kk + 16) * RS + dt * 32));
                        a = mfma16(af, bf, a);
                    }
                    float* dst = KV + (size_t)it * 4096 + (16 * et + 4 * fq) * 64 + 16 * dt + fr;
                    dst[0] = a[0]; dst[64] = a[1]; dst[128] = a[2]; dst[192] = a[3];
                }
                __syncthreads();
            }
        }
        if (rep > 0) { asm volatile("s_waitcnt vmcnt(0) lgkmcnt(0)" ::: "memory"); __syncthreads(); }
        }
    }
    SEAM(2);

    if (IN(3)) {
        PHASE_LOCALS
        for (int rep = ((REP_MASK >> 3) & 1); rep >= 0; --rep) {
        for (int it = bid * 8 + wave; it < 512; it += G * 8) {
            const int kv = it >> 8, r0 = (it & 255) * 16;
            const bf16_t* w2 = (const bf16_t*)(ws + (kv ? WS_W2V : WS_W2K)); bf16_t* o = (bf16_t*)(ws + (kv ? WS_CV : WS_CK));
            f32x4 a[4];
#pragma unroll
            for (int nt = 0; nt < 4; ++nt) a[nt] = (f32x4){0.f, 0.f, 0.f, 0.f};
#pragma unroll 2
            for (int ks = 0; ks < 8; ++ks) {
                bf16x8 hf;
                { const float* p0 = (const float*)(ws + WS_SB) + ((size_t)(kv * 2) * 4096 + r0 + fr) * 256 + 32 * ks + 8 * fq; const float* p1 = p0 + (size_t)4096 * 256;
                  const float* cb = (const float*)(ws + WS_C1) + kv * 256 + 32 * ks + 8 * fq;
                  f32x4 a0 = *(const f32x4*)p0 + *(const f32x4*)p1 + *(const f32x4*)cb, a1 = *(const f32x4*)(p0 + 4) + *(const f32x4*)(p1 + 4) + *(const f32x4*)(cb + 4);
#pragma unroll
                  for (int e = 0; e < 4; ++e) { a0[e] = gelu_tanh(a0[e]); a1[e] = gelu_tanh(a1[e]); }
                  hf = pack8(a0, a1); }
#pragma unroll
                for (int nt = 0; nt < 4; ++nt) { const bf16x8 wf = *(const bf16x8*)(w2 + (size_t)(16 * nt + fr) * 256 + 32 * ks + 8 * fq); a[nt] = mfma16(wf, hf, a[nt]); }
            }
#pragma unroll
            for (int nt = 0; nt < 4; ++nt) *(u32x2*)(o + (size_t)(r0 + fr) * 64 + 16 * nt + 4 * fq) = pack4(a[nt]);
        }
        float* KV = (float*)(ws + WS_KVST);
        for (int i = bid * NTHR + tid; i < 64 * 4096; i += G * NTHR) {
            const int bh = i >> 12, el = i & 4095, h = bh & 7;
            const float cd = fexp2(128.f * log1pf(-exp2f(-5.f - (float)h)) * 1.4426950408889634f);
            float* p = KV + (size_t)bh * 32 * 4096 + el; float s = 0.f;
#pragma unroll
            for (int n0 = 0; n0 < 32; n0 += 8) { float t[8];
#pragma unroll
                for (int n = 0; n < 8; ++n) t[n] = p[(size_t)(n0 + n) * 4096];
#pragma unroll
                for (int n = 0; n < 8; ++n) { p[(size_t)(n0 + n) * 4096] = s; s = s * cd + t[n]; } }
        }
        {
            pg8::Gemm g{(const bf16_t*)(ws + WS_PB), (const bf16_t*)(ws + WS_WP), T, DM, PLE, PLE, PLE}; pg8::StaticOrder S; S.init(T, DM, G, bid);
            EpiBf16<0> E{(bf16_t*)(ws + WS_PE), DM, nullptr};
            pg8::gemm_phase(lds, g, S, E, tid);
        }
        if (rep > 0) { asm volatile("s_waitcnt vmcnt(0) lgkmcnt(0)" ::: "memory"); __syncthreads(); }
        }
    }
    SEAM(3);

    if (IN(4)) {
        PHASE_LOCALS
        for (int rep = ((REP_MASK >> 4) & 1); rep >= 0; --rep) {
        bf16_t* MIX = (bf16_t*)out + (size_t)T * DM;
        LAS unsigned char* CKl = lds + 36864; LAS unsigned char* CVl = lds + 73728; LAS float* IMP = (LAS float*)(lds + 110592);
        LAS unsigned long long* SELM = (LAS unsigned long long*)(lds + 127232); LAS unsigned long long* UNI = (LAS unsigned long long*)(lds + 127744);
        const bf16_t* NQ = (const bf16_t*)(ws + WS_NQ); const float* NG = (const float*)(ws + WS_NG);
#ifndef DBG_SKIP
#define DBG_SKIP 0
#endif
        for (int rep2 = (REP2 & 1); rep2 >= 0; --rep2)
        for (int it = bid; it < ((DBG_SKIP & 1) ? 0 : 1024); it += G) {
            const int vb_ = it & 255, v = (G == 256) ? ((vb_ & 7) * 32 + (vb_ >> 3)) : vb_, kq = it >> 8, bg = v >> 4, s16 = v & 15;
            const int qb = (kq == 0) ? s16 : (kq == 1) ? 31 - s16 : (kq == 2) ? 32 + s16 : 63 - s16;
            const int b = bg >> 1, g = bg & 1;
            const int hr = fr >> 2, toff = 8 * wave + (fr & 3);
            const int head = g * 4 + hr;
            bf16x8 Qf[2][2]; float gate[2][3]; f32x4 acc_o[2][4];
#pragma unroll
            for (int qg = 0; qg < 2; ++qg) {
                const size_t row = (size_t)b * SEQ + 64 * qb + toff + 4 * qg;
#pragma unroll
                for (int ks = 0; ks < 2; ++ks) Qf[qg][ks] = *(const bf16x8*)(NQ + row * 512 + head * 64 + 32 * ks + 8 * fq);
#pragma unroll
                for (int br = 0; br < 3; ++br) gate[qg][br] = NG[row * 24 + head * 3 + br];
#pragma unroll
                for (int dt = 0; dt < 4; ++dt) acc_o[qg][dt] = (f32x4){0.f, 0.f, 0.f, 0.f};
                if (DBG_SKIP & 16) { gate[qg][0] = 1.f; gate[qg][1] = 1.f; gate[qg][2] = 1.f; }
                if (DBG_SKIP & 32) { const bf16x8 cq = {0x3c00, 0x3c80, 0x3d00, 0x3c00, 0x3d80, 0x3c00, 0x3c80, 0x3d00}; Qf[qg][0] = cq; Qf[qg][1] = cq; }
            }
            for (int nrep = (NSA_REP & 1); nrep >= 0; --nrep) {
            float zf = 0.f; asm volatile("" : "+v"(zf));
            const int ncv = (4 * qb + 3 < 255) ? 4 * qb + 3 : 255, NT2 = (ncv + 31) >> 5;
            {
                const bf16_t* ckg = (const bf16_t*)(ws + WS_CK) + (size_t)bg * 256 * 64; const bf16_t* cvg = (const bf16_t*)(ws + WS_CV) + (size_t)bg * 256 * 64;
                int ch0_ = tid; asm volatile("" : "+v"(ch0_));
                for (int ch = ch0_; ch < NT2 * 32 * 8; ch += NTHR) { const int r = ch >> 3, c8 = ch & 7;
                    u32x4 a_ = *(const u32x4*)(ckg + r * 64 + c8 * 8), b_ = *(const u32x4*)(cvg + r * 64 + c8 * 8);
                    if (DBG_SKIP & 128) { a_ = *(const u32x4*)((const bf16_t*)(ws + WS_HIDK) + ((size_t)bg * 256 + r) * 256 + c8 * 8); b_ = *(const u32x4*)((const bf16_t*)(ws + WS_HIDV) + ((size_t)bg * 256 + r) * 256 + c8 * 8); }
                    if (DBG_SKIP & 64) { const unsigned pz = 0x3c003c00u + ((unsigned)((r * 7 + c8 * 3) & 63) << 16) + (unsigned)((r * 5 + c8) & 31); a_ = (u32x4){pz, pz + 1u, pz + 2u, pz + 3u}; b_ = (u32x4){pz + 4u, pz + 5u, pz + 6u, pz + 7u}; }
                    *(LAS u32x4*)(CKl + r * RS + c8 * 16) = a_; *(LAS u32x4*)(CVl + r * RS + c8 * 16) = b_; }
            }
            __syncthreads();
            float cm[2] = {-1e30f, -1e30f}, cl[2] = {0.f, 0.f};
            const LAS unsigned char* kb = CKl + fr * RS + fq * 16;
            for (int kt = 0; kt < 2 * NT2; ++kt) {
                f32x4 S[2] = {(f32x4){0.f, 0.f, 0.f, 0.f}, (f32x4){0.f, 0.f, 0.f, 0.f}};
#pragma unroll
                for (int ks = 0; ks < 2; ++ks) { const bf16x8 kf = *(const LAS bf16x8*)(kb + kt * 16 * RS + ks * 64); S[0] = mfma16(kf, Qf[0][ks], S[0]); S[1] = mfma16(kf, Qf[1][ks], S[1]); }
#pragma unroll
                for (int qg = 0; qg < 2; ++qg) {
                    const int tq = 64 * qb + toff + 4 * qg; float rm = -INFINITY;
#pragma unroll
                    for (int e = 0; e < 4; ++e) { const int n = 16 * kt + 4 * fq + e; const float vv = (16 * n + 31 <= tq) ? S[qg][e] : -INFINITY; S[qg][e] = vv; rm = fmaxf(rm, vv); }
                    rm = rows_max(rm);
                    const float mn = fmaxf(cm[qg], rm); float sum = 0.f;
#pragma unroll
                    for (int e = 0; e < 4; ++e) sum += fexp2(S[qg][e] - mn);
                    cl[qg] = cl[qg] * fexp2(cm[qg] - mn) + sum; cm[qg] = mn;
                }
            }
            float cinv[2];
#pragma unroll
            for (int qg = 0; qg < 2; ++qg) { float l = cl[qg]; l = rows_sum(l); cinv[qg] = l > 0.f ? frcp(l) : 0.f; }
            {
                f32x4 O[2][4];
#pragma unroll
                for (int qg = 0; qg < 2; ++qg)
#pragma unroll
                    for (int dt = 0; dt < 4; ++dt) O[qg][dt] = (f32x4){0.f, 0.f, 0.f, 0.f};
                float carry[2] = {0.f, 0.f};
                const LAS unsigned char* vb = CVl + (4 * fq + (fr >> 2)) * RS + (fr & 3) * 8;
                for (int k2 = 0; k2 < NT2; ++k2) {
                    f32x4 S[2][2];
#pragma unroll
                    for (int qg = 0; qg < 2; ++qg) { S[qg][0] = (f32x4){0.f, 0.f, 0.f, 0.f}; S[qg][1] = (f32x4){0.f, 0.f, 0.f, 0.f}; }
#pragma unroll
                    for (int ks = 0; ks < 2; ++ks)
#pragma unroll
                        for (int t2 = 0; t2 < 2; ++t2) { const bf16x8 kf = *(const LAS bf16x8*)(kb + (2 * k2 + t2) * 16 * RS + ks * 64); S[0][t2] = mfma16(kf, Qf[0][ks], S[0][t2]); S[1][t2] = mfma16(kf, Qf[1][ks], S[1][t2]); }
                    bf16x8 Pf[2];
#pragma unroll
                    for (int qg = 0; qg < 2; ++qg) {
                        const int tq = 64 * qb + toff + 4 * qg;
#pragma unroll
                        for (int t2 = 0; t2 < 2; ++t2) {
                            const int kt = 2 * k2 + t2; float gs = 0.f;
#pragma unroll
                            for (int e = 0; e < 4; ++e) { const int n = 16 * kt + 4 * fq + e; const float p = (16 * n + 31 <= tq) ? fexp2(S[qg][t2][e] - cm[qg]) * cinv[qg] : 0.f; S[qg][t2][e] = p; gs += p; }
                            const float tsh = __shfl(S[qg][t2][3], (lane + 48) & 63);
                            float iv = gs + (fq == 0 ? carry[qg] : tsh); carry[qg] = tsh;
                            iv += __shfl_xor(iv, 4); iv += __shfl_xor(iv, 8);
                            if (hr == 0) IMP[(toff + 4 * qg) * 65 + 4 * kt + fq] = iv;
                        }
                        Pf[qg] = pack8(S[qg][0], S[qg][1]);
                    }
#pragma unroll
                    for (int dt = 0; dt < 4; ++dt) {
                        const bf16x8 vf = cat8(trrd(vb + (32 * k2) * RS + dt * 32), trrd(vb + (32 * k2 + 16) * RS + dt * 32));
                        O[0][dt] = mfma16(vf, Pf[0], O[0][dt]); O[1][dt] = mfma16(vf, Pf[1], O[1][dt]);
                    }
                }
#pragma unroll
                for (int qg = 0; qg < 2; ++qg)
#pragma unroll
                    for (int dt = 0; dt < 4; ++dt) acc_o[qg][dt] = acc_o[qg][dt] + O[qg][dt] * (nrep > 0 ? zf : gate[qg][0]);
            }
            __syncthreads();
            {
                const int tok = tid >> 3, sub = tid & 7; unsigned long long bits = 0ull;
                if (qb >= 16) {
                    for (int j = 1 + sub; j <= qb - 2; j += 8) {
                        const float vj = IMP[tok * 65 + j]; int rank = 0;
                        for (int jj = 1; jj <= qb - 2; ++jj) { const float uu = IMP[tok * 65 + jj]; rank += (uu > vj || (uu == vj && jj < j)) ? 1 : 0; }
                        if (rank < 13) bits |= 1ull << j;
                    }
                    unsigned blo = (unsigned)bits, bhi = (unsigned)(bits >> 32);
                    blo |= __shfl_xor(blo, 1); bhi |= __shfl_xor(bhi, 1); blo |= __shfl_xor(blo, 2); bhi |= __shfl_xor(bhi, 2); blo |= __shfl_xor(blo, 4); bhi |= __shfl_xor(bhi, 4);
                    bits = ((unsigned long long)bhi << 32) | blo;
                    bits |= 1ull | (1ull << qb) | (1ull << (qb - 1));
                } else bits = (2ull << qb) - 1ull;
                if (sub == 0) SELM[tok] = bits;
                __syncthreads();
                if (tid < 64) {
                    unsigned long long u = SELM[tid]; unsigned ulo = (unsigned)u, uhi = (unsigned)(u >> 32);
#pragma unroll
                    for (int o = 1; o < 64; o <<= 1) { ulo |= __shfl_xor(ulo, o); uhi |= __shfl_xor(uhi, o); }
                    if (tid == 0) UNI[0] = ((unsigned long long)uhi << 32) | ulo;
                }
                __syncthreads();
            }
            }
            unsigned long long selm[2] = {SELM[toff], SELM[toff + 4]};
            unsigned long long umask = UNI[0];
            { const unsigned ulo = __builtin_amdgcn_readfirstlane((unsigned)umask), uhi = __builtin_amdgcn_readfirstlane((unsigned)(umask >> 32)); umask = ((unsigned long long)uhi << 32) | ulo; }
            for (int nrep = ((NSA_REP >> 1) & 1); nrep >= 0; --nrep) { float zf = 0.f; asm volatile("" : "+v"(zf));
            if (!(DBG_SKIP & 4)) attn_branch(lds, (const bf16_t*)(ws + WS_KS) + (size_t)bg * SEQ * 64, (const bf16_t*)(ws + WS_VS) + (size_t)bg * SEQ * 64, umask, qb, 0, Qf, selm, fr, fq, toff, nrep > 0 ? zf : gate[0][1], nrep > 0 ? zf : gate[1][1], acc_o, tid); }
            { const int j0 = qb >= 8 ? qb - 8 : 0; const unsigned long long wm = ((2ull << qb) - 1ull) & ~((1ull << j0) - 1ull);
              for (int nrep = ((NSA_REP >> 2) & 1); nrep >= 0; --nrep) { float zf = 0.f; asm volatile("" : "+v"(zf));
              if (!(DBG_SKIP & 8)) attn_branch(lds, (const bf16_t*)(ws + WS_KW) + (size_t)bg * SEQ * 64, (const bf16_t*)(ws + WS_VW) + (size_t)bg * SEQ * 64, wm, qb, 1, Qf, selm, fr, fq, toff, nrep > 0 ? zf : gate[0][2], nrep > 0 ? zf : gate[1][2], acc_o, tid); } }
#pragma unroll
            for (int qg = 0; qg < 2; ++qg) {
                const size_t row = (size_t)b * SEQ + 64 * qb + toff + 4 * qg;
#pragma unroll
                for (int dt = 0; dt < 4; ++dt) *(u32x2*)(MIX + row * DM + 512 + head * 64 + 16 * dt + 4 * fq) = pack4(acc_o[qg][dt]);
            }
        }
        {
            int lane2_ = (int)__builtin_amdgcn_mbcnt_hi(~0u, __builtin_amdgcn_mbcnt_lo(~0u, 0u)); asm volatile("" : "+v"(lane2_));
            const int lane = lane2_, tid = wave * 64 + lane, fr = lane & 15, fq = lane >> 4;
            const bf16_t* RQ = (const bf16_t*)(ws + WS_RQ); const bf16_t* RK = (const bf16_t*)(ws + WS_RK); const bf16_t* RV = (const bf16_t*)(ws + WS_RV); const bf16_t* RG = (const bf16_t*)(ws + WS_RG);
            const float* KV = (const float*)(ws + WS_KVST); const float* gnw = args.in[opq(I_GNW)];
            u32x4 pk[2], pv[2]; f32x4 ps0, ps1; bf16x8 pq[2]; u32x2 pg[4];
#define R3_ISSUE(IT) do { const int n_ = (IT) & 31, h_ = ((IT) >> 5) & 7, b_ = (IT) >> 8; \
                _Pragma("unroll") for (int i = 0; i < 2; ++i) { const int ch = tid + i * NTHR, k = ch >> 3, c8 = ch & 7; const size_t src = ((size_t)(b_ * SEQ + n_ * 128 + k)) * 512 + h_ * 64 + c8 * 8; pk[i] = *(const u32x4*)(RK + src); pv[i] = *(const u32x4*)(RV + src); } \
                { const f32x4* sp = (const f32x4*)(KV + (size_t)(IT) * 4096 + (tid >> 3) * 64 + (tid & 7) * 8); ps0 = sp[0]; ps1 = sp[1]; } \
                { const size_t row_ = (size_t)b_ * SEQ + n_ * 128 + 16 * wave + fr; pq[0] = *(const bf16x8*)(RQ + row_ * 512 + h_ * 64 + 8 * fq); pq[1] = *(const bf16x8*)(RQ + row_ * 512 + h_ * 64 + 32 + 8 * fq); \
                  _Pragma("unroll") for (int dt = 0; dt < 4; ++dt) pg[dt] = *(const u32x2*)(RG + row_ * 512 + h_ * 64 + 16 * dt + 4 * fq); } } while (0)
            for (int rep3 = ((REP2 >> 1) & 1); rep3 >= 0; --rep3) {
            const int itend = (DBG_SKIP & 2) ? 0 : 2048;
            if (bid < itend) R3_ISSUE(bid);
            for (int it = bid; it < itend; it += G) {
                const int n = it & 31, h = (it >> 5) & 7, b = it >> 8;
                const float lg2 = log1pf(-exp2f(-5.f - (float)h)) * 1.4426950408889634f;
#pragma unroll
                for (int i = 0; i < 2; ++i) { const int ch = tid + i * NTHR, k = ch >> 3, c8 = ch & 7;
                    *(LAS u32x4*)(lds + k * RS + c8 * 16) = pk[i]; *(LAS u32x4*)(lds + 18432 + k * RS + c8 * 16) = pv[i]; }
                { const int e = tid >> 3, c8 = tid & 7;
                    u32x4 o; o.x = cvt_pk_bf16(ps0[0], ps0[1]); o.y = cvt_pk_bf16(ps0[2], ps0[3]); o.z = cvt_pk_bf16(ps1[0], ps1[1]); o.w = cvt_pk_bf16(ps1[2], ps1[3]);
                    *(LAS u32x4*)(lds + 36864 + e * RS + c8 * 16) = o; }
                bf16x8 Qf[2] = {pq[0], pq[1]}; u32x2 rgv[4] = {pg[0], pg[1], pg[2], pg[3]};
                __syncthreads();
                if (it + G < itend) R3_ISSUE(it + G);
                const int c = 16 * wave + fr; const size_t row = (size_t)b * SEQ + n * 128 + c;
                f32x4 O[4], X[4];
#pragma unroll
                for (int dt = 0; dt < 4; ++dt) { O[dt] = (f32x4){0.f, 0.f, 0.f, 0.f}; X[dt] = (f32x4){0.f, 0.f, 0.f, 0.f}; }
                const LAS unsigned char* kb = lds + fr * RS + fq * 16;
                const LAS unsigned char* vb = lds + 18432 + (4 * fq + (fr >> 2)) * RS + (fr & 3) * 8;
                for (int k2 = 0; k2 <= (wave >> 1); ++k2) {
                    f32x4 S0 = (f32x4){0.f, 0.f, 0.f, 0.f}, S1 = S0;
#pragma unroll
                    for (int ks = 0; ks < 2; ++ks) { S0 = mfma16(*(const LAS bf16x8*)(kb + (32 * k2) * RS + ks * 64), Qf[ks], S0); S1 = mfma16(*(const LAS bf16x8*)(kb + (32 * k2 + 16) * RS + ks * 64), Qf[ks], S1); }
#pragma unroll
                    for (int e = 0; e < 4; ++e) { const int d0 = c - (32 * k2 + 4 * fq + e), d1 = d0 - 16;
                        S0[e] = d0 >= 0 ? S0[e] * fexp2((float)d0 * lg2) : 0.f; S1[e] = d1 >= 0 ? S1[e] * fexp2((float)d1 * lg2) : 0.f; }
                    const bf16x8 pf = pack8(S0, S1);
#pragma unroll
                    for (int dt = 0; dt < 4; ++dt) O[dt] = mfma16(cat8(trrd(vb + (32 * k2) * RS + dt * 32), trrd(vb + (32 * k2 + 16) * RS + dt * 32)), pf, O[dt]);
                }
#pragma unroll
                for (int ks = 0; ks < 2; ++ks)
#pragma unroll
                    for (int dt = 0; dt < 4; ++dt) X[dt] = mfma16(*(const LAS bf16x8*)(lds + 36864 + (16 * dt + fr) * RS + ks * 64 + fq * 16), Qf[ks], X[dt]);
                const float qd = fexp2((float)(c + 1) * lg2);
                float s = 0.f;
#pragma unroll
                for (int dt = 0; dt < 4; ++dt) { O[dt] = O[dt] + X[dt] * qd; s += (O[dt][0] + O[dt][1]) + (O[dt][2] + O[dt][3]); }
                s += __shfl_xor(s, 16); s += __shfl_xor(s, 32);
                const float mu = s * (1.f / 64.f); float q = 0.f;
#pragma unroll
                for (int dt = 0; dt < 4; ++dt) { O[dt] = O[dt] - mu; q += (O[dt][0] * O[dt][0] + O[dt][1] * O[dt][1]) + (O[dt][2] * O[dt][2] + O[dt][3] * O[dt][3]); }
                q += __shfl_xor(q, 16); q += __shfl_xor(q, 32);
                const float rstd = rsqrtf(q * (1.f / 64.f) + EPS);
#pragma unroll
                for (int dt = 0; dt < 4; ++dt) {
                    const int e0 = h * 64 + 16 * dt + 4 * fq; const f32x4 gw = *(const f32x4*)(gnw + e0); const u32x2 rg = rgv[dt];
                    f32x4 o = O[dt] * rstd * gw;
                    o[0] *= __uint_as_float(rg.x << 16); o[1] *= __uint_as_float(rg.x & 0xffff0000u); o[2] *= __uint_as_float(rg.y << 16); o[3] *= __uint_as_float(rg.y & 0xffff0000u);
                    *(u32x2*)(MIX + row * DM + e0) = pack4(o);
                }
                __syncthreads();
            }
            }
#undef R3_ISSUE
        }
        if (rep > 0) { asm volatile("s_waitcnt vmcnt(0) lgkmcnt(0)" ::: "memory"); __syncthreads(); }
        }
    }
    SEAM(4);

    if (IN(5)) {
        PHASE_LOCALS
        for (int rep = ((REP_MASK >> 5) & 1); rep >= 0; --rep) {
        pg8::Gemm g{(const bf16_t*)out + (size_t)T * DM, (const bf16_t*)(ws + WS_WOUT), T, DM, DM, DM, DM}; pg8::StaticOrder S; S.init(T, DM, G, bid);
        EpiOut E{(const bf16_t*)(ws + WS_XS), (bf16_t*)out, (float*)(ws + WS_SS1), rep > 0 ? lnd_i(1) : 0};
        pg8::gemm_phase(lds, g, S, E, tid);
        if (rep > 0) { asm volatile("s_waitcnt vmcnt(0) lgkmcnt(0)" ::: "memory"); __syncthreads(); }
        }
    }
    SEAM(5);

    if (IN(6)) {
        PHASE_LOCALS
        for (int rep = ((REP_MASK >> 6) & 1); rep >= 0; --rep) {
        pg8::Gemm g{(const bf16_t*)out, (const bf16_t*)(ws + WS_WUP), T, 2 * DFF, DM, DM, DM}; pg8::StaticOrder S; S.init(T, 2 * DFF, G, bid);
        EpiUp E{(const float*)(ws + WS_SS1), args.in[opq(I_CONVW)], args.in[opq(I_CONVB)], (bf16_t*)(ws + WS_ACT), (float*)(ws + WS_SB)};
        pg8::gemm_phase(lds, g, S, E, tid);
        if (rep > 0) { asm volatile("s_waitcnt vmcnt(0) lgkmcnt(0)" ::: "memory"); __syncthreads(); }
        }
    }
    SEAM(6);

    if (IN(7)) {
        PHASE_LOCALS
        for (int rep = ((REP_MASK >> 7) & 1); rep >= 0; --rep) {
        const float* sb = (const float*)(ws + WS_SB); const float* cw = args.in[opq(I_CONVW)]; const float* cb = args.in[opq(I_CONVB)]; bf16_t* act = (bf16_t*)(ws + WS_ACT);
        for (int i = bid * NTHR + tid; i < 512 * 2 * (DFF / 4); i += G * NTHR) {
            const int c = (i % (DFF / 4)) * 4, ur = i / (DFF / 4), rr = ur & 1, u = ur >> 1; const bool first = (u & 63) == 0;
            const float* su = sb + (size_t)u * 6 * DFF + c; const float* sp = su - 6 * DFF;
            const f32x4 z4 = (f32x4){0.f, 0.f, 0.f, 0.f};
            const f32x4 gt = *(const f32x4*)(su + rr * DFF), vt = *(const f32x4*)(su + (2 + rr) * DFF);
            f32x4 g1, g2;
            if (rr == 0) { g1 = first ? z4 : *(const f32x4*)(sp + 5 * DFF); g2 = first ? z4 : *(const f32x4*)(sp + 4 * DFF); } else { g1 = *(const f32x4*)su; g2 = first ? z4 : *(const f32x4*)(sp + 5 * DFF); }
            const f32x4 gate = *(const f32x4*)(cb + c) + *(const f32x4*)(cw + c) * g2 + *(const f32x4*)(cw + DFF + c) * g1 + *(const f32x4*)(cw + 2 * DFF + c) * gt;
            f32x4 o; o[0] = siluf_(gate[0]) * vt[0]; o[1] = siluf_(gate[1]) * vt[1]; o[2] = siluf_(gate[2]) * vt[2]; o[3] = siluf_(gate[3]) * vt[3];
            *(u32x2*)(act + (size_t)(64 * u + rr) * DFF + c) = pack4(o);
        }
        if (rep > 0) { asm volatile("s_waitcnt vmcnt(0) lgkmcnt(0)" ::: "memory"); __syncthreads(); }
        }
    }
    SEAM(7);

    if (IN(8)) {
        PHASE_LOCALS
        for (int rep = ((REP_MASK >> 8) & 1); rep >= 0; --rep) {
        pg8::Gemm g{(const bf16_t*)(ws + WS_ACT), (const bf16_t*)(ws + WS_WDN), T, DM, DFF, DFF, DFF}; pg8::StaticOrder S; S.init(T, DM, G, bid);
        EpiDown E{(const bf16_t*)out, (bf16_t*)(ws + WS_HS), rep > 0 ? lnd_i(1) : 0};
        pg8::gemm_phase(lds, g, S, E, tid);
        if (rep > 0) { asm volatile("s_waitcnt vmcnt(0) lgkmcnt(0)" ::: "memory"); __syncthreads(); }
        }
    }
    SEAM(8);

    if (IN(9)) {
        PHASE_LOCALS
        for (int rep = ((REP_MASK >> 9) & 1); rep >= 0; --rep) {
        pg8::Gemm g{(const bf16_t*)(ws + WS_HS), (const bf16_t*)(ws + WS_WG), T, DM, DM, DM, DM}; pg8::StaticOrder S; S.init(T, DM, G, bid);
        EpiPle E{(const bf16_t*)(ws + WS_HS), (bf16_t*)(ws + WS_ACT), (const bf16_t*)(ws + WS_PE), (float*)(ws + WS_SS3), rep > 0 ? lnd_i(1) : 0};
        pg8::gemm_phase(lds, g, S, E, tid);
        if (rep > 0) { asm volatile("s_waitcnt vmcnt(0) lgkmcnt(0)" ::: "memory"); __syncthreads(); }
        }
    }
    SEAM(9);

    if (IN(10)) {
        PHASE_LOCALS
        const float* ss = (const float*)(ws + WS_SS3); const f32x4* wf = (const f32x4*)args.in[opq(I_FNW)]; f32x4* o4 = (f32x4*)out;
        const int gw = bid * 8 + wave, NGW = G * 8; const u32x2* h3 = (const u32x2*)(ws + WS_ACT);
        f32x4 wv[4];
#pragma unroll
        for (int j = 0; j < 4; ++j) wv[j] = wf[lane + 64 * j];
        for (int r0_ = gw * 4; r0_ < T; r0_ += NGW * 4) {
            u32x2 hv[4][4]; float rs[4];
#pragma unroll
            for (int rr = 0; rr < 4; ++rr) { rs[rr] = ss[r0_ + rr];
#pragma unroll
                for (int j = 0; j < 4; ++j) hv[rr][j] = __builtin_nontemporal_load(h3 + (size_t)(r0_ + rr) * 256 + lane + 64 * j); }
#pragma unroll
            for (int rr = 0; rr < 4; ++rr) { const float sc = rsqrtf(rs[rr] * (1.f / DM) + EPS);
#pragma unroll
                for (int j = 0; j < 4; ++j) { const u32x2 hw = hv[rr][j];
                    __builtin_nontemporal_store((f32x4){__uint_as_float(hw.x << 16), __uint_as_float(hw.x & 0xffff0000u), __uint_as_float(hw.y << 16), __uint_as_float(hw.y & 0xffff0000u)} * sc * wv[j], o4 + (size_t)(r0_ + rr) * 256 + lane + 64 * j); } }
        }
    }
#undef IN
#undef SEAM
}

extern "C" void kernel_launch(void* const* d_in, const int* in_sizes, int n_in, void* d_out, int out_size, void* d_ws, size_t ws_size, hipStream_t stream) {
    static int grid = 0;
    if (grid == 0) {
        if (n_in != 20 || out_size != T * DM || ws_size < WS_END) { fprintf(stderr, "kernel_launch: unexpected shapes (n_in %d out %d ws %zu)\n", n_in, out_size, ws_size); grid = -1; return; }
        int dev = 0, cus = 0, per_cu = 0;
        hipGetDevice(&dev); hipDeviceGetAttribute(&cus, hipDeviceAttributeMultiprocessorCount, dev);
        hipFuncSetAttribute((const void*)hymba_fwd, hipFuncAttributeMaxDynamicSharedMemorySize, LDS_BYTES);
        hipOccupancyMaxActiveBlocksPerMultiprocessor(&per_cu, (const void*)hymba_fwd, NTHR, LDS_BYTES);
        (void)hipGetLastError();
        if (per_cu < 1) { fprintf(stderr, "kernel_launch: occupancy query says %d blocks/CU\n", per_cu); per_cu = 1; }
        grid = cus;
    }
    if (grid < 0) return;
    Args a{};
    for (int i = 0; i < 20; ++i) a.in[i] = (const float*)d_in[i];
    a.out = (float*)d_out; a.ws = (unsigned char*)d_ws;
    const int NPH = 11;
#if N_LAUNCH_PER_PHASE
    for (int p = 0; p < NPH; ++p) {
        a.ph_lo = p; a.ph_hi = p + 1; void* args[] = {&a};
        hipError_t e = hipLaunchCooperativeKernel((const void*)hymba_fwd, dim3(grid), dim3(NTHR), args, LDS_BYTES, stream);
        if (e != hipSuccess) { fprintf(stderr, "launch %d failed: %s\n", p, hipGetErrorString(e)); break; }
    }
#else
    hipMemsetAsync((char*)d_ws + WS_BAR, 0, 16384, stream);
    a.ph_lo = 0; a.ph_hi = NPH; void* args[] = {&a};
    hipError_t e = hipLaunchCooperativeKernel((const void*)hymba_fwd, dim3(grid), dim3(NTHR), args, LDS_BYTES, stream);
    if (e != hipSuccess) fprintf(stderr, "cooperative launch failed: %s (grid %d)\n", hipGetErrorString(e), grid);
#endif
}
```

```cpp
#include <hip/hip_runtime.h>
#include <hip/hip_cooperative_groups.h>
#include <cstdio>
#include <cstdint>
namespace cg = cooperative_groups;

#ifndef XBAR
#define XBAR 0
#endif
#ifndef REP2
#define REP2 0
#endif
#ifndef NSA_REP
#define NSA_REP 0
#endif
#ifndef P0_REP
#define P0_REP 0
#endif
#ifndef REP_MASK
#define REP_MASK 0
#endif
#ifndef N_LAUNCH_PER_PHASE
#define N_LAUNCH_PER_PHASE 0
#endif

#define LAS __attribute__((address_space(3)))
typedef unsigned short bf16_t;
typedef short bf16x8 __attribute__((ext_vector_type(8)));
typedef short v4s __attribute__((ext_vector_type(4)));
typedef float f32x4 __attribute__((ext_vector_type(4)));
typedef float f32x2 __attribute__((ext_vector_type(2)));
typedef unsigned u32x4 __attribute__((ext_vector_type(4)));
typedef unsigned u32x2 __attribute__((ext_vector_type(2)));

constexpr int NB = 8, SEQ = 4096, DM = 1024, T = NB * SEQ;
constexpr int INW = 3352, INP = 3584;
constexpr int DFF = 2816, PLE = 256;
constexpr float EPS = 1e-6f;
constexpr float QSCALE = 0.125f * 1.4426950408889634f;
constexpr int NTHR = 512;

constexpr size_t MiB = 1u << 20;
constexpr size_t WS_WIN = 0, WS_WOUT = 8 * MiB, WS_WUP = 10 * MiB, WS_WDN = 22 * MiB, WS_WG = 28 * MiB, WS_WP = 30 * MiB;
constexpr size_t WS_W1K = 31 * MiB, WS_W1V = 32 * MiB, WS_W2K = 33 * MiB, WS_W2V = 33 * MiB + 65536;
constexpr size_t WS_C1P = 33 * MiB + 512 * 1024, WS_C1 = 33 * MiB + 768 * 1024;
constexpr size_t WS_COSR = 34 * MiB, WS_SINR = 38 * MiB, WS_COSN = 42 * MiB, WS_SINN = 43 * MiB;
constexpr size_t WS_R0 = 44 * MiB, WS_SS1 = 44 * MiB + 256 * 1024, WS_SS3 = 44 * MiB + 512 * 1024;
constexpr size_t WS_SB = 46 * MiB;
constexpr size_t WS_PE = 80 * MiB;
constexpr size_t WS_XS = 144 * MiB;
constexpr size_t WS_PB = 208 * MiB;
constexpr size_t WS_RQ = 224 * MiB, WS_RK = 256 * MiB, WS_RV = 288 * MiB, WS_RG = 320 * MiB, WS_NQ = 352 * MiB;
constexpr size_t WS_KC = 384 * MiB, WS_VC = 392 * MiB, WS_KS = 400 * MiB, WS_VS = 408 * MiB, WS_KW = 416 * MiB, WS_VW = 424 * MiB;
constexpr size_t WS_NG = 432 * MiB;
constexpr size_t WS_KVST = 436 * MiB;
constexpr size_t WS_HIDK = 468 * MiB, WS_HIDV = 470 * MiB, WS_CK = 472 * MiB, WS_CV = 472 * MiB + 512 * 1024;
constexpr size_t WS_HS = 224 * MiB;
constexpr size_t WS_ACT = 288 * MiB;
constexpr size_t WS_BAR = 474 * MiB;
constexpr size_t WS_END = 475 * MiB;

constexpr int LDS_BYTES = 147456;

typedef __bf16 bf16x2_t __attribute__((ext_vector_type(2)));
__device__ __forceinline__ unsigned cvt_pk_bf16(float lo, float hi) { const f32x2 v = {lo, hi}; const bf16x2_t b = __builtin_convertvector(v, bf16x2_t); return __builtin_bit_cast(unsigned, b); }
__device__ __forceinline__ float bf2f(unsigned short b) { return __uint_as_float(((unsigned)b) << 16); }
__device__ __forceinline__ float fexp2(float x) { return __builtin_amdgcn_exp2f(x); }
__device__ __forceinline__ float frcp(float x) { return __builtin_amdgcn_rcpf(x); }
__device__ __forceinline__ float sigmoidf_(float x) { return frcp(1.f + fexp2(-1.4426950408889634f * x)); }
__device__ __forceinline__ float siluf_(float x) { return x * sigmoidf_(x); }
__device__ __forceinline__ float gelu_tanh(float x) { const float u = 0.7978845608028654f * (x + 0.044715f * x * x * x); const float e = fexp2(2.f * 1.4426950408889634f * u); return 0.5f * x * (2.f - 2.f * frcp(1.f + e)); }
__device__ __forceinline__ v4s trrd(const LAS unsigned char* p) { return __builtin_amdgcn_ds_read_tr16_b64_v4i16((LAS v4s*)p); }
__device__ __forceinline__ bf16x8 cat8(v4s a, v4s b) { return __builtin_shufflevector(a, b, 0, 1, 2, 3, 4, 5, 6, 7); }
__device__ __forceinline__ f32x4 mfma16(bf16x8 a, bf16x8 b, f32x4 c) { return __builtin_amdgcn_mfma_f32_16x16x32_bf16(a, b, c, 0, 0, 0); }
__device__ __forceinline__ u32x2 pack4(f32x4 v) { u32x2 w; w.x = cvt_pk_bf16(v[0], v[1]); w.y = cvt_pk_bf16(v[2], v[3]); return w; }
__device__ __forceinline__ bf16x8 pack8(f32x4 a, f32x4 b) { u32x4 w; w.x = cvt_pk_bf16(a[0], a[1]); w.y = cvt_pk_bf16(a[2], a[3]); w.z = cvt_pk_bf16(b[0], b[1]); w.w = cvt_pk_bf16(b[2], b[3]); return __builtin_bit_cast(bf16x8, w); }
__device__ __forceinline__ float rows_max(float v) {
    auto a = __builtin_amdgcn_permlane16_swap(__float_as_uint(v), __float_as_uint(v), false, false); v = fmaxf(__uint_as_float(a[0]), __uint_as_float(a[1]));
    auto b = __builtin_amdgcn_permlane32_swap(__float_as_uint(v), __float_as_uint(v), false, false); return fmaxf(__uint_as_float(b[0]), __uint_as_float(b[1]));
}
__device__ __forceinline__ float rows_sum(float v) {
    auto a = __builtin_amdgcn_permlane16_swap(__float_as_uint(v), __float_as_uint(v), false, false); v = __uint_as_float(a[0]) + __uint_as_float(a[1]);
    auto b = __builtin_amdgcn_permlane32_swap(__float_as_uint(v), __float_as_uint(v), false, false); return __uint_as_float(b[0]) + __uint_as_float(b[1]);
}
template <int N> __device__ __forceinline__ float row_ror(float v) { return __uint_as_float((unsigned)__builtin_amdgcn_update_dpp(0, (int)__float_as_uint(v), 0x120 + N, 0xf, 0xf, false)); }
__device__ __forceinline__ void store_pair16(bf16_t* pX, bf16_t* pY, u32x2 X, u32x2 Y, int fq, bool okX, bool okY) {
    auto r0 = __builtin_amdgcn_permlane16_swap(X.x, Y.x, false, false); auto r1 = __builtin_amdgcn_permlane16_swap(X.y, Y.y, false, false);
    u32x4 o; o.x = r0[0]; o.y = r1[0]; o.z = r0[1]; o.w = r1[1];
    bf16_t* ad = (fq & 1) ? pY - 4 : pX; const bool ok = (fq & 1) ? okY : okX;
    if (ok) *(u32x4*)ad = o;
}
template <bool NT = false> __device__ __forceinline__ void load_pair16(const bf16_t* pX, const bf16_t* pY, u32x2& X, u32x2& Y, int fq) {
    const u32x4* ap = (const u32x4*)((fq & 1) ? pY - 4 : pX); const u32x4 o = NT ? __builtin_nontemporal_load(ap) : *ap;
    auto r0 = __builtin_amdgcn_permlane16_swap(o.x, o.z, false, false); auto r1 = __builtin_amdgcn_permlane16_swap(o.y, o.w, false, false);
    X.x = r0[0]; Y.x = r0[1]; X.y = r1[0]; Y.y = r1[1];
}
__device__ __forceinline__ float wave_sum(float v) {
#pragma unroll
    for (int o = 1; o < 64; o <<= 1) v += __shfl_xor(v, o);
    return v;
}

namespace pg8 {
constexpr int BM = 256, BK = 64, HALF = 128, HTB = HALF * BK * 2, STAGE_BYTES = 8 * HTB, NXCD = 8, WGM = 8;
__host__ __device__ __forceinline__ int lds_byte(int r, int c) { const int st = (r >> 4) * 2 + (c >> 5), rr = r & 15, cc = c & 31, ob = rr * 64 + cc * 2; return st * 1024 + (ob ^ (((ob >> 9) & 1) << 5)); }
__host__ __device__ __forceinline__ void stage_rc(int b, int& R, int& C) { const int st = b / 1024, sb = b % 1024, swz = sb ^ (((sb >> 9) & 1) << 5); R = (st >> 1) * 16 + swz / 64; C = (st & 1) * 32 + (swz % 64) / 2; }
struct Unit { int pm, pn; };
struct Gemm { const bf16_t* A; const bf16_t* Bt; int M, N, K, lda, ldb; };
struct StaticOrder {
    int nM, nN, nwg, G, c;
    __device__ void init(int M, int N, int G_, int c_) { nM = M / BM; nN = N / BM; nwg = nM * nN; G = G_; c = c_; }
    __device__ bool next(int i, Unit& u) const {
        const long L = (long)i * G + c; if (c < 0 || L >= nwg) return false;
        int wgid = (int)L; { const int q = nwg / NXCD, r = nwg % NXCD, xcd = wgid % NXCD, off = wgid / NXCD; wgid = (xcd < r ? xcd * (q + 1) : r * (q + 1) + (xcd - r) * q) + off; }
        const int nig = WGM * nN, gid = wgid / nig, fm = gid * WGM, gsz = (nM - fm) < WGM ? (nM - fm) : WGM;
        u.pm = fm + ((wgid % nig) % gsz); u.pn = (wgid % nig) / gsz; return true;
    }
};
template <class Epi>
__device__ __forceinline__ void gemm_phase(LAS unsigned char* lds, const Gemm g, const StaticOrder& S, const Epi& E, const int tid) {
    const int wid = __builtin_amdgcn_readfirstlane(tid >> 6), lane = tid & 63, wr = wid >> 2, wc = wid & 3, fr = lane & 15, fq = lane >> 4;
    const int K = g.K, nt = K / BK, lda = g.lda, ldb = g.ldb;
    unsigned voffA[2], voffB[2];
#pragma unroll
    for (int i = 0; i < 2; ++i) { int R, C; stage_rc(tid * 16 + i * 8192, R, C); voffA[i] = (unsigned)(R * lda + C) * 2u; voffB[i] = (unsigned)(R * ldb + C) * 2u; }
    const size_t kstep = (size_t)(BK * 2);
    const size_t hstepA = (size_t)HALF * lda * 2, hstepB = (size_t)HALF * ldb * 2;
    const size_t tstepA = 2 * hstepA, tstepB = 2 * hstepB;
    const unsigned ldsw = (unsigned)wid * 1024u;
    const int aoff = lds_byte(wr * 64 + fr, fq * 8), boff = lds_byte(wc * 32 + fr, fq * 8);
#define PG8_SA(b, h) (((b) * 2 + (h)) * HTB)
#define PG8_SB(b, h) ((4 + (b) * 2 + (h)) * HTB)
#define PG8_STAGE(bufoff, gbase, voff) do { _Pragma("unroll") for (int _i = 0; _i < 2; ++_i) \
        __builtin_amdgcn_global_load_lds((const unsigned*)((const char*)(gbase) + (voff)[_i]), (LAS unsigned*)(lds + (bufoff) + ldsw + _i * 8192), 16, 0, 0); } while (0)
#define PG8_LDA(dst, b, h) do { _Pragma("unroll") for (int m = 0; m < 4; ++m) _Pragma("unroll") for (int k = 0; k < 2; ++k) dst[m][k] = *(const LAS bf16x8*)(lds + PG8_SA(b, h) + aoff + m * 2048 + k * 1024); } while (0)
#define PG8_LDB(dst, b, h) do { _Pragma("unroll") for (int n = 0; n < 2; ++n) _Pragma("unroll") for (int k = 0; k < 2; ++k) dst[n][k] = *(const LAS bf16x8*)(lds + PG8_SB(b, h) + boff + n * 2048 + k * 1024); } while (0)
#define PG8_MMA(ai, bj, At, Bt) do { __builtin_amdgcn_s_setprio(1); _Pragma("unroll") for (int m = 0; m < 4; ++m) _Pragma("unroll") for (int n = 0; n < 2; ++n) _Pragma("unroll") for (int k = 0; k < 2; ++k) \
        acc[ai][bj][m][n] = __builtin_amdgcn_mfma_f32_16x16x32_bf16(Bt[n][k], At[m][k], acc[ai][bj][m][n], 0, 0, 0); __builtin_amdgcn_s_setprio(0); } while (0)
#define PG8_WAIT_V(n) asm volatile("s_waitcnt vmcnt(" #n ")" ::: "memory")
#define PG8_WAIT_L(n) asm volatile("s_waitcnt lgkmcnt(" #n ")" ::: "memory")
#define PG8_BAR __builtin_amdgcn_s_barrier()
#define PG8_SCHED __builtin_amdgcn_sched_barrier(0)
    Unit cur, nxt; int ui = 0;
    if (!S.next(0, cur)) return;
    f32x4 acc[2][2][4][2];
#pragma unroll
    for (int a = 0; a < 2; ++a)
#pragma unroll
        for (int b = 0; b < 2; ++b)
#pragma unroll
            for (int m = 0; m < 4; ++m)
#pragma unroll
                for (int n = 0; n < 2; ++n) acc[a][b][m][n] = (f32x4){0.f, 0.f, 0.f, 0.f};
    bf16x8 At[4][2], B0[2][2], B1[2][2];
    const char* cA = (const char*)g.A + (size_t)cur.pm * tstepA; const char* cB = (const char*)g.Bt + (size_t)cur.pn * tstepB;
    PG8_STAGE(PG8_SB(0, 0), cB, voffB); PG8_STAGE(PG8_SB(0, 1), cB + hstepB, voffB); PG8_STAGE(PG8_SA(0, 0), cA, voffA); PG8_STAGE(PG8_SA(0, 1), cA + hstepA, voffA);
    if (wr == 1) PG8_BAR;
    PG8_WAIT_V(2); PG8_BAR;
    PG8_STAGE(PG8_SB(1, 0), cB + kstep, voffB); PG8_STAGE(PG8_SA(1, 0), cA + kstep, voffA); PG8_STAGE(PG8_SB(1, 1), cB + hstepB + kstep, voffB);
    PG8_WAIT_V(6); PG8_BAR;
    for (;;) {
        const bool has_next = S.next(ui + 1, nxt);
        const char* nA = has_next ? (const char*)g.A + (size_t)nxt.pm * tstepA : cA; const char* nB = has_next ? (const char*)g.Bt + (size_t)nxt.pn * tstepB : cB;
        for (int t = 0; t < nt; t += 2) {
            const bool last = (t == nt - 2);
            const char* a1 = cA + (size_t)(t + 1) * kstep;
            const char* a2 = last ? nA : cA + (size_t)(t + 2) * kstep; const char* b2 = last ? nB : cB + (size_t)(t + 2) * kstep;
            const char* a3 = a2 + kstep; const char* b3 = b2 + kstep;
            PG8_LDB(B0, 0, 0); PG8_LDB(B1, 0, 1); PG8_SCHED; PG8_LDA(At, 0, 0); PG8_STAGE(PG8_SA(1, 1), a1 + hstepA, voffA);
            PG8_WAIT_V(8); PG8_WAIT_L(0); PG8_BAR; PG8_MMA(0, 0, At, B0); PG8_MMA(0, 1, At, B1); PG8_BAR; PG8_SCHED;
            PG8_LDA(At, 0, 1); PG8_STAGE(PG8_SB(0, 0), b2, voffB); PG8_STAGE(PG8_SB(0, 1), b2 + hstepB, voffB); PG8_STAGE(PG8_SA(0, 0), a2, voffA);
            PG8_WAIT_V(8); PG8_WAIT_L(0); PG8_BAR; PG8_MMA(1, 0, At, B0); PG8_MMA(1, 1, At, B1); PG8_BAR; PG8_SCHED;
            PG8_LDB(B0, 1, 0); PG8_LDB(B1, 1, 1); PG8_SCHED; PG8_LDA(At, 1, 0); PG8_STAGE(PG8_SA(0, 1), a2 + hstepA, voffA);
            PG8_WAIT_V(8); PG8_WAIT_L(0); PG8_BAR; PG8_MMA(0, 0, At, B0); PG8_MMA(0, 1, At, B1); PG8_BAR; PG8_SCHED;
            PG8_LDA(At, 1, 1); PG8_STAGE(PG8_SB(1, 0), b3, voffB); PG8_STAGE(PG8_SB(1, 1), b3 + hstepB, voffB); PG8_STAGE(PG8_SA(1, 0), a3, voffA);
            PG8_WAIT_V(8); PG8_WAIT_L(0); PG8_BAR; PG8_MMA(1, 0, At, B0); PG8_MMA(1, 1, At, B1); PG8_BAR; PG8_SCHED;
        }
        if (wr == 0) PG8_BAR;
        E(acc, cur, wr, wc, fr, fq);
        if (!has_next) break;
#pragma unroll
        for (int a = 0; a < 2; ++a)
#pragma unroll
            for (int b = 0; b < 2; ++b)
#pragma unroll
                for (int m = 0; m < 4; ++m)
#pragma unroll
                    for (int n = 0; n < 2; ++n) acc[a][b][m][n] = (f32x4){0.f, 0.f, 0.f, 0.f};
        cur = nxt; cA = nA; cB = nB; ++ui;
        if (wr == 1) PG8_BAR;
    }
    PG8_WAIT_V(0);
    PG8_BAR;
#undef PG8_SA
#undef PG8_SB
#undef PG8_STAGE
#undef PG8_LDA
#undef PG8_LDB
#undef PG8_MMA
#undef PG8_WAIT_V
#undef PG8_WAIT_L
#undef PG8_BAR
#undef PG8_SCHED
}
}
using pg8::Unit;
typedef f32x4 Acc[2][2][4][2];

struct EpiIn {
    const float* r0; const int* pos; unsigned char* ws;
    __device__ __forceinline__ void operator()(const Acc& acc, const Unit& u, int wr, int wc, int fr, int fq) const {
        const int tile = u.pn;
        f32x4 invr[2], invn;
#pragma unroll
        for (int e = 0; e < 4; ++e) { invr[0][e] = fexp2(-(float)(4 * fq + e) * (13.287712379549449f / 32.f)); invr[1][e] = fexp2(-(float)(16 + 4 * fq + e) * (13.287712379549449f / 32.f));
            invn[e] = fexp2(-(float)(4 * (fq & 1) + e) * (18.931568569324174f / 8.f)); }
        float rsv[2][4], pfv[2][4];
#pragma unroll
        for (int ai = 0; ai < 2; ++ai)
#pragma unroll
            for (int m = 0; m < 4; ++m) { const int row = u.pm * 256 + ai * 128 + wr * 64 + m * 16 + fr; rsv[ai][m] = r0[row]; pfv[ai][m] = (float)pos[row]; }
#pragma unroll
        for (int ai = 0; ai < 2; ++ai)
#pragma unroll
            for (int m = 0; m < 4; ++m) {
                const int row = u.pm * 256 + ai * 128 + wr * 64 + m * 16 + fr;
                const float rs = rsv[ai][m], pf = pfv[ai][m];
                if (tile < 4) {
                    bf16_t* dst = (bf16_t*)(ws + (tile < 2 ? WS_RQ : WS_RK)) + (size_t)row * 512 + ((tile & 1) * 4 + wc) * 64;
                    const float sc = tile < 2 ? rs : rs * 0.125f; u32x2 o1[2], o2[2];
#pragma unroll
                    for (int n = 0; n < 2; ++n) {
                        const int i0 = 16 * n + 4 * fq;
                        f32x4 c4, s4;
#pragma unroll
                        for (int e = 0; e < 4; ++e) { const float fv = __builtin_amdgcn_fractf(pf * invr[n][e] * 0.15915494309189535f); c4[e] = __builtin_amdgcn_cosf(fv); s4[e] = __builtin_amdgcn_sinf(fv); }
                        const f32x4 x1 = acc[ai][0][m][n] * sc, x2 = acc[ai][1][m][n] * sc;
                        o1[n] = pack4(x1 * c4 - x2 * s4); o2[n] = pack4(x1 * s4 + x2 * c4);
                    }
                    store_pair16(dst + 4 * fq, dst + 16 + 4 * fq, o1[0], o1[1], fq, true, true);
                    store_pair16(dst + 32 + 4 * fq, dst + 48 + 4 * fq, o2[0], o2[1], fq, true, true);
                } else if (tile < 8) {
                    bf16_t* dst = (bf16_t*)(ws + (tile < 6 ? WS_RV : WS_RG)) + (size_t)row * 512 + ((tile & 1) * 4 + wc) * 64;
#pragma unroll
                    for (int bj = 0; bj < 2; ++bj) { u32x2 ov[2];
#pragma unroll
                        for (int n = 0; n < 2; ++n) {
                            f32x4 v = acc[ai][bj][m][n] * rs;
                            if (tile >= 6) { v[0] = siluf_(v[0]); v[1] = siluf_(v[1]); v[2] = siluf_(v[2]); v[3] = siluf_(v[3]); }
                            ov[n] = pack4(v);
                        }
                        store_pair16(dst + 32 * bj + 4 * fq, dst + 32 * bj + 16 + 4 * fq, ov[0], ov[1], fq, true, true); }
                } else if (tile < 13) {
                    bf16_t* dst; bool roped; float sc = rs;
                    if (tile < 10) { dst = (bf16_t*)(ws + WS_NQ) + (size_t)row * 512 + ((tile & 1) * 4 + wc) * 64; roped = true; sc = rs * QSCALE; }
                    else { const int seg = wc >> 1, g = wc & 1, b = row >> 12, s = row & 4095;
                        const size_t base = (tile == 10 ? (seg ? WS_VC : WS_KC) : tile == 11 ? (seg ? WS_VS : WS_KS) : (seg ? WS_VW : WS_KW));
                        dst = (bf16_t*)(ws + base) + ((size_t)(b * 2 + g) * SEQ + s) * 64; roped = (seg == 0); }
                    f32x4 c4, s4;
#pragma unroll
                    for (int e = 0; e < 4; ++e) { const float fv = __builtin_amdgcn_fractf(pf * invn[e] * 0.15915494309189535f); c4[e] = __builtin_amdgcn_cosf(fv); s4[e] = __builtin_amdgcn_sinf(fv); }
#pragma unroll
                    for (int bj = 0; bj < 2; ++bj) { u32x2 ov[2];
#pragma unroll
                        for (int n = 0; n < 2; ++n) {
                            f32x4 v = acc[ai][bj][m][n] * sc;
                            if (bj == 0 && n == 0) {
                                f32x4 pr; pr[0] = __shfl_xor(v[0], 32); pr[1] = __shfl_xor(v[1], 32); pr[2] = __shfl_xor(v[2], 32); pr[3] = __shfl_xor(v[3], 32);
                                const f32x4 rot = (fq < 2) ? (v * c4 - pr * s4) : (pr * s4 + v * c4);
                                if (roped) v = rot;
                            }
                            ov[n] = pack4(v);
                        }
                        store_pair16(dst + 32 * bj + 4 * fq, dst + 32 * bj + 16 + 4 * fq, ov[0], ov[1], fq, true, true); }
                } else {
                    float* ng = (float*)(ws + WS_NG) + (size_t)row * 24;
                    if (wc == 0) {
                        const f32x4 v0 = acc[ai][0][m][0] * rs; f32x4 o;
                        o[0] = sigmoidf_(v0[0]); o[1] = sigmoidf_(v0[1]); o[2] = sigmoidf_(v0[2]); o[3] = sigmoidf_(v0[3]);
                        *(f32x4*)(ng + 4 * fq) = o;
                        if (fq < 2) { const f32x4 v1 = acc[ai][0][m][1] * rs; o[0] = sigmoidf_(v1[0]); o[1] = sigmoidf_(v1[1]); o[2] = sigmoidf_(v1[2]); o[3] = sigmoidf_(v1[3]); *(f32x4*)(ng + 16 + 4 * fq) = o; }
                    }
                }
            }
    }
};
template <int ACT> struct EpiBf16 {
    bf16_t* O; int ldc; const float* bias;
    __device__ __forceinline__ void operator()(const Acc& acc, const Unit& u, int wr, int wc, int fr, int fq) const {
#pragma unroll
        for (int ai = 0; ai < 2; ++ai)
#pragma unroll
            for (int m = 0; m < 4; ++m) {
                const int row = u.pm * 256 + ai * 128 + wr * 64 + m * 16 + fr;
#pragma unroll
                for (int bj = 0; bj < 2; ++bj) { u32x2 ov[2];
#pragma unroll
                    for (int n = 0; n < 2; ++n) {
                        const int col = u.pn * 256 + 128 * bj + 32 * wc + 16 * n + 4 * fq;
                        f32x4 v = acc[ai][bj][m][n];
                        if (ACT == 1) { const f32x4 bv = *(const f32x4*)(bias + col); v = v + bv; v[0] = gelu_tanh(v[0]); v[1] = gelu_tanh(v[1]); v[2] = gelu_tanh(v[2]); v[3] = gelu_tanh(v[3]); }
                        ov[n] = pack4(v);
                    }
                    bf16_t* pb_ = O + (size_t)row * ldc + u.pn * 256 + 128 * bj + 32 * wc + 4 * fq; store_pair16(pb_, pb_ + 16, ov[0], ov[1], fq, true, true); }
            }
    }
};
struct EpiF32 {
    float* O; int ldc;
    __device__ __forceinline__ void operator()(const Acc& acc, const Unit& u, int wr, int wc, int fr, int fq) const {
#pragma unroll
        for (int ai = 0; ai < 2; ++ai)
#pragma unroll
            for (int m = 0; m < 4; ++m) {
                const int row = u.pm * 256 + ai * 128 + wr * 64 + m * 16 + fr;
#pragma unroll
                for (int bj = 0; bj < 2; ++bj)
#pragma unroll
                    for (int n = 0; n < 2; ++n) *(f32x4*)(O + (size_t)row * ldc + u.pn * 256 + 128 * bj + 32 * wc + 16 * n + 4 * fq) = acc[ai][bj][m][n];
            }
    }
};
struct EpiOut {
    const bf16_t* xb; bf16_t* h1b; float* ss; int dry;
    __device__ __forceinline__ void operator()(const Acc& acc, const Unit& u, int wr, int wc, int fr, int fq) const {
        if (dry) { if (acc[0][0][0][0][0] == 1.2345e-30f) ss[0] = 0.f; return; }
#pragma unroll
        for (int ai = 0; ai < 2; ++ai) {
            u32x2 rv[4][2][2];
#pragma unroll
            for (int m = 0; m < 4; ++m)
#pragma unroll
                for (int bj = 0; bj < 2; ++bj) { const bf16_t* pl_ = xb + (size_t)(u.pm * 256 + ai * 128 + wr * 64 + m * 16 + fr) * DM + u.pn * 256 + 128 * bj + 32 * wc + 4 * fq; load_pair16<true>(pl_, pl_ + 16, rv[m][bj][0], rv[m][bj][1], fq); }
#pragma unroll
            for (int m = 0; m < 4; ++m) {
                const int row = u.pm * 256 + ai * 128 + wr * 64 + m * 16 + fr; float sq = 0.f;
#pragma unroll
                for (int bj = 0; bj < 2; ++bj) { u32x2 ov[2];
#pragma unroll
                    for (int n = 0; n < 2; ++n) {
                        const u32x2 w = rv[m][bj][n];
                        const f32x4 h = (f32x4){__uint_as_float(w.x << 16), __uint_as_float(w.x & 0xffff0000u), __uint_as_float(w.y << 16), __uint_as_float(w.y & 0xffff0000u)} + acc[ai][bj][m][n];
                        ov[n] = pack4(h); sq += (h[0] * h[0] + h[1] * h[1]) + (h[2] * h[2] + h[3] * h[3]);
                    }
                    bf16_t* pb_ = h1b + (size_t)row * DM + u.pn * 256 + 128 * bj + 32 * wc + 4 * fq; store_pair16(pb_, pb_ + 16, ov[0], ov[1], fq, true, true); }
                sq += __shfl_xor(sq, 16); sq += __shfl_xor(sq, 32);
                if (fq == 0) atomicAdd(ss + row, sq);
            }
        }
    }
};
struct EpiUp {
    const float* ss1; const float* cw; const float* cb; bf16_t* act; float* sb;
    __device__ __forceinline__ void operator()(const Acc& acc, const Unit& u, int wr, int wc, int fr, int fq) const {
        float rsv[2][4];
#pragma unroll
        for (int ai = 0; ai < 2; ++ai)
#pragma unroll
            for (int m = 0; m < 4; ++m) rsv[ai][m] = ss1[u.pm * 256 + ai * 128 + wr * 64 + m * 16 + fr];
#pragma unroll
        for (int ai = 0; ai < 2; ++ai)
#pragma unroll
            for (int m = 0; m < 4; ++m) rsv[ai][m] = rsqrtf(rsv[ai][m] * (1.f / DM) + EPS);
#pragma unroll
        for (int n = 0; n < 2; ++n) {
            const int col = u.pn * 128 + wc * 32 + 16 * n + 4 * fq;
            const f32x4 w0 = *(const f32x4*)(cw + col), w1 = *(const f32x4*)(cw + DFF + col), w2 = *(const f32x4*)(cw + 2 * DFF + col), bb = *(const f32x4*)(cb + col);
#pragma unroll
            for (int ai = 0; ai < 2; ++ai) {
                const int unit = u.pm * 4 + ai * 2 + wr;
                f32x4 pg = (f32x4){0.f, 0.f, 0.f, 0.f}; u32x2 ppk = (u32x2){0u, 0u};
#pragma unroll
                for (int m = 0; m < 4; ++m) {
                    const int row = u.pm * 256 + ai * 128 + wr * 64 + m * 16 + fr;
                    const float rs = rsv[ai][m];
                    const f32x4 G = acc[ai][0][m][n] * rs, V = acc[ai][1][m][n] * rs; f32x4 a;
#pragma unroll
                    for (int e = 0; e < 4; ++e) {
                        const float a1 = row_ror<1>(G[e]), a2 = row_ror<2>(G[e]), b1 = row_ror<1>(pg[e]), b2 = row_ror<2>(pg[e]);
                        const float g1 = fr >= 1 ? a1 : b1, g2 = fr >= 2 ? a2 : b2;
                        const float gate = bb[e] + w0[e] * g2 + w1[e] * g1 + w2[e] * G[e];
                        a[e] = siluf_(gate) * V[e];
                    }
                    if (m == 0 && fr < 2) { *(f32x4*)(sb + ((size_t)unit * 6 + fr) * DFF + col) = G; *(f32x4*)(sb + ((size_t)unit * 6 + 2 + fr) * DFF + col) = V; }
                    if (m == 3 && fr >= 14) *(f32x4*)(sb + ((size_t)unit * 6 + 4 + (fr - 14)) * DFF + col) = G;
                    if ((m & 1) == 0) ppk = pack4(a);
                    else store_pair16(act + (size_t)(row - 16) * DFF + col, act + (size_t)row * DFF + col, ppk, pack4(a), fq, (m != 1) || (fr >= 2), true);
                    pg = G;
                }
            }
        }
    }
};
struct EpiDown {
    const bf16_t* h1b; bf16_t* hb; int dry;
    __device__ __forceinline__ void operator()(const Acc& acc, const Unit& u, int wr, int wc, int fr, int fq) const {
        if (dry) { if (acc[0][0][0][0][0] == 1.2345e-30f) hb[0] = 0; return; }
#pragma unroll
        for (int ai = 0; ai < 2; ++ai) {
            u32x2 rv[4][2][2];
#pragma unroll
            for (int m = 0; m < 4; ++m)
#pragma unroll
                for (int bj = 0; bj < 2; ++bj) { const bf16_t* pl_ = h1b + (size_t)(u.pm * 256 + ai * 128 + wr * 64 + m * 16 + fr) * DM + u.pn * 256 + 128 * bj + 32 * wc + 4 * fq; load_pair16<true>(pl_, pl_ + 16, rv[m][bj][0], rv[m][bj][1], fq); }
#pragma unroll
            for (int m = 0; m < 4; ++m) {
                const int row = u.pm * 256 + ai * 128 + wr * 64 + m * 16 + fr;
#pragma unroll
                for (int bj = 0; bj < 2; ++bj) { u32x2 ov[2];
#pragma unroll
                    for (int n = 0; n < 2; ++n) { const u32x2 w = rv[m][bj][n];
                        ov[n] = pack4((f32x4){__uint_as_float(w.x << 16), __uint_as_float(w.x & 0xffff0000u), __uint_as_float(w.y << 16), __uint_as_float(w.y & 0xffff0000u)} + acc[ai][bj][m][n]); }
                    bf16_t* pb_ = hb + (size_t)row * DM + u.pn * 256 + 128 * bj + 32 * wc + 4 * fq; store_pair16(pb_, pb_ + 16, ov[0], ov[1], fq, true, true); }
            }
        }
    }
};
struct EpiPle {
    const bf16_t* h2b; bf16_t* h3b; const bf16_t* pe; float* ss; int dry;
    __device__ __forceinline__ void operator()(const Acc& acc, const Unit& u, int wr, int wc, int fr, int fq) const {
        if (dry) { if (acc[0][0][0][0][0] == 1.2345e-30f) h3b[0] = 0; return; }
#pragma unroll
        for (int ai = 0; ai < 2; ++ai)
#pragma unroll
            for (int mh = 0; mh < 2; ++mh) {
                u32x2 hv[2][2][2], pv[2][2][2];
#pragma unroll
                for (int mm = 0; mm < 2; ++mm)
#pragma unroll
                    for (int bj = 0; bj < 2; ++bj) { const size_t off = (size_t)(u.pm * 256 + ai * 128 + wr * 64 + (2 * mh + mm) * 16 + fr) * DM + u.pn * 256 + 128 * bj + 32 * wc + 4 * fq;
                        load_pair16(h2b + off, h2b + off + 16, hv[mm][bj][0], hv[mm][bj][1], fq); load_pair16<true>(pe + off, pe + off + 16, pv[mm][bj][0], pv[mm][bj][1], fq); }
#pragma unroll
                for (int mm = 0; mm < 2; ++mm) {
                    const int m = 2 * mh + mm; const int row = u.pm * 256 + ai * 128 + wr * 64 + m * 16 + fr; float sq = 0.f;
#pragma unroll
                    for (int bj = 0; bj < 2; ++bj) { u32x2 ov[2];
#pragma unroll
                        for (int n = 0; n < 2; ++n) {
                            const u32x2 pw = pv[mm][bj][n], hw = hv[mm][bj][n]; const f32x4 a = acc[ai][bj][m][n];
                            f32x4 h = (f32x4){__uint_as_float(hw.x << 16), __uint_as_float(hw.x & 0xffff0000u), __uint_as_float(hw.y << 16), __uint_as_float(hw.y & 0xffff0000u)};
                            h[0] += sigmoidf_(a[0]) * __uint_as_float(pw.x << 16); h[1] += sigmoidf_(a[1]) * __uint_as_float(pw.x & 0xffff0000u);
                            h[2] += sigmoidf_(a[2]) * __uint_as_float(pw.y << 16); h[3] += sigmoidf_(a[3]) * __uint_as_float(pw.y & 0xffff0000u);
                            ov[n] = pack4(h); sq += (h[0] * h[0] + h[1] * h[1]) + (h[2] * h[2] + h[3] * h[3]);
                        }
                        bf16_t* pb_ = h3b + (size_t)row * DM + u.pn * 256 + 128 * bj + 32 * wc + 4 * fq; store_pair16(pb_, pb_ + 16, ov[0], ov[1], fq, true, true); }
                    sq += __shfl_xor(sq, 16); sq += __shfl_xor(sq, 32);
                    if (fq == 0) atomicAdd(ss + row, sq);
                }
            }
    }
};

__device__ __forceinline__ void tr_item(const float* W, int K, int N, bf16_t* WT, LAS float* scr, int k0, int np0, int src0, int lane, const float* ksc = nullptr) {
    const int q4 = lane & 7, kr = lane >> 3, sc = src0 + 4 * q4; const bool ok = sc < N;
#pragma unroll
    for (int i = 0; i < 8; ++i) { const int kk = 8 * i + kr; const f32x4 v = ok ? __builtin_nontemporal_load((const f32x4*)(W + (size_t)(k0 + kk) * N + sc)) : (f32x4){0.f, 0.f, 0.f, 0.f};
        LAS float* d = scr + kk * 33 + 4 * q4; d[0] = v[0]; d[1] = v[1]; d[2] = v[2]; d[3] = v[3]; }
    asm volatile("s_waitcnt lgkmcnt(0)" ::: "memory");
    const int c = lane & 7;
    f32x4 k0v = (f32x4){1.f, 1.f, 1.f, 1.f}, k1v = k0v;
    if (ksc) { k0v = *(const f32x4*)(ksc + k0 + 8 * c); k1v = *(const f32x4*)(ksc + k0 + 8 * c + 4); }
#pragma unroll
    for (int j = 0; j < 4; ++j) { const int n = (lane >> 3) + 8 * j; const LAS float* s = scr + (8 * c) * 33 + n;
        u32x4 o; o.x = cvt_pk_bf16(s[0 * 33] * k0v[0], s[1 * 33] * k0v[1]); o.y = cvt_pk_bf16(s[2 * 33] * k0v[2], s[3 * 33] * k0v[3]); o.z = cvt_pk_bf16(s[4 * 33] * k1v[0], s[5 * 33] * k1v[1]); o.w = cvt_pk_bf16(s[6 * 33] * k1v[2], s[7 * 33] * k1v[3]);
        *(u32x4*)(WT + (size_t)(np0 + n) * K + k0 + 8 * c) = o; }
    asm volatile("s_waitcnt lgkmcnt(0)" ::: "memory");
}

__device__ __forceinline__ int lnd_i(int v) { asm volatile("" : "+s"(v)); return v; }
template <class P> __device__ __forceinline__ P* lnd_p(P* p) { asm volatile("" : "+s"(p)); return p; }
#define PHASE_LOCALS const int wave = lnd_i(wave0); int lane_ = (int)__builtin_amdgcn_mbcnt_hi(~0u, __builtin_amdgcn_mbcnt_lo(~0u, 0u)); asm volatile("" : "+v"(lane_)); const int lane = lane_, tid = wave * 64 + lane, fr = lane & 15, fq = lane >> 4; (void)fr; (void)fq; (void)wave; const int G = lnd_i(G0), bid = lnd_i(bid0); unsigned char* ws = lnd_p(args.ws); float* out = lnd_p(args.out); (void)G; (void)bid; (void)ws; (void)out;
struct Args { const float* in[20]; float* out; unsigned char* ws; int ph_lo, ph_hi; };
__device__ __forceinline__ int opq(int i) { int r; asm volatile("s_mov_b32 %0, %1" : "=s"(r) : "i"(i)); return r; }
enum { I_X = 0, I_P, I_POS, I_NMIX, I_WIN, I_GNW, I_CPOS, I_KW1, I_KW2, I_VW1, I_VW2, I_WOUT, I_NFFN, I_WUP, I_CONVW, I_CONVB, I_WDN, I_PLEW, I_PLEG, I_FNW };

constexpr int RS = 144;
__device__ __forceinline__ void attn_tile(const int MODE, const LAS unsigned char* Kl, const LAS unsigned char* Vl, const bf16x8 (&Qf)[2][2],
                                          float (&mx)[2], f32x4 (&ls)[2], f32x4 (&O)[2][4], int fr, int fq, int toff, const bool (&rsel)[2]) {
    const bf16x8 ones8 = {0x3f80, 0x3f80, 0x3f80, 0x3f80, 0x3f80, 0x3f80, 0x3f80, 0x3f80};
    f32x4 S[2][4];
#pragma unroll
    for (int qg = 0; qg < 2; ++qg) {
        const float ci = (MODE == 0 && !rsel[qg]) ? -INFINITY : -mx[qg];
#pragma unroll
        for (int kt = 0; kt < 4; ++kt) S[qg][kt] = (f32x4){ci, ci, ci, ci};
    }
    const LAS unsigned char* kb = Kl + fr * RS + fq * 16;
#pragma unroll
    for (int ks = 0; ks < 2; ++ks) {
        bf16x8 kf[4];
#pragma unroll
        for (int kt = 0; kt < 4; ++kt) kf[kt] = *(const LAS bf16x8*)(kb + kt * 16 * RS + ks * 64);
        __builtin_amdgcn_sched_barrier(0);
#pragma unroll
        for (int kt = 0; kt < 4; ++kt) { S[0][kt] = mfma16(kf[kt], Qf[0][ks], S[0][kt]); S[1][kt] = mfma16(kf[kt], Qf[1][ks], S[1][kt]); }
    }
    const LAS unsigned char* vb = Vl + (4 * fq + (fr >> 2)) * RS + (fr & 3) * 8;
    bf16x8 Pf[2][2];
#pragma unroll
    for (int qg = 0; qg < 2; ++qg) {
        const int to = toff + 4 * qg;
        float rm = -INFINITY;
        if (MODE != 0) {
#pragma unroll
            for (int kt = 0; kt < 4; ++kt)
#pragma unroll
                for (int e = 0; e < 4; ++e) { const int ko = 16 * kt + 4 * fq + e; const bool ok = (MODE == 1) ? (ko <= to) : (ko > to); S[qg][kt][e] = ok ? S[qg][kt][e] : -INFINITY; }
        }
#pragma unroll
        for (int kt = 0; kt < 4; ++kt)
#pragma unroll
            for (int e = 0; e < 4; ++e) rm = fmaxf(rm, S[qg][kt][e]);
        rm = rows_max(rm);
        const bool was = __float_as_uint(mx[qg]) != 0x80000000u;
        const bool need = was ? (rm > 8.f) : (rm > -INFINITY);
        if (__builtin_amdgcn_ballot_w64(need) != 0ull) {
            const float delta = need ? rm : 0.f, f = (need && was) ? fexp2(-delta) : 1.f;
            mx[qg] += delta;
            ls[qg] = ls[qg] * f;
#pragma unroll
            for (int dt = 0; dt < 4; ++dt) O[qg][dt] = O[qg][dt] * f;
#pragma unroll
            for (int kt = 0; kt < 4; ++kt) S[qg][kt] = S[qg][kt] - delta;
        }
#pragma unroll
        for (int kt = 0; kt < 4; ++kt)
#pragma unroll
            for (int e = 0; e < 4; ++e) S[qg][kt][e] = fexp2(S[qg][kt][e]);
        Pf[qg][0] = pack8(S[qg][0], S[qg][1]); Pf[qg][1] = pack8(S[qg][2], S[qg][3]);
    }
#pragma unroll
    for (int kk = 0; kk < 2; ++kk) {
        bf16x8 vf[4];
#pragma unroll
        for (int dt = 0; dt < 4; ++dt) vf[dt] = cat8(trrd(vb + (32 * kk) * RS + dt * 32), trrd(vb + (32 * kk + 16) * RS + dt * 32));
        __builtin_amdgcn_sched_barrier(0);
#pragma unroll
        for (int dt = 0; dt < 4; ++dt) { O[0][dt] = mfma16(vf[dt], Pf[0][kk], O[0][dt]); O[1][dt] = mfma16(vf[dt], Pf[1][kk], O[1][dt]); }
        ls[0] = mfma16(ones8, Pf[0][kk], ls[0]); ls[1] = mfma16(ones8, Pf[1][kk], ls[1]);
    }
}

__device__ __forceinline__ void attn_branch(LAS unsigned char* lds, const bf16_t* Kg, const bf16_t* Vg, unsigned long long tmask, int qb, int is_win,
                                            const bf16x8 (&Qf)[2][2], const unsigned long long (&selm)[2], int fr, int fq, int toff, float gate0, float gate1, f32x4 (&acc_o)[2][4], const int tid) {
    const int lrow = tid >> 3, lch = tid & 7;
    float mx[2] = {-0.f, -0.f}; f32x4 ls[2] = {(f32x4){0.f, 0.f, 0.f, 0.f}, (f32x4){0.f, 0.f, 0.f, 0.f}}; f32x4 O[2][4];
#pragma unroll
    for (int qg = 0; qg < 2; ++qg)
#pragma unroll
        for (int dt = 0; dt < 4; ++dt) O[qg][dt] = (f32x4){0.f, 0.f, 0.f, 0.f};
    int j = __builtin_ctzll(tmask); tmask &= tmask - 1;
    int cur = 0;
    {
        const u32x4 kv = *(const u32x4*)(Kg + ((size_t)(64 * j + lrow)) * 64 + lch * 8), vv = *(const u32x4*)(Vg + ((size_t)(64 * j + lrow)) * 64 + lch * 8);
        *(LAS u32x4*)(lds + lrow * RS + lch * 16) = kv; *(LAS u32x4*)(lds + 9216 + lrow * RS + lch * 16) = vv;
    }
    __syncthreads();
    for (;;) {
        const bool more = tmask != 0ull; int jn = 0; u32x4 kv, vv;
        if (more) { jn = __builtin_ctzll(tmask); tmask &= tmask - 1;
            kv = *(const u32x4*)(Kg + ((size_t)(64 * jn + lrow)) * 64 + lch * 8); vv = *(const u32x4*)(Vg + ((size_t)(64 * jn + lrow)) * 64 + lch * 8); }
        bool rsel[2] = {true, true};
        const LAS unsigned char* Kl = lds + cur * 18432; const LAS unsigned char* Vl = Kl + 9216;
        int mode = 0;
        if (j == qb) mode = 1;
        else if (is_win) { if (j == qb - 8) mode = 2; }
        else { rsel[0] = (selm[0] >> j) & 1ull; rsel[1] = (selm[1] >> j) & 1ull; }
        attn_tile(mode, Kl, Vl, Qf, mx, ls, O, fr, fq, toff, rsel);
        if (!more) break;
        cur ^= 1;
        *(LAS u32x4*)(lds + cur * 18432 + lrow * RS + lch * 16) = kv; *(LAS u32x4*)(lds + cur * 18432 + 9216 + lrow * RS + lch * 16) = vv;
        __syncthreads();
        j = jn;
    }
    __syncthreads();
#pragma unroll
    for (int qg = 0; qg < 2; ++qg) {
        const float l = ls[qg][0];
        const float sc = (qg ? gate1 : gate0) * (l > 0.f ? frcp(l) : 0.f);
#pragma unroll
        for (int dt = 0; dt < 4; ++dt) acc_o[qg][dt] = acc_o[qg][dt] + O[qg][dt] * sc;
    }
}

#define XB_TMO      128
#define XB_XCNT(j)  (256  + 64 * (j))
#define XB_XSUB(j)  (1280 + 64 * (j))
#define XB_XGEN(j)  (2304 + 64 * (j))
#define XB_TOP      3328
#define XB_TOPGEN   3392
#define XCD_BAR_WORDS 3456
#define XB_SPIN_CAP (1u << 22)
__device__ __forceinline__ unsigned xb_ld(unsigned* p)              { return __hip_atomic_load(p, __ATOMIC_RELAXED, __HIP_MEMORY_SCOPE_AGENT); }
__device__ __forceinline__ unsigned xb_add(unsigned* p, unsigned v) { return __hip_atomic_fetch_add(p, v, __ATOMIC_RELAXED, __HIP_MEMORY_SCOPE_AGENT); }
__device__ __forceinline__ unsigned xb_xcc_id() { return (unsigned)__builtin_amdgcn_s_getreg((3 << 11) | 20) & 0xFu; }
#define XB_SPIN(cond, bar) do { unsigned _sp = 0; while (cond) { __builtin_amdgcn_s_sleep(1); \
    if ((++_sp & 255u) == 0u) { if (xb_ld(&(bar)[XB_TMO])) break; if (_sp > XB_SPIN_CAP) { atomicAdd(&(bar)[XB_TMO], 1u); break; } } } } while (0)
__device__ __forceinline__ void xcd_barrier_complete(unsigned* bar, unsigned x, unsigned G, unsigned& nloc, unsigned& nx) {
    unsigned sum, cnt, mine, sp = 0u;
    for (;;) {
        sum = 0u; cnt = 0u; mine = 0u;
#pragma unroll
        for (unsigned j = 0; j < 16; ++j) { const unsigned c = xb_ld(&bar[XB_XCNT(j)]); sum += c; cnt += (c > 0u) ? 1u : 0u; mine = (j == x) ? c : mine; }
        if (sum == G) break;
        __builtin_amdgcn_s_sleep(1);
        if ((++sp & 255u) == 0u) { if (xb_ld(&bar[XB_TMO])) break; if (sp > XB_SPIN_CAP) { atomicAdd(&bar[XB_TMO], 1u); break; } }
    }
    nloc = mine > 0u ? mine : 1u; nx = cnt > 0u ? cnt : 1u;
}
__device__ __forceinline__ void xcd_barrier(unsigned* bar, unsigned x, volatile LAS unsigned* st, unsigned G, bool is_leader) {
    asm volatile("s_waitcnt vmcnt(0)" ::: "memory");
    __syncthreads();
    if (is_leader) {
        __builtin_amdgcn_s_waitcnt(0);
        unsigned nloc = st[0], nx = st[1];
        if (nloc == 0u) { xcd_barrier_complete(bar, x, G, nloc, nx); st[0] = nloc; st[1] = nx; }
        const unsigned old = xb_add(&bar[XB_XSUB(x)], 1u);
        const unsigned gen = old / nloc;
        if (old + 1u == (gen + 1u) * nloc) {
            __builtin_amdgcn_fence(__ATOMIC_RELEASE, "agent");
            asm volatile("s_waitcnt vmcnt(0)" ::: "memory");
            const unsigned og = xb_add(&bar[XB_TOP], 1u);
            const unsigned tg = og / nx;
            if (og + 1u == (tg + 1u) * nx) xb_add(&bar[XB_TOPGEN], 1u);
            else XB_SPIN(xb_ld(&bar[XB_TOPGEN]) == tg, bar);
            __builtin_amdgcn_fence(__ATOMIC_ACQUIRE, "agent");
            xb_add(&bar[XB_XGEN(x)], 1u);
            asm volatile("s_waitcnt vmcnt(0)" ::: "memory");
        } else {
            XB_SPIN(xb_ld(&bar[XB_XGEN(x)]) == gen, bar);
            __builtin_amdgcn_fence(__ATOMIC_ACQUIRE, "agent");
            asm volatile("s_waitcnt vmcnt(0)" ::: "memory");
        }
    }
    __syncthreads();
}

__global__ void __launch_bounds__(NTHR, 2) hymba_fwd(Args args) {
    extern __shared__ __attribute__((aligned(16))) unsigned char lds_raw[];
    LAS unsigned char* lds = (LAS unsigned char*)lds_raw;
    cg::grid_group grid = cg::this_grid();
    const int G0 = gridDim.x, bid0 = blockIdx.x, wave0 = __builtin_amdgcn_readfirstlane((int)threadIdx.x >> 6);
    const int lo = args.ph_lo, hi = args.ph_hi;
#define IN(k) (lo <= (k) && (k) < hi)
    unsigned* const barw = (unsigned*)(args.ws + WS_BAR);
    volatile LAS unsigned* const xst = (volatile LAS unsigned*)(lds + 147200);
    const bool xlead = (wave0 == 0) && (__builtin_amdgcn_mbcnt_hi(~0u, __builtin_amdgcn_mbcnt_lo(~0u, 0u)) == 0u);
    const unsigned xcc = xb_xcc_id();
    if (hi - lo > 1) { if (xlead) { xst[0] = 0u; xst[1] = 0u; (void)xb_add(&barw[XB_XCNT(xcc)], 1u); } __syncthreads(); }
#define SEAM(k) do { if (IN(k) && IN((k) + 1)) xcd_barrier(barw, xcc, xst, (unsigned)G0, xlead); } while (0)
    if (lo < 0) grid.sync();

    if (IN(0)) {
        PHASE_LOCALS
        for (int rep = ((REP_MASK >> 0) & 1); rep >= 0; --rep) {
        LAS float* scr = (LAS float*)(lds + wave * 16384);
        const int gw = bid * 8 + wave, NGW = G * 8;
        constexpr int I0 = 16 * (INP / 32), I1 = 16 * 32, I2 = 16 * (2 * DFF / 32), I3 = (DFF / 64) * 32, I4 = 16 * 32, I5 = 4 * 32, I6 = 32 * 8, I7 = 32 * 8, I8 = 4 * 2, I9 = 4 * 2;
        constexpr int NIT = I0 + I1 + I2 + I3 + I4 + I5 + I6 + I7 + I8 + I9;
        for (int r0_ = (P0_REP & 1); r0_ >= 0; --r0_)
        for (int it = gw; it < NIT; it += NGW) {
            int r = it;
            if (r < I0) { const int nblk = INP / 32, kb = r / nblk, nb = r % nblk, np0 = nb * 32, tile = np0 >> 8, p = np0 & 255;
                const int src = tile < 13 ? tile * 256 + 64 * ((p >> 5) & 3) + 32 * (p >> 7) : 3328 + p;
                tr_item(args.in[opq(I_WIN)], DM, INW, (bf16_t*)(ws + WS_WIN), scr, kb * 64, np0, src, lane, args.in[opq(I_NMIX)]); continue; } r -= I0;
            if (r < I1) { tr_item(args.in[opq(I_WOUT)], DM, DM, (bf16_t*)(ws + WS_WOUT), scr, (r / 32) * 64, (r % 32) * 32, (r % 32) * 32, lane); continue; } r -= I1;
            if (r < I2) { const int nblk = 2 * DFF / 32, kb = r / nblk, nb = r % nblk, np0 = nb * 32, tile = np0 >> 8, p = np0 & 255;
                const int src = (p >> 7) * DFF + tile * 128 + (p & 127);
                tr_item(args.in[opq(I_WUP)], DM, 2 * DFF, (bf16_t*)(ws + WS_WUP), scr, kb * 64, np0, src, lane, args.in[opq(I_NFFN)]); continue; } r -= I2;
            if (r < I3) { tr_item(args.in[opq(I_WDN)], DFF, DM, (bf16_t*)(ws + WS_WDN), scr, (r / 32) * 64, (r % 32) * 32, (r % 32) * 32, lane); continue; } r -= I3;
            if (r < I4) { tr_item(args.in[opq(I_PLEG)], DM, DM, (bf16_t*)(ws + WS_WG), scr, (r / 32) * 64, (r % 32) * 32, (r % 32) * 32, lane); continue; } r -= I4;
            if (r < I5) { tr_item(args.in[opq(I_PLEW)], PLE, DM, (bf16_t*)(ws + WS_WP), scr, (r / 32) * 64, (r % 32) * 32, (r % 32) * 32, lane); continue; } r -= I5;
            if (r < I6) { tr_item(args.in[opq(I_KW1)], 2048, 256, (bf16_t*)(ws + WS_W1K), scr, (r / 8) * 64, (r % 8) * 32, (r % 8) * 32, lane); continue; } r -= I6;
            if (r < I7) { tr_item(args.in[opq(I_VW1)], 2048, 256, (bf16_t*)(ws + WS_W1V), scr, (r / 8) * 64, (r % 8) * 32, (r % 8) * 32, lane); continue; } r -= I7;
            if (r < I8) { tr_item(args.in[opq(I_KW2)], 256, 64, (bf16_t*)(ws + WS_W2K), scr, (r / 2) * 64, (r % 2) * 32, (r % 2) * 32, lane); continue; } r -= I8;
            tr_item(args.in[opq(I_VW2)], 256, 64, (bf16_t*)(ws + WS_W2V), scr, (r / 2) * 64, (r % 2) * 32, (r % 2) * 32, lane);
        }
        {
            const float* x = args.in[opq(I_X)]; bf16_t* xs = (bf16_t*)(ws + WS_XS); float* r0 = (float*)(ws + WS_R0);
            for (int r1_ = ((P0_REP >> 1) & 1); r1_ >= 0; --r1_)
            for (int m0 = gw * 4; m0 < T; m0 += NGW * 4) {
                f32x4 v[4][4];
#pragma unroll
                for (int rr = 0; rr < 4; ++rr)
#pragma unroll
                    for (int j = 0; j < 4; ++j) v[rr][j] = __builtin_nontemporal_load((const f32x4*)(x + (size_t)(m0 + rr) * DM) + lane + 64 * j);
                float s[4];
#pragma unroll
                for (int rr = 0; rr < 4; ++rr) { s[rr] = 0.f;
#pragma unroll
                    for (int j = 0; j < 4; ++j) s[rr] += (v[rr][j][0] * v[rr][j][0] + v[rr][j][1] * v[rr][j][1]) + (v[rr][j][2] * v[rr][j][2] + v[rr][j][3] * v[rr][j][3]); }
#pragma unroll
                for (int o = 1; o < 64; o <<= 1) { s[0] += __shfl_xor(s[0], o); s[1] += __shfl_xor(s[1], o); s[2] += __shfl_xor(s[2], o); s[3] += __shfl_xor(s[3], o); }
                if (lane < 4) r0[m0 + lane] = rsqrtf((lane == 0 ? s[0] : lane == 1 ? s[1] : lane == 2 ? s[2] : s[3]) * (1.f / DM) + EPS);
#pragma unroll
                for (int j = 0; j < 4; ++j) {
#pragma unroll
                    for (int rr = 0; rr < 4; ++rr) *(u32x2*)(xs + (size_t)(m0 + rr) * DM + 4 * lane + 256 * j) = pack4(v[rr][j]); }
            }
        }
        const int gt = bid * NTHR + tid, NGT = G * NTHR;
        { const f32x4* p4 = (const f32x4*)args.in[opq(I_P)]; u32x2* pb = (u32x2*)(ws + WS_PB);
            for (int r2_ = ((P0_REP >> 2) & 1); r2_ >= 0; --r2_)
#pragma unroll 8
            for (int i = gt; i < T * PLE / 4; i += NGT) pb[i] = pack4(__builtin_nontemporal_load(p4 + i)); }
        { float* z1 = (float*)(ws + WS_SS1); float* z3 = (float*)(ws + WS_SS3); for (int i = gt; i < T; i += NGT) { z1[i] = 0.f; z3[i] = 0.f; } }
        { float* c1p = (float*)(ws + WS_C1P); const float* cp = args.in[opq(I_CPOS)];
            for (int r4_ = ((P0_REP >> 4) & 1); r4_ >= 0; --r4_)
            for (int i = gt; i < 16 * 512; i += NGT) { const int kc = i >> 9, o = i & 511; const float* w1 = ((o >> 8) ? args.in[opq(I_VW1)] : args.in[opq(I_KW1)]); const int n = o & 255; float s = 0.f;
#pragma unroll 32
                for (int k = kc * 128; k < kc * 128 + 128; ++k) s += cp[k] * w1[(size_t)k * 256 + n];
                c1p[i] = s; } }
        if (rep > 0) { asm volatile("s_waitcnt vmcnt(0) lgkmcnt(0)" ::: "memory"); __syncthreads(); }
        }
    }
    SEAM(0);
    for (int xb = 0; xb < XBAR; ++xb) { SEAM(0); }

    if (IN(1)) {
        PHASE_LOCALS
        for (int rep = ((REP_MASK >> 1) & 1); rep >= 0; --rep) {
        if (bid == 0) { const float* c1p = (const float*)(ws + WS_C1P); float s = 0.f; for (int k = 0; k < 16; ++k) s += c1p[k * 512 + tid]; ((float*)(ws + WS_C1))[tid] = s; }
        {
            pg8::Gemm g{(const bf16_t*)(ws + WS_XS), (const bf16_t*)(ws + WS_WIN), T, INP, DM, DM, DM}; pg8::StaticOrder S; S.init(T, INP, G, bid);
            for (int rep4 = ((REP2 >> 2) & 1); rep4 >= 0; --rep4) {
            EpiIn E{(const float*)(ws + WS_R0), (const int*)args.in[opq(I_POS)], ws};
            pg8::gemm_phase(lds, g, S, E, tid); }
        }
        if (rep > 0) { asm volatile("s_waitcnt vmcnt(0) lgkmcnt(0)" ::: "memory"); __syncthreads(); }
        }
    }
    SEAM(1);

    if (IN(2)) {
        PHASE_LOCALS
        for (int rep = ((REP_MASK >> 2) & 1); rep >= 0; --rep) {
        const int ngemm = (G >= 128) ? 64 : 0;
        {
            for (int q = bid; q < 64; q += G) {
                const int kv = q >> 5, ks = (q >> 4) & 1;
                pg8::Gemm g{(const bf16_t*)(ws + (kv ? WS_VC : WS_KC)) + ks * 1024, (const bf16_t*)(ws + (kv ? WS_W1V : WS_W1K)) + ks * 1024, 4096, 256, 1024, 1024, 2048};
                pg8::StaticOrder S; S.init(4096, 256, 16, q & 15);
                EpiF32 E{(float*)(ws + WS_SB) + (size_t)(kv * 2 + ks) * 4096 * 256, 256};
                pg8::gemm_phase(lds, g, S, E, tid);
            }
        }
        if (bid >= ngemm) {
            const bf16_t* RK = (const bf16_t*)(ws + WS_RK); const bf16_t* RV = (const bf16_t*)(ws + WS_RV); float* KV = (float*)(ws + WS_KVST);
            for (int it = bid - ngemm; it < 2048; it += G - ngemm) {
                const int n = it & 31, h = (it >> 5) & 7, b = it >> 8;
                const float lg2 = log1pf(-exp2f(-5.f - (float)h)) * 1.4426950408889634f;
#pragma unroll
                for (int i = 0; i < 2; ++i) {
                    const int ch = tid + i * NTHR, k = ch >> 3, c8 = ch & 7; const size_t src = ((size_t)(b * SEQ + n * 128 + k)) * 512 + h * 64 + c8 * 8;
                    const u32x4 kr = *(const u32x4*)(RK + src), vr = *(const u32x4*)(RV + src);
                    const float dk = fexp2((float)(127 - k) * lg2); u32x4 ko;
                    ko.x = cvt_pk_bf16(__uint_as_float(kr.x << 16) * dk, __uint_as_float(kr.x & 0xffff0000u) * dk); ko.y = cvt_pk_bf16(__uint_as_float(kr.y << 16) * dk, __uint_as_float(kr.y & 0xffff0000u) * dk);
                    ko.z = cvt_pk_bf16(__uint_as_float(kr.z << 16) * dk, __uint_as_float(kr.z & 0xffff0000u) * dk); ko.w = cvt_pk_bf16(__uint_as_float(kr.w << 16) * dk, __uint_as_float(kr.w & 0xffff0000u) * dk);
                    *(LAS u32x4*)(lds + k * RS + c8 * 16) = ko; *(LAS u32x4*)(lds + 18432 + k * RS + c8 * 16) = vr;
                }
                __syncthreads();
                const LAS unsigned char* tb = lds + (4 * fq + (fr >> 2)) * RS + (fr & 3) * 8;
#pragma unroll
                for (int tt = 0; tt < 2; ++tt) {
                    const int et = (2 * wave + tt) >> 2, dt = (2 * wave + tt) & 3; f32x4 a = (f32x4){0.f, 0.f, 0.f, 0.f};
#pragma unroll
                    for (int kk = 0; kk < 4; ++kk) {
                        const bf16x8 af = cat8(trrd(tb + 18432 + (32 * kk) * RS + et * 32), trrd(tb + 18432 + (32 * kk + 16) * RS + et * 32));
                        const bf16x8 bf = cat8(trrd(tb + (32 * kk) * RS + dt * 32), trrd(tb + (32 * kk + 16) * RS + dt * 32));
                        a = mfma16(af, bf, a);
                    }
                    float* dst = KV + (size_t)it * 4096 + (16 * et + 4 * fq) * 64 + 16 * dt + fr;
                    dst[0] = a[0]; dst[64] = a[1]; dst[128] = a[2]; dst[192] = a[3];
                }
                __syncthreads();
            }
        }
        if (rep > 0) { asm volatile("s_waitcnt vmcnt(0) lgkmcnt(0)" ::: "memory"); __syncthreads(); }
        }
    }
    SEAM(2);

    if (IN(3)) {
        PHASE_LOCALS
        for (int rep = ((REP_MASK >> 3) & 1); rep >= 0; --rep) {
        for (int it = bid * 8 + wave; it < 512; it += G * 8) {
            const int kv = it >> 8, r0 = (it & 255) * 16;
            const bf16_t* w2 = (const bf16_t*)(ws + (kv ? WS_W2V : WS_W2K)); bf16_t* o = (bf16_t*)(ws + (kv ? WS_CV : WS_CK));
            f32x4 a[4];
#pragma unroll
            for (int nt = 0; nt < 4; ++nt) a[nt] = (f32x4){0.f, 0.f, 0.f, 0.f};
#pragma unroll 2
            for (int ks = 0; ks < 8; ++ks) {
                bf16x8 hf;
                { const float* p0 = (const float*)(ws + WS_SB) + ((size_t)(kv * 2) * 4096 + r0 + fr) * 256 + 32 * ks + 8 * fq; const float* p1 = p0 + (size_t)4096 * 256;
                  const float* cb = (const float*)(ws + WS_C1) + kv * 256 + 32 * ks + 8 * fq;
                  f32x4 a0 = __builtin_nontemporal_load((const f32x4*)p0) + __builtin_nontemporal_load((const f32x4*)p1) + *(const f32x4*)cb, a1 = __builtin_nontemporal_load((const f32x4*)(p0 + 4)) + __builtin_nontemporal_load((const f32x4*)(p1 + 4)) + *(const f32x4*)(cb + 4);
#pragma unroll
                  for (int e = 0; e < 4; ++e) { a0[e] = gelu_tanh(a0[e]); a1[e] = gelu_tanh(a1[e]); }
                  hf = pack8(a0, a1); }
#pragma unroll
                for (int nt = 0; nt < 4; ++nt) { const bf16x8 wf = *(const bf16x8*)(w2 + (size_t)(16 * nt + fr) * 256 + 32 * ks + 8 * fq); a[nt] = mfma16(wf, hf, a[nt]); }
            }
#pragma unroll
            for (int nt = 0; nt < 4; ++nt) *(u32x2*)(o + (size_t)(r0 + fr) * 64 + 16 * nt + 4 * fq) = pack4(a[nt]);
        }
        float* KV = (float*)(ws + WS_KVST);
        for (int i = bid * NTHR + tid; i < 64 * 4096; i += G * NTHR) {
            const int bh = i >> 12, el = i & 4095, h = bh & 7;
            const float cd = fexp2(128.f * log1pf(-exp2f(-5.f - (float)h)) * 1.4426950408889634f);
            float* p = KV + (size_t)bh * 32 * 4096 + el; float s = 0.f;
#pragma unroll
            for (int n0 = 0; n0 < 32; n0 += 8) { float t[8];
#pragma unroll
                for (int n = 0; n < 8; ++n) t[n] = p[(size_t)(n0 + n) * 4096];
#pragma unroll
                for (int n = 0; n < 8; ++n) { p[(size_t)(n0 + n) * 4096] = s; s = s * cd + t[n]; } }
        }
        {
            pg8::Gemm g{(const bf16_t*)(ws + WS_PB), (const bf16_t*)(ws + WS_WP), T, DM, PLE, PLE, PLE}; pg8::StaticOrder S; S.init(T, DM, G, bid);
            EpiBf16<0> E{(bf16_t*)(ws + WS_PE), DM, nullptr};
            pg8::gemm_phase(lds, g, S, E, tid);
        }
        if (rep > 0) { asm volatile("s_waitcnt vmcnt(0) lgkmcnt(0)" ::: "memory"); __syncthreads(); }
        }
    }
    SEAM(3);

    if (IN(4)) {
        PHASE_LOCALS
        for (int rep = ((REP_MASK >> 4) & 1); rep >= 0; --rep) {
        bf16_t* MIX = (bf16_t*)out + (size_t)T * DM;
        LAS unsigned char* CKl = lds + 36864; LAS unsigned char* CVl = lds + 73728; LAS float* IMP = (LAS float*)(lds + 110592);
        LAS unsigned long long* SELM = (LAS unsigned long long*)(lds + 127232); LAS unsigned long long* UNI = (LAS unsigned long long*)(lds + 127744);
        const bf16_t* NQ = (const bf16_t*)(ws + WS_NQ); const float* NG = (const float*)(ws + WS_NG);
#ifndef DBG_SKIP
#define DBG_SKIP 0
#endif
        for (int rep2 = (REP2 & 1); rep2 >= 0; --rep2)
        for (int it = bid; it < ((DBG_SKIP & 1) ? 0 : 1024); it += G) {
            const int vb_ = it & 255, v = (G == 256) ? ((vb_ & 7) * 32 + (vb_ >> 3)) : vb_, kq = it >> 8, bg = v >> 4, s16 = v & 15;
            const int qb = (kq == 0) ? s16 : (kq == 1) ? 31 - s16 : (kq == 2) ? 32 + s16 : 63 - s16;
            const int b = bg >> 1, g = bg & 1;
            const int hr = fr >> 2, toff = 8 * wave + (fr & 3);
            const int head = g * 4 + hr;
            bf16x8 Qf[2][2]; float gate[2][3]; f32x4 acc_o[2][4];
#pragma unroll
            for (int qg = 0; qg < 2; ++qg) {
                const size_t row = (size_t)b * SEQ + 64 * qb + toff + 4 * qg;
#pragma unroll
                for (int ks = 0; ks < 2; ++ks) Qf[qg][ks] = *(const bf16x8*)(NQ + row * 512 + head * 64 + 32 * ks + 8 * fq);
#pragma unroll
                for (int br = 0; br < 3; ++br) gate[qg][br] = NG[row * 24 + head * 3 + br];
#pragma unroll
                for (int dt = 0; dt < 4; ++dt) acc_o[qg][dt] = (f32x4){0.f, 0.f, 0.f, 0.f};
                if (DBG_SKIP & 16) { gate[qg][0] = 1.f; gate[qg][1] = 1.f; gate[qg][2] = 1.f; }
                if (DBG_SKIP & 32) { const bf16x8 cq = {0x3c00, 0x3c80, 0x3d00, 0x3c00, 0x3d80, 0x3c00, 0x3c80, 0x3d00}; Qf[qg][0] = cq; Qf[qg][1] = cq; }
            }
            for (int nrep = (NSA_REP & 1); nrep >= 0; --nrep) {
            float zf = 0.f; asm volatile("" : "+v"(zf));
            const int ncv = (4 * qb + 3 < 255) ? 4 * qb + 3 : 255, NT2 = (ncv + 31) >> 5;
            {
                const bf16_t* ckg = (const bf16_t*)(ws + WS_CK) + (size_t)bg * 256 * 64; const bf16_t* cvg = (const bf16_t*)(ws + WS_CV) + (size_t)bg * 256 * 64;
                int ch0_ = tid; asm volatile("" : "+v"(ch0_));
                for (int ch = ch0_; ch < NT2 * 32 * 8; ch += NTHR) { const int r = ch >> 3, c8 = ch & 7;
                    u32x4 a_ = *(const u32x4*)(ckg + r * 64 + c8 * 8), b_ = *(const u32x4*)(cvg + r * 64 + c8 * 8);
                    if (DBG_SKIP & 128) { a_ = *(const u32x4*)((const bf16_t*)(ws + WS_HIDK) + ((size_t)bg * 256 + r) * 256 + c8 * 8); b_ = *(const u32x4*)((const bf16_t*)(ws + WS_HIDV) + ((size_t)bg * 256 + r) * 256 + c8 * 8); }
                    if (DBG_SKIP & 64) { const unsigned pz = 0x3c003c00u + ((unsigned)((r * 7 + c8 * 3) & 63) << 16) + (unsigned)((r * 5 + c8) & 31); a_ = (u32x4){pz, pz + 1u, pz + 2u, pz + 3u}; b_ = (u32x4){pz + 4u, pz + 5u, pz + 6u, pz + 7u}; }
                    *(LAS u32x4*)(CKl + r * RS + c8 * 16) = a_; *(LAS u32x4*)(CVl + r * RS + c8 * 16) = b_; }
            }
            __syncthreads();
            float cm[2] = {-1e30f, -1e30f}, cl[2] = {0.f, 0.f};
            const LAS unsigned char* kb = CKl + fr * RS + fq * 16;
            for (int kt = 0; kt < 2 * NT2; ++kt) {
                f32x4 S[2] = {(f32x4){0.f, 0.f, 0.f, 0.f}, (f32x4){0.f, 0.f, 0.f, 0.f}};
#pragma unroll
                for (int ks = 0; ks < 2; ++ks) { const bf16x8 kf = *(const LAS bf16x8*)(kb + kt * 16 * RS + ks * 64); S[0] = mfma16(kf, Qf[0][ks], S[0]); S[1] = mfma16(kf, Qf[1][ks], S[1]); }
#pragma unroll
                for (int qg = 0; qg < 2; ++qg) {
                    const int tq = 64 * qb + toff + 4 * qg; float rm = -INFINITY;
#pragma unroll
                    for (int e = 0; e < 4; ++e) { const int n = 16 * kt + 4 * fq + e; const float vv = (16 * n + 31 <= tq) ? S[qg][e] : -INFINITY; S[qg][e] = vv; rm = fmaxf(rm, vv); }
                    rm = rows_max(rm);
                    const float mn = fmaxf(cm[qg], rm); float sum = 0.f;
#pragma unroll
                    for (int e = 0; e < 4; ++e) sum += fexp2(S[qg][e] - mn);
                    cl[qg] = cl[qg] * fexp2(cm[qg] - mn) + sum; cm[qg] = mn;
                }
            }
            float cinv[2];
#pragma unroll
            for (int qg = 0; qg < 2; ++qg) { float l = cl[qg]; l = rows_sum(l); cinv[qg] = l > 0.f ? frcp(l) : 0.f; }
            {
                f32x4 O[2][4];
#pragma unroll
                for (int qg = 0; qg < 2; ++qg)
#pragma unroll
                    for (int dt = 0; dt < 4; ++dt) O[qg][dt] = (f32x4){0.f, 0.f, 0.f, 0.f};
                float carry[2] = {0.f, 0.f};
                const LAS unsigned char* vb = CVl + (4 * fq + (fr >> 2)) * RS + (fr & 3) * 8;
                for (int k2 = 0; k2 < NT2; ++k2) {
                    f32x4 S[2][2];
#pragma unroll
                    for (int qg = 0; qg < 2; ++qg) { S[qg][0] = (f32x4){0.f, 0.f, 0.f, 0.f}; S[qg][1] = (f32x4){0.f, 0.f, 0.f, 0.f}; }
#pragma unroll
                    for (int ks = 0; ks < 2; ++ks)
#pragma unroll
                        for (int t2 = 0; t2 < 2; ++t2) { const bf16x8 kf = *(const LAS bf16x8*)(kb + (2 * k2 + t2) * 16 * RS + ks * 64); S[0][t2] = mfma16(kf, Qf[0][ks], S[0][t2]); S[1][t2] = mfma16(kf, Qf[1][ks], S[1][t2]); }
                    bf16x8 Pf[2];
#pragma unroll
                    for (int qg = 0; qg < 2; ++qg) {
                        const int tq = 64 * qb + toff + 4 * qg;
#pragma unroll
                        for (int t2 = 0; t2 < 2; ++t2) {
                            const int kt = 2 * k2 + t2; float gs = 0.f;
#pragma unroll
                            for (int e = 0; e < 4; ++e) { const int n = 16 * kt + 4 * fq + e; const float p = (16 * n + 31 <= tq) ? fexp2(S[qg][t2][e] - cm[qg]) * cinv[qg] : 0.f; S[qg][t2][e] = p; gs += p; }
                            const float tsh = __shfl(S[qg][t2][3], (lane + 48) & 63);
                            float iv = gs + (fq == 0 ? carry[qg] : tsh); carry[qg] = tsh;
                            iv += __shfl_xor(iv, 4); iv += __shfl_xor(iv, 8);
                            if (hr == 0) IMP[(toff + 4 * qg) * 65 + 4 * kt + fq] = iv;
                        }
                        Pf[qg] = pack8(S[qg][0], S[qg][1]);
                    }
#pragma unroll
                    for (int dt = 0; dt < 4; ++dt) {
                        const bf16x8 vf = cat8(trrd(vb + (32 * k2) * RS + dt * 32), trrd(vb + (32 * k2 + 16) * RS + dt * 32));
                        O[0][dt] = mfma16(vf, Pf[0], O[0][dt]); O[1][dt] = mfma16(vf, Pf[1], O[1][dt]);
                    }
                }
#pragma unroll
                for (int qg = 0; qg < 2; ++qg)
#pragma unroll
                    for (int dt = 0; dt < 4; ++dt) acc_o[qg][dt] = acc_o[qg][dt] + O[qg][dt] * (nrep > 0 ? zf : gate[qg][0]);
            }
            __syncthreads();
            {
                const int tok = tid >> 3, sub = tid & 7; unsigned long long bits = 0ull;
                if (qb >= 16) {
                    for (int j = 1 + sub; j <= qb - 2; j += 8) {
                        const float vj = IMP[tok * 65 + j]; int rank = 0;
                        for (int jj = 1; jj <= qb - 2; ++jj) { const float uu = IMP[tok * 65 + jj]; rank += (uu > vj || (uu == vj && jj < j)) ? 1 : 0; }
                        if (rank < 13) bits |= 1ull << j;
                    }
                    unsigned blo = (unsigned)bits, bhi = (unsigned)(bits >> 32);
                    blo |= __shfl_xor(blo, 1); bhi |= __shfl_xor(bhi, 1); blo |= __shfl_xor(blo, 2); bhi |= __shfl_xor(bhi, 2); blo |= __shfl_xor(blo, 4); bhi |= __shfl_xor(bhi, 4);
                    bits = ((unsigned long long)bhi << 32) | blo;
                    bits |= 1ull | (1ull << qb) | (1ull << (qb - 1));
                } else bits = (2ull << qb) - 1ull;
                if (sub == 0) SELM[tok] = bits;
                __syncthreads();
                if (tid < 64) {
                    unsigned long long u = SELM[tid]; unsigned ulo = (unsigned)u, uhi = (unsigned)(u >> 32);
#pragma unroll
                    for (int o = 1; o < 64; o <<= 1) { ulo |= __shfl_xor(ulo, o); uhi |= __shfl_xor(uhi, o); }
                    if (tid == 0) UNI[0] = ((unsigned long long)uhi << 32) | ulo;
                }
                __syncthreads();
            }
            }
            unsigned long long selm[2] = {SELM[toff], SELM[toff + 4]};
            unsigned long long umask = UNI[0];
            { const unsigned ulo = __builtin_amdgcn_readfirstlane((unsigned)umask), uhi = __builtin_amdgcn_readfirstlane((unsigned)(umask >> 32)); umask = ((unsigned long long)uhi << 32) | ulo; }
            for (int nrep = ((NSA_REP >> 1) & 1); nrep >= 0; --nrep) { float zf = 0.f; asm volatile("" : "+v"(zf));
            if (!(DBG_SKIP & 4)) attn_branch(lds, (const bf16_t*)(ws + WS_KS) + (size_t)bg * SEQ * 64, (const bf16_t*)(ws + WS_VS) + (size_t)bg * SEQ * 64, umask, qb, 0, Qf, selm, fr, fq, toff, nrep > 0 ? zf : gate[0][1], nrep > 0 ? zf : gate[1][1], acc_o, tid); }
            { const int j0 = qb >= 8 ? qb - 8 : 0; const unsigned long long wm = ((2ull << qb) - 1ull) & ~((1ull << j0) - 1ull);
              for (int nrep = ((NSA_REP >> 2) & 1); nrep >= 0; --nrep) { float zf = 0.f; asm volatile("" : "+v"(zf));
              if (!(DBG_SKIP & 8)) attn_branch(lds, (const bf16_t*)(ws + WS_KW) + (size_t)bg * SEQ * 64, (const bf16_t*)(ws + WS_VW) + (size_t)bg * SEQ * 64, wm, qb, 1, Qf, selm, fr, fq, toff, nrep > 0 ? zf : gate[0][2], nrep > 0 ? zf : gate[1][2], acc_o, tid); } }
#pragma unroll
            for (int qg = 0; qg < 2; ++qg) {
                const size_t row = (size_t)b * SEQ + 64 * qb + toff + 4 * qg;
#pragma unroll
                for (int dt = 0; dt < 4; ++dt) *(u32x2*)(MIX + row * DM + 512 + head * 64 + 16 * dt + 4 * fq) = pack4(acc_o[qg][dt]);
            }
        }
        {
            int lane2_ = (int)__builtin_amdgcn_mbcnt_hi(~0u, __builtin_amdgcn_mbcnt_lo(~0u, 0u)); asm volatile("" : "+v"(lane2_));
            const int lane = lane2_, tid = wave * 64 + lane, fr = lane & 15, fq = lane >> 4;
            const bf16_t* RQ = (const bf16_t*)(ws + WS_RQ); const bf16_t* RK = (const bf16_t*)(ws + WS_RK); const bf16_t* RV = (const bf16_t*)(ws + WS_RV); const bf16_t* RG = (const bf16_t*)(ws + WS_RG);
            const float* KV = (const float*)(ws + WS_KVST); const float* gnw = args.in[opq(I_GNW)];
            u32x4 pk[2], pv[2]; f32x4 ps0, ps1; bf16x8 pq[2]; u32x2 pg[4];
#define R3_ISSUE(IT) do { const int n_ = (IT) & 31, h_ = ((IT) >> 5) & 7, b_ = (IT) >> 8; \
                _Pragma("unroll") for (int i = 0; i < 2; ++i) { const int ch = tid + i * NTHR, k = ch >> 3, c8 = ch & 7; const size_t src = ((size_t)(b_ * SEQ + n_ * 128 + k)) * 512 + h_ * 64 + c8 * 8; pk[i] = *(const u32x4*)(RK + src); pv[i] = *(const u32x4*)(RV + src); } \
                { const f32x4* sp = (const f32x4*)(KV + (size_t)(IT) * 4096 + (tid >> 3) * 64 + (tid & 7) * 8); ps0 = sp[0]; ps1 = sp[1]; } \
                { const size_t row_ = (size_t)b_ * SEQ + n_ * 128 + 16 * wave + fr; pq[0] = *(const bf16x8*)(RQ + row_ * 512 + h_ * 64 + 8 * fq); pq[1] = *(const bf16x8*)(RQ + row_ * 512 + h_ * 64 + 32 + 8 * fq); \
                  _Pragma("unroll") for (int dt = 0; dt < 4; ++dt) pg[dt] = *(const u32x2*)(RG + row_ * 512 + h_ * 64 + 16 * dt + 4 * fq); } } while (0)
            for (int rep3 = ((REP2 >> 1) & 1); rep3 >= 0; --rep3) {
            const int itend = (DBG_SKIP & 2) ? 0 : 2048;
            if (bid < itend) R3_ISSUE(bid);
            for (int it = bid; it < itend; it += G) {
                const int n = it & 31, h = (it >> 5) & 7, b = it >> 8;
                const float lg2 = log1pf(-exp2f(-5.f - (float)h)) * 1.4426950408889634f;
#pragma unroll
                for (int i = 0; i < 2; ++i) { const int ch = tid + i * NTHR, k = ch >> 3, c8 = ch & 7;
                    *(LAS u32x4*)(lds + k * RS + c8 * 16) = pk[i]; *(LAS u32x4*)(lds + 18432 + k * RS + c8 * 16) = pv[i]; }
                { const int e = tid >> 3, c8 = tid & 7;
                    u32x4 o; o.x = cvt_pk_bf16(ps0[0], ps0[1]); o.y = cvt_pk_bf16(ps0[2], ps0[3]); o.z = cvt_pk_bf16(ps1[0], ps1[1]); o.w = cvt_pk_bf16(ps1[2], ps1[3]);
                    *(LAS u32x4*)(lds + 36864 + e * RS + c8 * 16) = o; }
                bf16x8 Qf[2] = {pq[0], pq[1]}; u32x2 rgv[4] = {pg[0], pg[1], pg[2], pg[3]};
                __syncthreads();
                if (it + G < itend) R3_ISSUE(it + G);
                const int c = 16 * wave + fr; const size_t row = (size_t)b * SEQ + n * 128 + c;
                f32x4 O[4], X[4];
#pragma unroll
                for (int dt = 0; dt < 4; ++dt) { O[dt] = (f32x4){0.f, 0.f, 0.f, 0.f}; X[dt] = (f32x4){0.f, 0.f, 0.f, 0.f}; }
                const LAS unsigned char* kb = lds + fr * RS + fq * 16;
                const LAS unsigned char* vb = lds + 18432 + (4 * fq + (fr >> 2)) * RS + (fr & 3) * 8;
                for (int k2 = 0; k2 <= (wave >> 1); ++k2) {
                    f32x4 S0 = (f32x4){0.f, 0.f, 0.f, 0.f}, S1 = S0;
#pragma unroll
                    for (int ks = 0; ks < 2; ++ks) { S0 = mfma16(*(const LAS bf16x8*)(kb + (32 * k2) * RS + ks * 64), Qf[ks], S0); S1 = mfma16(*(const LAS bf16x8*)(kb + (32 * k2 + 16) * RS + ks * 64), Qf[ks], S1); }
#pragma unroll
                    for (int e = 0; e < 4; ++e) { const int d0 = c - (32 * k2 + 4 * fq + e), d1 = d0 - 16;
                        S0[e] = d0 >= 0 ? S0[e] * fexp2((float)d0 * lg2) : 0.f; S1[e] = d1 >= 0 ? S1[e] * fexp2((float)d1 * lg2) : 0.f; }
                    const bf16x8 pf = pack8(S0, S1);
#pragma unroll
                    for (int dt = 0; dt < 4; ++dt) O[dt] = mfma16(cat8(trrd(vb + (32 * k2) * RS + dt * 32), trrd(vb + (32 * k2 + 16) * RS + dt * 32)), pf, O[dt]);
                }
#pragma unroll
                for (int ks = 0; ks < 2; ++ks)
#pragma unroll
                    for (int dt = 0; dt < 4; ++dt) X[dt] = mfma16(*(const LAS bf16x8*)(lds + 36864 + (16 * dt + fr) * RS + ks * 64 + fq * 16), Qf[ks], X[dt]);
                const float qd = fexp2((float)(c + 1) * lg2);
                float s = 0.f;
#pragma unroll
                for (int dt = 0; dt < 4; ++dt) { O[dt] = O[dt] + X[dt] * qd; s += (O[dt][0] + O[dt][1]) + (O[dt][2] + O[dt][3]); }
                s += __shfl_xor(s, 16); s += __shfl_xor(s, 32);
                const float mu = s * (1.f / 64.f); float q = 0.f;
#pragma unroll
                for (int dt = 0; dt < 4; ++dt) { O[dt] = O[dt] - mu; q += (O[dt][0] * O[dt][0] + O[dt][1] * O[dt][1]) + (O[dt][2] * O[dt][2] + O[dt][3] * O[dt][3]); }
                q += __shfl_xor(q, 16); q += __shfl_xor(q, 32);
                const float rstd = rsqrtf(q * (1.f / 64.f) + EPS);
#pragma unroll
                for (int dt = 0; dt < 4; ++dt) {
                    const int e0 = h * 64 + 16 * dt + 4 * fq; const f32x4 gw = *(const f32x4*)(gnw + e0); const u32x2 rg = rgv[dt];
                    f32x4 o = O[dt] * rstd * gw;
                    o[0] *= __uint_as_float(rg.x << 16); o[1] *= __uint_as_float(rg.x & 0xffff0000u); o[2] *= __uint_as_float(rg.y << 16); o[3] *= __uint_as_float(rg.y & 0xffff0000u);
                    *(u32x2*)(MIX + row * DM + e0) = pack4(o);
                }
                __syncthreads();
            }
            }
#undef R3_ISSUE
        }
        if (rep > 0) { asm volatile("s_waitcnt vmcnt(0) lgkmcnt(0)" ::: "memory"); __syncthreads(); }
        }
    }
    SEAM(4);

    if (IN(5)) {
        PHASE_LOCALS
        for (int rep = ((REP_MASK >> 5) & 1); rep >= 0; --rep) {
        pg8::Gemm g{(const bf16_t*)out + (size_t)T * DM, (const bf16_t*)(ws + WS_WOUT), T, DM, DM, DM, DM}; pg8::StaticOrder S; S.init(T, DM, G, bid);
        EpiOut E{(const bf16_t*)(ws + WS_XS), (bf16_t*)out, (float*)(ws + WS_SS1), rep > 0 ? lnd_i(1) : 0};
        pg8::gemm_phase(lds, g, S, E, tid);
        if (rep > 0) { asm volatile("s_waitcnt vmcnt(0) lgkmcnt(0)" ::: "memory"); __syncthreads(); }
        }
    }
    SEAM(5);

    if (IN(6)) {
        PHASE_LOCALS
        for (int rep = ((REP_MASK >> 6) & 1); rep >= 0; --rep) {
        pg8::Gemm g{(const bf16_t*)out, (const bf16_t*)(ws + WS_WUP), T, 2 * DFF, DM, DM, DM}; pg8::StaticOrder S; S.init(T, 2 * DFF, G, bid);
        EpiUp E{(const float*)(ws + WS_SS1), args.in[opq(I_CONVW)], args.in[opq(I_CONVB)], (bf16_t*)(ws + WS_ACT), (float*)(ws + WS_SB)};
        pg8::gemm_phase(lds, g, S, E, tid);
        if (rep > 0) { asm volatile("s_waitcnt vmcnt(0) lgkmcnt(0)" ::: "memory"); __syncthreads(); }
        }
    }
    SEAM(6);

    if (IN(7)) {
        PHASE_LOCALS
        for (int rep = ((REP_MASK >> 7) & 1); rep >= 0; --rep) {
        const float* sb = (const float*)(ws + WS_SB); const float* cw = args.in[opq(I_CONVW)]; const float* cb = args.in[opq(I_CONVB)]; bf16_t* act = (bf16_t*)(ws + WS_ACT);
        for (int i = bid * NTHR + tid; i < 512 * 2 * (DFF / 4); i += G * NTHR) {
            const int c = (i % (DFF / 4)) * 4, ur = i / (DFF / 4), rr = ur & 1, u = ur >> 1; const bool first = (u & 63) == 0;
            const float* su = sb + (size_t)u * 6 * DFF + c; const float* sp = su - 6 * DFF;
            const f32x4 z4 = (f32x4){0.f, 0.f, 0.f, 0.f};
            const f32x4 gt = __builtin_nontemporal_load((const f32x4*)(su + rr * DFF)), vt = __builtin_nontemporal_load((const f32x4*)(su + (2 + rr) * DFF));
            f32x4 g1, g2;
            if (rr == 0) { g1 = first ? z4 : *(const f32x4*)(sp + 5 * DFF); g2 = first ? z4 : *(const f32x4*)(sp + 4 * DFF); } else { g1 = *(const f32x4*)su; g2 = first ? z4 : *(const f32x4*)(sp + 5 * DFF); }
            const f32x4 gate = *(const f32x4*)(cb + c) + *(const f32x4*)(cw + c) * g2 + *(const f32x4*)(cw + DFF + c) * g1 + *(const f32x4*)(cw + 2 * DFF + c) * gt;
            f32x4 o; o[0] = siluf_(gate[0]) * vt[0]; o[1] = siluf_(gate[1]) * vt[1]; o[2] = siluf_(gate[2]) * vt[2]; o[3] = siluf_(gate[3]) * vt[3];
            *(u32x2*)(act + (size_t)(64 * u + rr) * DFF + c) = pack4(o);
        }
        if (rep > 0) { asm volatile("s_waitcnt vmcnt(0) lgkmcnt(0)" ::: "memory"); __syncthreads(); }
        }
    }
    SEAM(7);

    if (IN(8)) {
        PHASE_LOCALS
        for (int rep = ((REP_MASK >> 8) & 1); rep >= 0; --rep) {
        pg8::Gemm g{(const bf16_t*)(ws + WS_ACT), (const bf16_t*)(ws + WS_WDN), T, DM, DFF, DFF, DFF}; pg8::StaticOrder S; S.init(T, DM, G, bid);
        EpiDown E{(const bf16_t*)out, (bf16_t*)(ws + WS_HS), rep > 0 ? lnd_i(1) : 0};
        pg8::gemm_phase(lds, g, S, E, tid);
        if (rep > 0) { asm volatile("s_waitcnt vmcnt(0) lgkmcnt(0)" ::: "memory"); __syncthreads(); }
        }
    }
    SEAM(8);

    if (IN(9)) {
        PHASE_LOCALS
        for (int rep = ((REP_MASK >> 9) & 1); rep >= 0; --rep) {
        pg8::Gemm g{(const bf16_t*)(ws + WS_HS), (const bf16_t*)(ws + WS_WG), T, DM, DM, DM, DM}; pg8::StaticOrder S; S.init(T, DM, G, bid);
        EpiPle E{(const bf16_t*)(ws + WS_HS), (bf16_t*)(ws + WS_ACT), (const bf16_t*)(ws + WS_PE), (float*)(ws + WS_SS3), rep > 0 ? lnd_i(1) : 0};
        pg8::gemm_phase(lds, g, S, E, tid);
        if (rep > 0) { asm volatile("s_waitcnt vmcnt(0) lgkmcnt(0)" ::: "memory"); __syncthreads(); }
        }
    }
    SEAM(9);

    if (IN(10)) {
        PHASE_LOCALS
        const float* ss = (const float*)(ws + WS_SS3); const f32x4* wf = (const f32x4*)args.in[opq(I_FNW)]; f32x4* o4 = (f32x4*)out;
        const int gw = bid * 8 + wave, NGW = G * 8; const u32x2* h3 = (const u32x2*)(ws + WS_ACT);
        f32x4 wv[4];
#pragma unroll
        for (int j = 0; j < 4; ++j) wv[j] = wf[lane + 64 * j];
        for (int r0_ = gw * 4; r0_ < T; r0_ += NGW * 4) {
            u32x2 hv[4][4]; float rs[4];
#pragma unroll
            for (int rr = 0; rr < 4; ++rr) { rs[rr] = ss[r0_ + rr];
#pragma unroll
                for (int j = 0; j < 4; ++j) hv[rr][j] = __builtin_nontemporal_load(h3 + (size_t)(r0_ + rr) * 256 + lane + 64 * j); }
#pragma unroll
            for (int rr = 0; rr < 4; ++rr) { const float sc = rsqrtf(rs[rr] * (1.f / DM) + EPS);
#pragma unroll
                for (int j = 0; j < 4; ++j) { const u32x2 hw = hv[rr][j];
                    __builtin_nontemporal_store((f32x4){__uint_as_float(hw.x << 16), __uint_as_float(hw.x & 0xffff0000u), __uint_as_float(hw.y << 16), __uint_as_float(hw.y & 0xffff0000u)} * sc * wv[j], o4 + (size_t)(r0_ + rr) * 256 + lane + 64 * j); } }
        }
    }
#undef IN
#undef SEAM
}

extern "C" void kernel_launch(void* const* d_in, const int* in_sizes, int n_in, void* d_out, int out_size, void* d_ws, size_t ws_size, hipStream_t stream) {
    static int grid = 0;
    if (grid == 0) {
        if (n_in != 20 || out_size != T * DM || ws_size < WS_END) { fprintf(stderr, "kernel_launch: unexpected shapes (n_in %d out %d ws %zu)\n", n_in, out_size, ws_size); grid = -1; return; }
        int dev = 0, cus = 0, per_cu = 0;
        hipGetDevice(&dev); hipDeviceGetAttribute(&cus, hipDeviceAttributeMultiprocessorCount, dev);
        hipFuncSetAttribute((const void*)hymba_fwd, hipFuncAttributeMaxDynamicSharedMemorySize, LDS_BYTES);
        hipOccupancyMaxActiveBlocksPerMultiprocessor(&per_cu, (const void*)hymba_fwd, NTHR, LDS_BYTES);
        (void)hipGetLastError();
        if (per_cu < 1) { fprintf(stderr, "kernel_launch: occupancy query says %d blocks/CU\n", per_cu); per_cu = 1; }
        grid = cus;
    }
    if (grid < 0) return;
    Args a{};
    for (int i = 0; i < 20; ++i) a.in[i] = (const float*)d_in[i];
    a.out = (float*)d_out; a.ws = (unsigned char*)d_ws;
    const int NPH = 11;
#if N_LAUNCH_PER_PHASE
    for (int p = 0; p < NPH; ++p) {
        a.ph_lo = p; a.ph_hi = p + 1; void* args[] = {&a};
        hipError_t e = hipLaunchCooperativeKernel((const void*)hymba_fwd, dim3(grid), dim3(NTHR), args, LDS_BYTES, stream);
        if (e != hipSuccess) { fprintf(stderr, "launch %d failed: %s\n", p, hipGetErrorString(e)); break; }
    }
#else
    hipMemsetAsync((char*)d_ws + WS_BAR, 0, 16384, stream);
    a.ph_lo = 0; a.ph_hi = NPH; void* args[] = {&a};
    hipError_t e = hipLaunchCooperativeKernel((const void*)hymba_fwd, dim3(grid), dim3(NTHR), args, LDS_BYTES, stream);
    if (e != hipSuccess) fprintf(stderr, "cooperative launch failed: %s (grid %d)\n", hipGetErrorString(e), grid);
#endif
}
```
